# Optimizing an MI355X kernel written in HIP

```python
import math
import jax
import jax.numpy as jnp
from jax import lax
import numpy as np

D_MODEL = 1024
BATCH = 8
SEQ = 4096
DEPTH = 1

HEAD_DIM = 64
DIL_PAIRS = ((128, 1), (512, 4), (2048, 16))
DIL_HEADS_PER_GROUP = 4
DIL_HEADS = DIL_HEADS_PER_GROUP * len(DIL_PAIRS)
DIL_WIDTH = DIL_HEADS * HEAD_DIM
DIL_OUT = DIL_HEADS_PER_GROUP * HEAD_DIM
DIL_QBLOCK = 64
NA_HEADS = 8
NA_WIDTH = NA_HEADS * HEAD_DIM
GRID_W = 64
NA_KH_MAX = 8
NA_KW = 16
NA_QC = 16
NA_KC = NA_QC + NA_KW
N_EXPERTS = 16
EC_CAPACITY_FACTOR = 2
EXPERT_FF = 1024
ROPE_THETA = 10000.0
EPS = 1e-6
SPLIT_SIZES = (DIL_WIDTH, DIL_WIDTH, DIL_WIDTH, NA_WIDTH, NA_WIDTH, NA_WIDTH, D_MODEL, D_MODEL)
IN_COLS = sum(SPLIT_SIZES)
SPLIT_POINTS = tuple(sum(SPLIT_SIZES[:i + 1]) for i in range(len(SPLIT_SIZES) - 1))

kernel_name = 'hybrid_dilated_neighbourhood_ec_block'


def rms_norm(t, g):
    tf = t.astype(jnp.float32)
    y = tf * lax.rsqrt(jnp.mean(tf * tf, axis=-1, keepdims=True) + EPS)
    return (y * g.astype(jnp.float32)).astype(t.dtype)


def rotary(t, pos):
    half = t.shape[-1] // 2
    inv = ROPE_THETA ** (-jnp.arange(half, dtype=jnp.float32) / half)
    ang = pos[:, None] * inv[None, :]
    cos = jnp.cos(ang)[None, :, None, :]
    sin = jnp.sin(ang)[None, :, None, :]
    tf = t.astype(jnp.float32)
    t1, t2 = tf[..., :half], tf[..., half:]
    return jnp.concatenate([t1 * cos - t2 * sin, t2 * cos + t1 * sin], axis=-1).astype(t.dtype)


def dilated_group_attention(q, k, v, window, dilation):
    B, S, H, hd = q.shape
    d = dilation
    R = (window // 2) // d
    L = S // d
    qb = math.gcd(L, DIL_QBLOCK)
    nb = L // qb
    kw = qb + 2 * R

    def to_sub(t):
        return t.reshape(B, L, d, H, hd).transpose(0, 2, 3, 1, 4)

    pad = ((0, 0), (0, 0), (0, 0), (R, R), (0, 0))
    qs = to_sub(q).reshape(B, d, H, nb, qb, hd)
    ks = jnp.pad(to_sub(k), pad)
    vs = jnp.pad(to_sub(v), pad)
    kidx = jnp.arange(nb)[:, None] * qb + jnp.arange(kw)[None, :]
    kb = ks[:, :, :, kidx]
    vb = vs[:, :, :, kidx]
    s = jnp.einsum('brhnqc,brhnkc->brhnqk', qs, kb).astype(jnp.float32) * (hd ** -0.5)
    u_q = jnp.arange(nb)[:, None] * qb + jnp.arange(qb)[None, :]
    u_k = kidx - R
    off = u_k[:, None, :] - u_q[:, :, None]
    valid = (jnp.abs(off) <= R) & (u_k[:, None, :] >= 0) & (u_k[:, None, :] < L)
    s = jnp.where(valid, s, -jnp.inf)
    m = jnp.max(s, axis=-1, keepdims=True)
    p = jnp.exp(s - m)
    den = jnp.sum(p, axis=-1, keepdims=True)
    out = jnp.einsum('brhnqk,brhnkc->brhnqc', p, vb.astype(jnp.float32)) / den
    lse = (m + jnp.log(den))[..., 0]
    out = out.reshape(B, d, H, L, hd).transpose(0, 3, 1, 2, 4).reshape(B, S, H, hd)
    lse = lse.reshape(B, d, H, L).transpose(0, 3, 1, 2).reshape(B, S, H)
    return out.astype(q.dtype), lse


def neighbourhood_attention(q, k, v, rpb):
    B, S, H, hd = q.shape
    rows = S // GRID_W
    kh = min(NA_KH_MAX, rows)
    ncb = GRID_W // NA_QC
    qg = q.reshape(B, rows, GRID_W, H, hd)
    kg = k.reshape(B, rows, GRID_W, H, hd)
    vg = v.reshape(B, rows, GRID_W, H, hd)
    qcol = jnp.arange(GRID_W).reshape(ncb, NA_QC)
    kc_start = jnp.clip(jnp.arange(ncb) * NA_QC - NA_KW // 2, 0, GRID_W - NA_KC)
    kcol = kc_start[:, None] + jnp.arange(NA_KC)[None, :]
    ws = jnp.clip(qcol - NA_KW // 2, 0, GRID_W - NA_KW)
    col_ok = (kcol[:, None, :] >= ws[:, :, None]) & (kcol[:, None, :] < ws[:, :, None] + NA_KW)
    dc_idx = jnp.clip(kcol[:, None, :] - qcol[:, :, None] + NA_KW - 1, 0, 2 * NA_KW - 2)
    scale = hd ** -0.5

    def row_block(r):
        rs = jnp.clip(r - kh // 2, 0, rows - kh)
        q_r = lax.dynamic_index_in_dim(qg, r, axis=1, keepdims=False)
        k_r = lax.dynamic_slice_in_dim(kg, rs, kh, axis=1)
        v_r = lax.dynamic_slice_in_dim(vg, rs, kh, axis=1)
        kb = k_r[:, :, kcol]
        vb = v_r[:, :, kcol]
        qb = q_r.reshape(B, ncb, NA_QC, H, hd)
        s = jnp.einsum('bnqhc,bjnkhc->bhnqjk', qb, kb).astype(jnp.float32) * scale
        dr_idx = rs + jnp.arange(kh) - r + NA_KH_MAX - 1
        bias = rpb[:, dr_idx[:, None, None, None], dc_idx[None]]
        s = s + bias.transpose(0, 2, 3, 1, 4).astype(jnp.float32)[None]
        s = jnp.where(col_ok[:, :, None, :], s, -jnp.inf)
        p = jax.nn.softmax(s.reshape(B, H, ncb, NA_QC, kh * NA_KC), axis=-1)
        p = p.reshape(B, H, ncb, NA_QC, kh, NA_KC)
        o = jnp.einsum('bhnqjk,bjnkhc->bnqhc', p, vb.astype(jnp.float32))
        return o.reshape(B, GRID_W, H, hd).astype(q.dtype)

    out = lax.map(row_block, jnp.arange(rows))
    return out.transpose(1, 0, 2, 3, 4).reshape(B, S, H, hd)


def expert_choice_ffn(h, w_router, w_gate, w_up, w_down):
    B, S, D = h.shape
    cap = (EC_CAPACITY_FACTOR * S) // N_EXPERTS
    logits = jnp.einsum('bsd,de->bse', h, w_router).astype(jnp.float32)
    aff = jax.nn.softmax(logits, axis=-1)
    gates, idx = lax.top_k(aff.transpose(0, 2, 1), cap)
    flat = jnp.arange(B)[:, None, None] * S + idx
    h_flat = h.reshape(B * S, D)
    xin = h_flat[flat]
    a = jnp.einsum('becd,edf->becf', xin, w_gate)
    u = jnp.einsum('becd,edf->becf', xin, w_up)
    y = jnp.einsum('becf,efd->becd', jax.nn.silu(a) * u, w_down)
    y = y * gates[..., None].astype(y.dtype)
    out = jnp.zeros((B * S, D), y.dtype).at[flat.reshape(-1)].add(y.reshape(-1, D))
    return out.reshape(B, S, D)


def setup_inputs(seed: int = 0) -> dict:
    key = jax.random.key(seed)
    ks = jax.random.split(key, 16)
    f32 = jnp.float32

    def nrm(k, shape, scale):
        return jax.random.normal(k, shape, f32) * scale

    def gain(k, shape):
        return 1.0 + 0.05 * jax.random.normal(k, shape, f32)

    L = DEPTH
    return {
        'x': nrm(ks[0], (BATCH, SEQ, D_MODEL), 1.0),
        'norm1_g': gain(ks[1], (L, D_MODEL)),
        'w_in': nrm(ks[2], (L, D_MODEL, IN_COLS), D_MODEL ** -0.5),
        'dil_q_norm_g': gain(ks[3], (L, HEAD_DIM)),
        'dil_k_norm_g': gain(ks[4], (L, HEAD_DIM)),
        'na_q_norm_g': gain(ks[5], (L, HEAD_DIM)),
        'na_k_norm_g': gain(ks[6], (L, HEAD_DIM)),
        'na_rpb': nrm(ks[7], (L, NA_HEADS, 2 * NA_KH_MAX - 1, 2 * NA_KW - 1), 0.1),
        'w_dil_branch': nrm(ks[8], (L, DIL_OUT, D_MODEL), DIL_OUT ** -0.5),
        'w_na_branch': nrm(ks[9], (L, NA_WIDTH, D_MODEL), NA_WIDTH ** -0.5),
        'w_out': nrm(ks[10], (L, D_MODEL, D_MODEL), D_MODEL ** -0.5),
        'norm2_g': gain(ks[11], (L, D_MODEL)),
        'w_router': nrm(ks[12], (L, D_MODEL, N_EXPERTS), D_MODEL ** -0.5),
        'w_gate': nrm(ks[13], (L, N_EXPERTS, D_MODEL, EXPERT_FF), D_MODEL ** -0.5),
        'w_up': nrm(ks[14], (L, N_EXPERTS, D_MODEL, EXPERT_FF), D_MODEL ** -0.5),
        'w_down': nrm(ks[15], (L, N_EXPERTS, EXPERT_FF, D_MODEL), EXPERT_FF ** -0.5),
    }


def reference(x, norm1_g, w_in, dil_q_norm_g, dil_k_norm_g, na_q_norm_g, na_k_norm_g, na_rpb,
              w_dil_branch, w_na_branch, w_out, norm2_g, w_router, w_gate, w_up, w_down):
    B, S, _ = x.shape
    pos = jnp.arange(S, dtype=jnp.float32)
    for l in range(DEPTH):
        h = rms_norm(x, norm1_g[l])
        proj = jnp.einsum('bsd,dc->bsc', h, w_in[l])
        qa, ka, va, qn, kn, vn, ga, gn = jnp.split(proj, SPLIT_POINTS, axis=-1)

        qa = rotary(rms_norm(qa.reshape(B, S, DIL_HEADS, HEAD_DIM), dil_q_norm_g[l]), pos)
        ka = rotary(rms_norm(ka.reshape(B, S, DIL_HEADS, HEAD_DIM), dil_k_norm_g[l]), pos)
        va = va.reshape(B, S, DIL_HEADS, HEAD_DIM)
        outs = []
        lses = []
        for g, (window, dilation) in enumerate(DIL_PAIRS):
            hs = slice(g * DIL_HEADS_PER_GROUP, (g + 1) * DIL_HEADS_PER_GROUP)
            o_g, lse_g = dilated_group_attention(qa[:, :, hs], ka[:, :, hs], va[:, :, hs], window, dilation)
            outs.append(o_g.astype(jnp.float32))
            lses.append(lse_g)
        wts = jax.nn.softmax(jnp.stack(lses, axis=0), axis=0)
        y_a = jnp.sum(wts[..., None] * jnp.stack(outs, axis=0), axis=0).astype(x.dtype)
        y_a = jnp.einsum('bsc,cd->bsd', y_a.reshape(B, S, DIL_OUT), w_dil_branch[l])

        qn = rms_norm(qn.reshape(B, S, NA_HEADS, HEAD_DIM), na_q_norm_g[l])
        kn = rms_norm(kn.reshape(B, S, NA_HEADS, HEAD_DIM), na_k_norm_g[l])
        vn = vn.reshape(B, S, NA_HEADS, HEAD_DIM)
        y_b = neighbourhood_attention(qn, kn, vn, na_rpb[l])
        y_b = jnp.einsum('bsc,cd->bsd', y_b.reshape(B, S, NA_WIDTH), w_na_branch[l])

        merged = jax.nn.sigmoid(ga) * y_a + jax.nn.sigmoid(gn) * y_b
        x = x + jnp.einsum('bsd,de->bse', merged, w_out[l])

        h2 = rms_norm(x, norm2_g[l])
        x = x + expert_choice_ffn(h2, w_router[l], w_gate[l], w_up[l], w_down[l])
    return x
```

```cpp
#define MK_HYB 10
#define MK_PER_PHASE 0
#include <hip/hip_runtime.h>
#include <stdint.h>
#include <stdio.h>

#define LAS __attribute__((address_space(3)))
#define GAS __attribute__((address_space(1)))
typedef unsigned short bf16_t;
typedef short bf16x8 __attribute__((ext_vector_type(8)));
typedef short s16x4 __attribute__((ext_vector_type(4)));
typedef float f32x2 __attribute__((ext_vector_type(2)));
typedef float f32x4 __attribute__((ext_vector_type(4)));
typedef float f32x16 __attribute__((ext_vector_type(16)));
typedef unsigned u32x2 __attribute__((ext_vector_type(2)));
typedef unsigned u32x4 __attribute__((ext_vector_type(4)));
typedef __bf16 bf16x2_t __attribute__((ext_vector_type(2)));

constexpr int D = 1024, NB = 8, S = 4096, HD = 64, M = NB * S;
constexpr int DILH = 12, NAH = 8, GW = 64, NE = 16, CAP = 512, FF = 1024, INC = 5888;
constexpr float EPS = 1e-6f;
constexpr float LOG2E = 1.4426950408889634f;

constexpr size_t MiB = 1u << 20;
constexpr size_t WS_CTL = 0, CTL_BYTES = 1 * MiB;
constexpr size_t WS_ROPE = 1 * MiB;
constexpr size_t WS_WIN = 2 * MiB;
constexpr size_t WS_PA = WS_WIN + (size_t)INC * D * 2;
constexpr size_t WS_PB = 14 * MiB;
constexpr size_t WS_WO = 15 * MiB;
constexpr size_t WS_WGU = 17 * MiB;
constexpr size_t WS_WD = 81 * MiB;
constexpr size_t WS_AFF = 113 * MiB;
constexpr size_t WS_TOKSLOT = 115 * MiB;
constexpr size_t WS_IDX = 117 * MiB;
constexpr size_t WS_GLIST = WS_IDX + 256 * 1024;
constexpr size_t WS_HB = 118 * MiB;
constexpr size_t WS_QD = 182 * MiB, WS_KD = 230 * MiB, WS_VTD = 278 * MiB;
constexpr size_t WS_QN = 326 * MiB, WS_KN = 358 * MiB, WS_VTN = 390 * MiB;
constexpr size_t WS_H = 182 * MiB;
constexpr size_t WS_Y = 310 * MiB;
constexpr size_t WS_YA = 422 * MiB;
constexpr size_t WS_YB = 438 * MiB;
constexpr size_t WS_DLT = 438 * MiB;
constexpr size_t WS_END = 502 * MiB;
constexpr int CW_TMO = 0, CW_BAR = 4096;

constexpr int RING_BYTES = 131072;
constexpr int LDS_L_OFF = RING_BYTES;
constexpr int LDS_IDX_OFF = RING_BYTES + 2048;
constexpr int LDS_MISC_OFF = RING_BYTES + 4096;
constexpr int LDS_BYTES = 147456;

__device__ __forceinline__ unsigned pk2(float lo, float hi) { f32x2 v = {lo, hi}; return __builtin_bit_cast(unsigned, __builtin_convertvector(v, bf16x2_t)); }
__device__ __forceinline__ float bflo(unsigned w) { return __builtin_bit_cast(float, w << 16); }
__device__ __forceinline__ float bfhi(unsigned w) { return __builtin_bit_cast(float, w & 0xffff0000u); }
__device__ __forceinline__ float shx(float v, int mask, int lane) { return __builtin_bit_cast(float, __builtin_amdgcn_ds_bpermute((lane ^ mask) << 2, __builtin_bit_cast(int, v))); }
__device__ __forceinline__ int shxi(int v, int mask, int lane) { return __builtin_amdgcn_ds_bpermute((lane ^ mask) << 2, v); }
__device__ __forceinline__ float wave_sum(float v, int lane) {
#pragma unroll
    for (int o = 1; o < 64; o <<= 1) v += shx(v, o, lane);
    return v;
}
__device__ __forceinline__ float wave_max(float v, int lane) {
#pragma unroll
    for (int o = 1; o < 64; o <<= 1) v = fmaxf(v, shx(v, o, lane));
    return v;
}
__device__ __forceinline__ float sigmoidf_fast(float x) { return __builtin_amdgcn_rcpf(1.0f + __builtin_amdgcn_exp2f(-x * LOG2E)); }
__device__ __forceinline__ int fresh_lane() { int l; asm volatile("v_mbcnt_lo_u32_b32 %0, -1, 0\n\tv_mbcnt_hi_u32_b32 %0, -1, %0" : "=v"(l)); return l; }
#define LDS_WAIT() asm volatile("s_waitcnt lgkmcnt(0)" ::: "memory")
#define VM_WAIT() asm volatile("s_waitcnt vmcnt(0)" ::: "memory")

#define XB_TMO      128
#define XB_XCNT(j)  (256  + 64 * (j))
#define XB_XSUB(j)  (1280 + 64 * (j))
#define XB_XGEN(j)  (2304 + 64 * (j))
#define XB_TOP      3328
#define XB_TOPGEN   3392
#define XCD_BAR_WORDS 3456
#define XB_SPIN_CAP (1u << 18)
__device__ __forceinline__ unsigned xb_ld(unsigned* p)              { return __hip_atomic_load(p, __ATOMIC_RELAXED, __HIP_MEMORY_SCOPE_AGENT); }
__device__ __forceinline__ unsigned xb_add(unsigned* p, unsigned v) { return __hip_atomic_fetch_add(p, v, __ATOMIC_RELAXED, __HIP_MEMORY_SCOPE_AGENT); }
__device__ __forceinline__ unsigned xb_xcc_id() { return (unsigned)__builtin_amdgcn_s_getreg((3 << 11) | 20) & 0xFu; }
#define XB_SPIN(cond, bar) do { unsigned _sp = 0; while (cond) { __builtin_amdgcn_s_sleep(1); \
    if ((++_sp & 255u) == 0u) { if (xb_ld(&(bar)[XB_TMO])) break; if (_sp > XB_SPIN_CAP) { atomicAdd(&(bar)[XB_TMO], 1u); break; } } } } while (0)
struct XcdBarrier { unsigned* bar; unsigned x; volatile LAS unsigned* st; };
__device__ __forceinline__ XcdBarrier xcd_barrier_post(unsigned* bar, volatile LAS unsigned* st, const bool first) {
    XcdBarrier b; b.bar = bar; b.x = xb_xcc_id(); b.st = st;
    if (first) (void)xb_add(&bar[XB_XCNT(b.x)], 1u);
    return b;
}
__device__ __forceinline__ void xcd_barrier_complete(unsigned* bar, unsigned x, unsigned& nloc, unsigned& nx) {
    const unsigned G = gridDim.x * gridDim.y * gridDim.z;
    unsigned sum, cnt, mine, sp = 0u;
    for (;;) {
        sum = 0u; cnt = 0u; mine = 0u;
#pragma unroll
        for (unsigned j = 0; j < 16; ++j) { const unsigned c = xb_ld(&bar[XB_XCNT(j)]); sum += c; cnt += (c > 0u) ? 1u : 0u; mine = (j == x) ? c : mine; }
        if (sum == G) break;
        __builtin_amdgcn_s_sleep(1);
        if ((++sp & 255u) == 0u) { if (xb_ld(&bar[XB_TMO])) break; if (sp > XB_SPIN_CAP) { atomicAdd(&bar[XB_TMO], 1u); break; } }
    }
    nloc = mine > 0u ? mine : 1u; nx = cnt > 0u ? cnt : 1u;
}
__device__ __forceinline__ void xcd_barrier(const XcdBarrier& b, const bool first) {
    asm volatile("s_waitcnt vmcnt(0)" ::: "memory");
    __syncthreads();
    if (first) {
        unsigned* bar = b.bar;
        __builtin_amdgcn_s_waitcnt(0);
        unsigned nloc = b.st[0], nx = b.st[1];
        if (nloc == 0u) { xcd_barrier_complete(bar, b.x, nloc, nx); b.st[0] = nloc; b.st[1] = nx; }
        const unsigned old = xb_add(&bar[XB_XSUB(b.x)], 1u);
        const unsigned gen = old / nloc;
        if (old + 1u == (gen + 1u) * nloc) {
            __builtin_amdgcn_fence(__ATOMIC_RELEASE, "agent");
            asm volatile("s_waitcnt vmcnt(0)" ::: "memory");
            const unsigned og = xb_add(&bar[XB_TOP], 1u);
            const unsigned tg = og / nx;
            if (og + 1u == (tg + 1u) * nx) xb_add(&bar[XB_TOPGEN], 1u);
            else XB_SPIN(xb_ld(&bar[XB_TOPGEN]) == tg, bar);
            __builtin_amdgcn_fence(__ATOMIC_ACQUIRE, "agent");
            xb_add(&bar[XB_XGEN(b.x)], 1u);
            asm volatile("s_waitcnt vmcnt(0)" ::: "memory");
        } else {
            XB_SPIN(xb_ld(&bar[XB_XGEN(b.x)]) == gen, bar);
            __builtin_amdgcn_fence(__ATOMIC_ACQUIRE, "agent");
            asm volatile("s_waitcnt vmcnt(0)" ::: "memory");
        }
    }
    __syncthreads();
}

namespace g8 {
constexpr int BM = 256, BK = 64, HALF = 128, HTB = HALF * BK * 2, STAGE_BYTES = 8 * HTB;
__host__ __device__ __forceinline__ int lds_byte(int r, int c) { const int st = (r >> 4) * 2 + (c >> 5), rr = r & 15, cc = c & 31, ob = rr * 64 + cc * 2; return st * 1024 + (ob ^ (((ob >> 9) & 1) << 5)); }
__host__ __device__ __forceinline__ void stage_rc(int b, int& R, int& C) { const int st = b / 1024, sb = b % 1024, swz = sb ^ (((sb >> 9) & 1) << 5); R = (st >> 1) * 16 + swz / 64; C = (st & 1) * 32 + (swz % 64) / 2; }
__host__ __device__ __forceinline__ int perm32(int rho) { const int n = rho >> 4, i = rho & 15; return 8 * (i >> 2) + 4 * n + (i & 3); }

__device__ __forceinline__ bool tile_order(long L, int nM, int nN, int& pm, int& pn) {
    const int nwg = nM * nN; if (L >= nwg) return false;
    int wgid = (int)L; { const int q = nwg / 8, r = nwg % 8, xcd = wgid % 8, off = wgid / 8; wgid = (xcd < r ? xcd * (q + 1) : r * (q + 1) + (xcd - r) * q) + off; }
    const int nig = 8 * nN, gid = wgid / nig, fm = gid * 8, gsz = (nM - fm) < 8 ? (nM - fm) : 8;
    pm = fm + ((wgid % nig) % gsz); pn = (wgid % nig) / gsz; return true;
}

struct Unit {
    const char* A; const char* B;
    unsigned sA, sB;
    char* p;
    int nt, ty;
    int e0, e1, e2, e3;
};

#ifndef G8_ALIGN_EPI
#define G8_ALIGN_EPI true
#endif
template <class Epi, class Sched, bool GATHER>
__device__ __forceinline__ void gemm_phase(LAS unsigned char* lds, const Sched& S, const Epi& E, const int wid) {
    const int lane = fresh_lane();
    const int tid = wid * 64 + lane, wr = wid >> 2, wc = wid & 3, fr = lane & 15, fq = lane >> 4;
    unsigned rA[2], rB[2], c2[2];
#pragma unroll
    for (int i = 0; i < 2; ++i) { int R, C; stage_rc(tid * 16 + i * 8192, R, C); rA[i] = (unsigned)R; rB[i] = (unsigned)(Epi::PERM ? ((R & ~31) + perm32(R & 31)) : R); c2[i] = (unsigned)(C * 2);
        if constexpr (Epi::COL64) rB[i] = (unsigned)(64 * (R >> 5) + perm32(R & 31)); }
    const unsigned ldsw = (unsigned)wid * 1024u;
    const int aoff = lds_byte(wr * 64 + fr, fq * 8), boff = lds_byte(wc * 32 + fr, fq * 8);
    LAS int* idxbuf = (LAS int*)(lds + LDS_IDX_OFF);
#define G8_SA(b, h) (((b) * 2 + (h)) * HTB)
#define G8_SB(b, h) ((4 + (b) * 2 + (h)) * HTB)
#define G8_STAGE(bufoff, gbase, stride, rr) do { _Pragma("unroll") for (int _i = 0; _i < 2; ++_i) \
        __builtin_amdgcn_global_load_lds((const unsigned*)((const char*)(gbase) + ((rr)[_i] * (stride) + c2[_i])), (LAS unsigned*)(lds + (bufoff) + ldsw + _i * 8192), 16, 0, 0); } while (0)
#define G8_STAGE_G(bufoff, gbase, offs) do { _Pragma("unroll") for (int _i = 0; _i < 2; ++_i) \
        __builtin_amdgcn_global_load_lds((const unsigned*)((const char*)(gbase) + (offs)[_i]), (LAS unsigned*)(lds + (bufoff) + ldsw + _i * 8192), 16, 0, 0); } while (0)
#define G8_LDA(dst, b, h) do { _Pragma("unroll") for (int m = 0; m < 4; ++m) _Pragma("unroll") for (int k = 0; k < 2; ++k) dst[m][k] = *(const LAS bf16x8*)(lds + G8_SA(b, h) + aoff + m * 2048 + k * 1024); } while (0)
#define G8_LDB(dst, b, h) do { _Pragma("unroll") for (int n = 0; n < 2; ++n) _Pragma("unroll") for (int k = 0; k < 2; ++k) dst[n][k] = *(const LAS bf16x8*)(lds + G8_SB(b, h) + boff + n * 2048 + k * 1024); } while (0)
#define G8_MMA(ai, bj, At, Bt) do { __builtin_amdgcn_s_setprio(1); _Pragma("unroll") for (int m = 0; m < 4; ++m) _Pragma("unroll") for (int n = 0; n < 2; ++n) _Pragma("unroll") for (int k = 0; k < 2; ++k) \
        acc[ai][bj][m][n] = __builtin_amdgcn_mfma_f32_16x16x32_bf16(Bt[n][k], At[m][k], acc[ai][bj][m][n], 0, 0, 0); __builtin_amdgcn_s_setprio(0); } while (0)
#define G8_WAIT_V(n) asm volatile("s_waitcnt vmcnt(" #n ")" ::: "memory")
#define G8_WAIT_L(n) asm volatile("s_waitcnt lgkmcnt(" #n ")" ::: "memory")
#define G8_BAR __builtin_amdgcn_s_barrier()
#define G8_SCHED __builtin_amdgcn_sched_barrier(0)
#define G8_STA(bufoff, u, go, h, koff) do { if constexpr (GATHER) { G8_STAGE_G(bufoff, (u).A + (koff), (go)[h]); } else { G8_STAGE(bufoff, (u).A + (size_t)(h) * HALF * (u).sA + (koff), (u).sA, rA); } } while (0)
#define G8_STB(bufoff, u, h, koff) G8_STAGE(bufoff, (u).B + (size_t)(h) * (Epi::COL64 ? 32 : HALF) * (u).sB + (koff), (u).sB, rB)
    Unit cur, nxt; int ui = 0;
    if (!S.next(0, cur)) return;
    f32x4 acc[2][2][4][2];
#pragma unroll
    for (int a = 0; a < 2; ++a)
#pragma unroll
        for (int b = 0; b < 2; ++b)
#pragma unroll
            for (int m = 0; m < 4; ++m)
#pragma unroll
                for (int n = 0; n < 2; ++n) acc[a][b][m][n] = (f32x4){0.f, 0.f, 0.f, 0.f};
    bf16x8 At[4][2], B0[2][2], B1[2][2];
    unsigned gcur[2][2], gnxt[2][2];
    if constexpr (GATHER) {
        if (wid == 0) __builtin_amdgcn_global_load_lds((const unsigned*)((const int*)cur.p + lane * 4), (LAS unsigned*)(idxbuf), 16, 0, 0);
        G8_WAIT_V(0); G8_BAR;
#pragma unroll
        for (int h = 0; h < 2; ++h)
#pragma unroll
            for (int i = 0; i < 2; ++i) gcur[h][i] = (unsigned)idxbuf[h * HALF + (int)rA[i]] * cur.sA + c2[i];
        G8_WAIT_L(0);
    }
#define G8_KOFF(u, t) ((size_t)((t) * 128))
    { const size_t k0 = G8_KOFF(cur, 0); G8_STB(G8_SB(0, 0), cur, 0, k0); G8_STB(G8_SB(0, 1), cur, 1, k0); G8_STA(G8_SA(0, 0), cur, gcur, 0, k0); G8_STA(G8_SA(0, 1), cur, gcur, 1, k0); }
    if (wr == 1) G8_BAR;
    G8_WAIT_V(2); G8_BAR;
    { const size_t k1 = G8_KOFF(cur, 1); G8_STB(G8_SB(1, 0), cur, 0, k1); G8_STA(G8_SA(1, 0), cur, gcur, 0, k1); G8_STB(G8_SB(1, 1), cur, 1, k1); }
    G8_WAIT_V(6); G8_BAR;
    for (;;) {
        const bool has_next = S.next(ui + 1, nxt);
        if (!has_next) nxt = cur;
        if constexpr (GATHER) {
            if (has_next && wid == 0) __builtin_amdgcn_global_load_lds((const unsigned*)((const int*)nxt.p + lane * 4), (LAS unsigned*)(idxbuf + ((ui + 1) & 1) * 256), 16, 0, 0);
        }
        const int nt = cur.nt;
        for (int t = 0; t < nt; t += 2) {
            const bool last = (t == nt - 2);
            const size_t k1 = G8_KOFF(cur, t + 1);
            const size_t k2 = last ? G8_KOFF(nxt, 0) : G8_KOFF(cur, t + 2), k3 = last ? G8_KOFF(nxt, 1) : G8_KOFF(cur, t + 3);
            if constexpr (GATHER) {
                if (last) {
                    if (has_next) {
#pragma unroll
                        for (int h = 0; h < 2; ++h)
#pragma unroll
                            for (int i = 0; i < 2; ++i) gnxt[h][i] = (unsigned)idxbuf[((ui + 1) & 1) * 256 + h * HALF + (int)rA[i]] * nxt.sA + c2[i];
                    } else {
#pragma unroll
                        for (int h = 0; h < 2; ++h)
#pragma unroll
                            for (int i = 0; i < 2; ++i) gnxt[h][i] = gcur[h][i];
                    }
                }
            }
            G8_LDB(B0, 0, 0); G8_LDB(B1, 0, 1); G8_SCHED; G8_LDA(At, 0, 0); G8_STA(G8_SA(1, 1), cur, gcur, 1, k1);
            G8_WAIT_V(8); G8_WAIT_L(0); G8_BAR; G8_MMA(0, 0, At, B0); G8_MMA(0, 1, At, B1); G8_BAR; G8_SCHED;
            G8_LDA(At, 0, 1);
            if (last) { G8_STB(G8_SB(0, 0), nxt, 0, k2); G8_STB(G8_SB(0, 1), nxt, 1, k2); G8_STA(G8_SA(0, 0), nxt, gnxt, 0, k2); }
            else      { G8_STB(G8_SB(0, 0), cur, 0, k2); G8_STB(G8_SB(0, 1), cur, 1, k2); G8_STA(G8_SA(0, 0), cur, gcur, 0, k2); }
            G8_WAIT_V(8); G8_WAIT_L(0); G8_BAR; G8_MMA(1, 0, At, B0); G8_MMA(1, 1, At, B1); G8_BAR; G8_SCHED;
            G8_LDB(B0, 1, 0); G8_LDB(B1, 1, 1); G8_SCHED; G8_LDA(At, 1, 0);
            if (last) { G8_STA(G8_SA(0, 1), nxt, gnxt, 1, k2); } else { G8_STA(G8_SA(0, 1), cur, gcur, 1, k2); }
            G8_WAIT_V(8); G8_WAIT_L(0); G8_BAR; G8_MMA(0, 0, At, B0); G8_MMA(0, 1, At, B1); G8_BAR; G8_SCHED;
            G8_LDA(At, 1, 1);
            if (last) { G8_STB(G8_SB(1, 0), nxt, 0, k3); G8_STB(G8_SB(1, 1), nxt, 1, k3); G8_STA(G8_SA(1, 0), nxt, gnxt, 0, k3); }
            else      { G8_STB(G8_SB(1, 0), cur, 0, k3); G8_STB(G8_SB(1, 1), cur, 1, k3); G8_STA(G8_SA(1, 0), cur, gcur, 0, k3); }
            G8_WAIT_V(8); G8_WAIT_L(0); G8_BAR; G8_MMA(1, 0, At, B0); G8_MMA(1, 1, At, B1); G8_BAR; G8_SCHED;
        }
        if constexpr (G8_ALIGN_EPI) { if (wr == 0) G8_BAR; }
        const bool keep = E(acc, cur, wr, wc, fr, fq);
        if (!has_next) break;
        if (!keep) {
#pragma unroll
        for (int a = 0; a < 2; ++a)
#pragma unroll
            for (int b = 0; b < 2; ++b)
#pragma unroll
                for (int m = 0; m < 4; ++m)
#pragma unroll
                    for (int n = 0; n < 2; ++n) acc[a][b][m][n] = (f32x4){0.f, 0.f, 0.f, 0.f};
        }
        cur = nxt; ++ui;
        if constexpr (GATHER) {
#pragma unroll
            for (int h = 0; h < 2; ++h)
#pragma unroll
                for (int i = 0; i < 2; ++i) gcur[h][i] = gnxt[h][i];
        }
        if constexpr (G8_ALIGN_EPI) { if (wr == 1) G8_BAR; }
    }
    G8_WAIT_V(0);
    if constexpr (!G8_ALIGN_EPI) { if (wr == 0) G8_BAR; }
    G8_BAR;
#undef G8_SA
#undef G8_SB
#undef G8_STAGE
#undef G8_STAGE_G
#undef G8_LDA
#undef G8_LDB
#undef G8_MMA
#undef G8_WAIT_V
#undef G8_WAIT_L
#undef G8_BAR
#undef G8_SCHED
#undef G8_STA
#undef G8_STB
#undef G8_KOFF
}
}
struct Frame {
    LAS unsigned char* lds;
    int tid, lane, wave, vcu, G;
    float* out; unsigned char* ws;
};
__device__ __forceinline__ void phase_ids(Frame& F) { const int l = fresh_lane(); F.lane = l; F.tid = F.wave * 64 + l; }
enum { IN_X = 0, IN_NORM1 = 1, IN_WIN = 2, IN_DQG = 3, IN_DKG = 4, IN_NQG = 5, IN_NKG = 6, IN_RPB = 7, IN_WDIL = 8, IN_WNA = 9, IN_WOUT = 10, IN_NORM2 = 11, IN_WROUTER = 12, IN_WGATE = 13, IN_WUP = 14, IN_WDOWN = 15 };
__device__ __forceinline__ const float* inptr(int k) {
    int off = k * 8; asm volatile("" : "+s"(off));
    const __attribute__((address_space(4))) char* ka = (const __attribute__((address_space(4))) char*)__builtin_amdgcn_kernarg_segment_ptr();
    return *(const float* const __attribute__((address_space(4)))*)(ka + off);
}
__device__ __forceinline__ int dil_of(int g) { return g == 0 ? 1 : (g == 1 ? 4 : 16); }

constexpr int KT = 16;
struct SchedQKd {
    const char* hb; const char* win; char* qd; char* kd; int G, c;
    __device__ __forceinline__ bool next(int i, g8::Unit& u) const { return at((long)i * G + c, u); }
    __device__ __forceinline__ bool at(long Lu, g8::Unit& u) const {
        int pm, pn; if (!g8::tile_order(Lu, 128, 6, pm, pn)) return false;
        const int b = pm >> 4, j = pm & 15, which = pn / 3, g = pn % 3, d = dil_of(g), L = S / d, pos0 = j * 256, r = pos0 / L, u0 = pos0 % L;
        u.A = hb + ((size_t)b * S + (size_t)u0 * d + r) * (D * 2); u.sA = (unsigned)(d * D * 2);
        u.B = win + (size_t)pn * 256 * (D * 2); u.sB = D * 2;
        u.p = (which ? kd : qd) + ((size_t)(b * DILH + g * 4) * S + pos0) * (HD * 2);
        u.e0 = u0; u.e1 = d; u.e2 = r; u.e3 = which; u.nt = KT; u.ty = 0;
        return true;
    }
};
struct SchedQKn {
    const char* hb; const char* win; char* qn; char* kn; int G, c;
    __device__ __forceinline__ bool next(int i, g8::Unit& u) const { return at((long)i * G + c, u); }
    __device__ __forceinline__ bool at(long L, g8::Unit& u) const {
        int pm, pn; if (!g8::tile_order(L, 128, 4, pm, pn)) return false;
        const int b = pm >> 4, j = pm & 15, which = pn >> 1, hh = pn & 1;
        u.A = hb + (size_t)pm * 256 * (D * 2); u.sA = D * 2;
        u.B = win + (size_t)(9 + pn) * 256 * (D * 2); u.sB = D * 2;
        u.p = (which ? kn : qn) + ((size_t)(b * NAH + hh * 4) * S + j * 256) * (HD * 2);
        u.e0 = j * 256; u.e1 = 1; u.e2 = 0; u.e3 = which; u.nt = KT; u.ty = 1;
        return true;
    }
};
struct SchedVt {
    const char* hb; const char* win; char* vtd; char* vtn; int G, c;
    __device__ __forceinline__ bool next(int i, g8::Unit& u) const { return at((long)i * G + c, u); }
    __device__ __forceinline__ bool at(long Lu, g8::Unit& u) const {
        int pm, pn; if (!g8::tile_order(Lu, 5, 128, pm, pn)) return false;
        const int b = pn >> 4, j = pn & 15, pos0 = j * 256;
        const int d = pm < 3 ? dil_of(pm) : 1, L = S / d, r = pos0 / L, u0 = pos0 % L;
        u.A = win + (size_t)(pm < 3 ? 6 + pm : 10 + pm) * 256 * (D * 2); u.sA = D * 2;
        u.B = hb + ((size_t)b * S + (size_t)u0 * d + r) * (D * 2); u.sB = (unsigned)(d * D * 2);
        u.p = (pm < 3 ? vtd + ((size_t)(b * DILH + pm * 4) * HD * S + (size_t)pos0 * HD) * 2 : vtn + ((size_t)(b * NAH + (pm - 3) * 4) * HD * S + (size_t)pos0 * HD) * 2);
        u.e0 = 0; u.e1 = 0; u.e2 = 0; u.e3 = pm < 3 ? 0 : 1; u.nt = KT; u.ty = 3;
        return true;
    }
};
struct SchedDense {
    const char* A; const char* B; unsigned lda, ldb; int nM, nN, G, c, kt;
    __device__ __forceinline__ bool next(int i, g8::Unit& u) const {
        int pm, pn; if (!g8::tile_order((long)i * G + c, nM, nN, pm, pn)) return false;
        u.A = A + (size_t)pm * 256 * lda; u.sA = lda; u.B = B + (size_t)pn * 256 * ldb; u.sB = ldb;
        u.p = nullptr; u.e0 = pm * 256; u.e1 = pn * 256; u.e2 = 0; u.e3 = 0; u.nt = kt; u.ty = 0;
        return true;
    }
};
struct SchedGU {
    const char* h2; const char* wgu; const int* idx; int G, c;
    __device__ __forceinline__ bool next(int i, g8::Unit& u) const {
        int pm, pn; if (!g8::tile_order((long)i * G + c, 256, 8, pm, pn)) return false;
        const int e = pm >> 4, b = (pm >> 1) & 7;
        u.A = h2 + (size_t)b * S * (D * 2); u.sA = D * 2; u.p = (char*)(idx + (size_t)pm * 256);
        u.B = wgu + ((size_t)e * 2048 + (size_t)pn * 256) * (D * 2); u.sB = D * 2;
        u.e0 = pm * 256; u.e1 = pn * 128; u.e2 = 0; u.e3 = 0; u.nt = KT; u.ty = 0;
        return true;
    }
};
struct SchedDown {
    const char* hbuf; const char* wd; int G, c;
    __device__ __forceinline__ bool next(int i, g8::Unit& u) const {
        const long Lf = (long)i * G + c; if (Lf >= 1024) return false;
        int pm, pn; if (!g8::tile_order(1023 - Lf, 256, 4, pm, pn)) return false;
        const int e = pm >> 4;
        u.A = hbuf + (size_t)pm * 256 * (FF * 2); u.sA = FF * 2;
        u.B = wd + ((size_t)e * 1024 + (size_t)pn * 256) * (FF * 2); u.sB = FF * 2;
        u.p = nullptr; u.e0 = pm * 256; u.e1 = pn * 256; u.e2 = 0; u.e3 = 0; u.nt = KT; u.ty = 0;
        return true;
    }
};
struct SchedGates {
    const char* hb; const char* win; int G, c;
    __device__ __forceinline__ bool at(long L, g8::Unit& u) const {
        int pm, pn; if (!g8::tile_order(L, 128, 8, pm, pn)) return false;
        u.A = hb + (size_t)pm * 256 * (D * 2); u.sA = D * 2; u.B = win + (size_t)(15 + pn) * 256 * (D * 2); u.sB = D * 2;
        u.p = nullptr; u.e0 = pm * 256; u.e1 = pn * 128; u.e2 = 0; u.e3 = 0; u.nt = KT; u.ty = 2;
        return true;
    }
};
struct SchedP1 {
    SchedQKd a; SchedQKn b; SchedGates g; SchedVt v; int G, c;
    __device__ __forceinline__ bool next(int i, g8::Unit& u) const {
        long L = (long)i * G + c;
        if (L < 768) return a.at(L, u); L -= 768;
        if (L < 512) return b.at(L, u); L -= 512;
        if (L < 1024) return g.at(L, u); L -= 1024;
        return v.at(L, u);
    }
};
struct SchedP3 {
    const char* ya; const char* pa; const char* yb; const char* pb; int G, c;
    __device__ __forceinline__ bool next(int i, g8::Unit& u) const {
        int pm, pn; if (!g8::tile_order((long)(i >> 1) * G + c, 128, 4, pm, pn)) return false;
        if (i & 1) { u.A = yb + (size_t)pm * 256 * 1024; u.sA = 1024; u.B = pb + (size_t)pn * 256 * 1024; u.sB = 1024; u.nt = 8; u.ty = 1; }
        else       { u.A = ya + (size_t)pm * 256 * 512;  u.sA = 512;  u.B = pa + (size_t)pn * 256 * 512;  u.sB = 512;  u.nt = 4; u.ty = 0; }
        u.p = nullptr; u.e0 = pm * 256; u.e1 = pn * 256; u.e2 = 0; u.e3 = 0;
        return true;
    }
};

typedef f32x4 (&AccRef)[2][2][4][2];

template <bool ROT> struct EpiQK {
    static constexpr bool PERM = true, COL64 = false;
    const float* gq; const float* gk; const f32x2* rope; float qscale;
    __device__ __forceinline__ bool operator()(AccRef acc, const g8::Unit& u, int wr, int wc, int fr, int fq) const { run(acc, u, wr, wc, fr, fq); return false; }
    __device__ __forceinline__ void run(AccRef acc, const g8::Unit& u, int wr, int wc, int fr, int fq) const {
        asm volatile("" : "+v"(fq), "+v"(fr));
        const float* g = u.e3 ? gk : gq; const float sc = u.e3 ? 1.0f : qscale;
        f32x4 rp[2][4];
#define EQK_LOAD(grp, buf) do { const int _R = ((grp) >> 2) * 128 + wr * 64 + ((grp) & 3) * 16 + fr; const f32x4* _p = (const f32x4*)(rope + (size_t)((u.e0 + _R) * u.e1 + u.e2) * 32 + 8 * fq); \
        rp[buf][0] = _p[0]; rp[buf][1] = _p[1]; rp[buf][2] = _p[2]; rp[buf][3] = _p[3]; } while (0)
        if (ROT) { EQK_LOAD(0, 0); }
        float gl[2][8];
#pragma unroll
        for (int bj = 0; bj < 2; ++bj) { const f32x4 a = *(const f32x4*)(g + 32 * bj + 8 * fq), b = *(const f32x4*)(g + 32 * bj + 8 * fq + 4);
            gl[bj][0] = a[0] * sc; gl[bj][1] = a[1] * sc; gl[bj][2] = a[2] * sc; gl[bj][3] = a[3] * sc; gl[bj][4] = b[0] * sc; gl[bj][5] = b[1] * sc; gl[bj][6] = b[2] * sc; gl[bj][7] = b[3] * sc; }
        char* ob = u.p + (size_t)wc * S * (HD * 2);
        const int ln = fq * 16 + fr;
#pragma unroll
        for (int ai = 0; ai < 2; ++ai) {
            float rs[4];
#pragma unroll
            for (int m = 0; m < 4; ++m) { float ss = 0.f;
#pragma unroll
                for (int bj = 0; bj < 2; ++bj)
#pragma unroll
                    for (int n = 0; n < 2; ++n)
#pragma unroll
                        for (int k = 0; k < 4; ++k) { const float t = acc[ai][bj][m][n][k]; ss += t * t; }
                rs[m] = ss; }
#pragma unroll
            for (int m = 0; m < 4; ++m) rs[m] += shx(rs[m], 16, ln);
#pragma unroll
            for (int m = 0; m < 4; ++m) rs[m] += shx(rs[m], 32, ln);
#pragma unroll
            for (int m = 0; m < 4; ++m) rs[m] = rsqrtf(rs[m] * (1.0f / 64.0f) + EPS);
#pragma unroll
            for (int m = 0; m < 4; ++m) {
                const int grp = ai * 4 + m;
                if (ROT) { if (grp + 1 < 8) EQK_LOAD(grp + 1, (grp + 1) & 1); __builtin_amdgcn_sched_barrier(0); }
                const int R = ai * 128 + wr * 64 + m * 16 + fr;
                float v[2][8];
#pragma unroll
                for (int bj = 0; bj < 2; ++bj)
#pragma unroll
                    for (int n = 0; n < 2; ++n)
#pragma unroll
                        for (int k = 0; k < 4; ++k) v[bj][4 * n + k] = acc[ai][bj][m][n][k] * rs[m] * gl[bj][4 * n + k];
                float o[2][8];
                if (ROT) {
                    const f32x4 c0 = rp[grp & 1][0], c1 = rp[grp & 1][1], c2 = rp[grp & 1][2], c3 = rp[grp & 1][3];
                    const float cs[8] = {c0[0], c0[2], c1[0], c1[2], c2[0], c2[2], c3[0], c3[2]}, sn[8] = {c0[1], c0[3], c1[1], c1[3], c2[1], c2[3], c3[1], c3[3]};
#pragma unroll
                    for (int k = 0; k < 8; ++k) { o[0][k] = v[0][k] * cs[k] - v[1][k] * sn[k]; o[1][k] = v[1][k] * cs[k] + v[0][k] * sn[k]; }
                } else {
#pragma unroll
                    for (int k = 0; k < 8; ++k) { o[0][k] = v[0][k]; o[1][k] = v[1][k]; }
                }
#pragma unroll
                for (int bj = 0; bj < 2; ++bj) { u32x4 w; w.x = pk2(o[bj][0], o[bj][1]); w.y = pk2(o[bj][2], o[bj][3]); w.z = pk2(o[bj][4], o[bj][5]); w.w = pk2(o[bj][6], o[bj][7]);
                    char* dst = ROT ? ob + (size_t)(R >> 5) * 4096 + (2 * bj + (fq >> 1)) * 1024 + (fq & 1) * 512 + (R & 31) * 16
                                    : ob + (size_t)(R >> 3) * 1024 + bj * 512 + fq * 128 + (R & 7) * 16;
                    *(u32x4*)dst = w; }
                if (ROT) __builtin_amdgcn_sched_barrier(0);
            }
        }
#undef EQK_LOAD
    }
};
struct EpiVt {
    static constexpr bool PERM = true, COL64 = false;
    __device__ __forceinline__ bool operator()(AccRef acc, const g8::Unit& u, int wr, int wc, int fr, int fq) const { run(acc, u, wr, wc, fr, fq); return false; }
    __device__ __forceinline__ void run(AccRef acc, const g8::Unit& u, int wr, int wc, int fr, int fq) const {
#pragma unroll
        for (int ai = 0; ai < 2; ++ai)
#pragma unroll
            for (int m = 0; m < 4; ++m) { const int dim = 16 * m + fr; char* hp = u.p + (size_t)(2 * ai + wr) * (S * HD * 2);
#pragma unroll
                for (int bj = 0; bj < 2; ++bj) { const f32x4 v0 = acc[ai][bj][m][0], v1 = acc[ai][bj][m][1];
                    u32x4 w; w.x = pk2(v0[0], v0[1]); w.y = pk2(v0[2], v0[3]); w.z = pk2(v1[0], v1[1]); w.w = pk2(v1[2], v1[3]);
                    if (u.e3) { *(u32x4*)(hp + (size_t)(16 * bj + 4 * wc + fq) * 1024 + dim * 16) = w; }
                    else { char* q = hp + (size_t)(4 * bj + wc) * 4096 + ((dim >> 5) * 2 + (fq >> 1)) * 1024 + (dim & 31) * 16 + (fq & 1) * 8;
                        *(u32x2*)q = (u32x2){w.x, w.y}; *(u32x2*)(q + 512) = (u32x2){w.z, w.w}; } } }
    }
};
template <int ACT> struct EpiBf16 {
    static constexpr bool PERM = true, COL64 = false;
    bf16_t* O; int ldc;
    __device__ __forceinline__ bool operator()(AccRef acc, const g8::Unit& u, int wr, int wc, int fr, int fq) const { run(acc, u, wr, wc, fr, fq); return false; }
    __device__ __forceinline__ void run(AccRef acc, const g8::Unit& u, int wr, int wc, int fr, int fq) const {
#pragma unroll
        for (int ai = 0; ai < 2; ++ai)
#pragma unroll
            for (int m = 0; m < 4; ++m) { bf16_t* rowp = O + (size_t)(u.e0 + ai * 128 + wr * 64 + m * 16 + fr) * ldc + u.e1 + wc * 32 + 8 * fq;
#pragma unroll
                for (int bj = 0; bj < 2; ++bj) { f32x4 v0 = acc[ai][bj][m][0], v1 = acc[ai][bj][m][1];
                    if (ACT == 1) {
#pragma unroll
                        for (int k = 0; k < 4; ++k) { v0[k] = sigmoidf_fast(v0[k]); v1[k] = sigmoidf_fast(v1[k]); } }
                    u32x4 w; w.x = pk2(v0[0], v0[1]); w.y = pk2(v0[2], v0[3]); w.z = pk2(v1[0], v1[1]); w.w = pk2(v1[2], v1[3]);
                    *(u32x4*)(rowp + bj * 128) = w; } }
    }
};
template <bool ADD> struct EpiGated {
    static constexpr bool PERM = true, COL64 = false;
    bf16_t* O; const bf16_t* gates; int gcol0;
    __device__ __forceinline__ bool operator()(AccRef acc, const g8::Unit& u, int wr, int wc, int fr, int fq) const { run(acc, u, wr, wc, fr, fq); return false; }
    __device__ __forceinline__ void run(AccRef acc, const g8::Unit& u, int wr, int wc, int fr, int fq) const {
        const int col = u.e1 + wc * 32 + 8 * fq;
        u32x4 gw[2][2], ow[2][2];
#define EG_LOAD(grp, buf) do { const size_t _row = (size_t)(u.e0 + ((grp) >> 2) * 128 + wr * 64 + ((grp) & 3) * 16 + fr); _Pragma("unroll") for (int bj = 0; bj < 2; ++bj) { \
        gw[buf][bj] = *(const u32x4*)(gates + _row * 2048 + gcol0 + col + bj * 128); if (ADD) ow[buf][bj] = *(const u32x4*)(O + _row * D + col + bj * 128); } } while (0)
        EG_LOAD(0, 0);
#pragma unroll
        for (int grp = 0; grp < 8; ++grp) {
            const int ai = grp >> 2, m = grp & 3;
            if (grp + 1 < 8) EG_LOAD(grp + 1, (grp + 1) & 1);
            __builtin_amdgcn_sched_barrier(0);
            const size_t row = (size_t)(u.e0 + ai * 128 + wr * 64 + m * 16 + fr);
#pragma unroll
            for (int bj = 0; bj < 2; ++bj) { const f32x4 v0 = acc[ai][bj][m][0], v1 = acc[ai][bj][m][1]; const u32x4 g = gw[grp & 1][bj];
                float r[8] = {v0[0] * bflo(g.x), v0[1] * bfhi(g.x), v0[2] * bflo(g.y), v0[3] * bfhi(g.y), v1[0] * bflo(g.z), v1[1] * bfhi(g.z), v1[2] * bflo(g.w), v1[3] * bfhi(g.w)};
                if (ADD) { const u32x4 o = ow[grp & 1][bj]; r[0] += bflo(o.x); r[1] += bfhi(o.x); r[2] += bflo(o.y); r[3] += bfhi(o.y); r[4] += bflo(o.z); r[5] += bfhi(o.z); r[6] += bflo(o.w); r[7] += bfhi(o.w); }
                u32x4 w; w.x = pk2(r[0], r[1]); w.y = pk2(r[2], r[3]); w.z = pk2(r[4], r[5]); w.w = pk2(r[6], r[7]);
                *(u32x4*)(O + row * D + col + bj * 128) = w; }
            __builtin_amdgcn_sched_barrier(0);
        }
#undef EG_LOAD
    }
};
struct EpiGates {
    static constexpr bool PERM = true, COL64 = false;
    bf16_t* Gt;
    __device__ __forceinline__ void run(AccRef acc, const g8::Unit& u, int wr, int wc, int fr, int fq) const {
#pragma unroll
        for (int ai = 0; ai < 2; ++ai)
#pragma unroll
            for (int m = 0; m < 4; ++m) { bf16_t* rowp = Gt + (size_t)(u.e0 + ai * 128 + wr * 64 + m * 16 + fr) * 2048 + u.e1 + wc * 32 + 8 * fq;
                float rho[8], sn[8];
#pragma unroll
                for (int n = 0; n < 2; ++n)
#pragma unroll
                    for (int k = 0; k < 4; ++k) { const float ea = __builtin_amdgcn_exp2f(-acc[ai][0][m][n][k] * LOG2E), en = __builtin_amdgcn_exp2f(-acc[ai][1][m][n][k] * LOG2E);
                        sn[4 * n + k] = __builtin_amdgcn_rcpf(1.0f + en); rho[4 * n + k] = (1.0f + en) * __builtin_amdgcn_rcpf(1.0f + ea); }
                u32x4 w; w.x = pk2(rho[0], rho[1]); w.y = pk2(rho[2], rho[3]); w.z = pk2(rho[4], rho[5]); w.w = pk2(rho[6], rho[7]); *(u32x4*)rowp = w;
                w.x = pk2(sn[0], sn[1]); w.y = pk2(sn[2], sn[3]); w.z = pk2(sn[4], sn[5]); w.w = pk2(sn[6], sn[7]); *(u32x4*)(rowp + 1024) = w; }
    }
};
struct EpiP1 {
    static constexpr bool PERM = true, COL64 = false;
    EpiQK<true> qkd; EpiQK<false> qkn; EpiGates gt; EpiVt vt; int skipmask;
    __device__ __forceinline__ bool operator()(AccRef acc, const g8::Unit& u, int wr, int wc, int fr, int fq) const {
        if ((skipmask >> u.ty) & 1) return false;
        if (u.ty == 0) qkd.run(acc, u, wr, wc, fr, fq);
        else if (u.ty == 1) qkn.run(acc, u, wr, wc, fr, fq);
        else if (u.ty == 2) gt.run(acc, u, wr, wc, fr, fq);
        else vt.run(acc, u, wr, wc, fr, fq);
        return false;
    }
};
struct EpiP3 {
    static constexpr bool PERM = true, COL64 = false;
    bf16_t* O; const bf16_t* Gt;
    __device__ __forceinline__ bool operator()(AccRef acc, const g8::Unit& u, int wr, int wc, int fr, int fq) const {
        const int col = u.e1 + wc * 32 + 8 * fq; const int gc = (u.ty ? 1024 : 0) + col;
        u32x4 gw[2][2];
#define EP3_LOAD(grp, buf) do { const size_t _row = (size_t)(u.e0 + ((grp) >> 2) * 128 + wr * 64 + ((grp) & 3) * 16 + fr); _Pragma("unroll") for (int bj = 0; bj < 2; ++bj) gw[buf][bj] = *(const u32x4*)(Gt + _row * 2048 + gc + bj * 128); } while (0)
        EP3_LOAD(0, 0);
#pragma unroll
        for (int grp = 0; grp < 8; ++grp) {
            const int ai = grp >> 2, m = grp & 3;
            if (grp + 1 < 8) EP3_LOAD(grp + 1, (grp + 1) & 1);
            __builtin_amdgcn_sched_barrier(0);
            const size_t row = (size_t)(u.e0 + ai * 128 + wr * 64 + m * 16 + fr);
#pragma unroll
            for (int bj = 0; bj < 2; ++bj) { const u32x4 g = gw[grp & 1][bj];
                const f32x4 s0 = {bflo(g.x), bfhi(g.x), bflo(g.y), bfhi(g.y)}, s1 = {bflo(g.z), bfhi(g.z), bflo(g.w), bfhi(g.w)};
                const f32x4 v0 = acc[ai][bj][m][0] * s0, v1 = acc[ai][bj][m][1] * s1;
                if (u.ty) { u32x4 w; w.x = pk2(v0[0], v0[1]); w.y = pk2(v0[2], v0[3]); w.z = pk2(v1[0], v1[1]); w.w = pk2(v1[2], v1[3]); *(u32x4*)(O + row * D + col + bj * 128) = w; }
                else { acc[ai][bj][m][0] = v0; acc[ai][bj][m][1] = v1; } }
            __builtin_amdgcn_sched_barrier(0);
        }
#undef EP3_LOAD
        return u.ty == 0;
    }
};
struct EpiResid {
    static constexpr bool PERM = false, COL64 = false;
    const float* base; float* out;
    __device__ __forceinline__ bool operator()(AccRef acc, const g8::Unit& u, int wr, int wc, int fr, int fq) const { run(acc, u, wr, wc, fr, fq); return false; }
    __device__ __forceinline__ void run(AccRef acc, const g8::Unit& u, int wr, int wc, int fr, int fq) const {
        const int col = u.e1 + wc * 32 + 4 * fq;
        f32x4 bs[3][2][2];
#define ER_LOAD(grp, buf) do { const size_t _off = (size_t)(u.e0 + ((grp) >> 2) * 128 + wr * 64 + ((grp) & 3) * 16 + fr) * D + col; _Pragma("unroll") for (int bj = 0; bj < 2; ++bj) _Pragma("unroll") for (int n = 0; n < 2; ++n) \
        bs[buf][bj][n] = *(const f32x4*)(base + _off + bj * 128 + n * 16); } while (0)
        ER_LOAD(0, 0); ER_LOAD(1, 1);
#pragma unroll
        for (int grp = 0; grp < 8; ++grp) {
            const int ai = grp >> 2, m = grp & 3;
            if (grp + 2 < 8) ER_LOAD(grp + 2, (grp + 2) % 3);
            __builtin_amdgcn_sched_barrier(0);
            const size_t off = (size_t)(u.e0 + ai * 128 + wr * 64 + m * 16 + fr) * D + col;
#pragma unroll
            for (int bj = 0; bj < 2; ++bj)
#pragma unroll
                for (int n = 0; n < 2; ++n) *(f32x4*)(out + off + bj * 128 + n * 16) = bs[grp % 3][bj][n] + acc[ai][bj][m][n];
            __builtin_amdgcn_sched_barrier(0);
        }
#undef ER_LOAD
    }
};
struct EpiSwiGLU {
    static constexpr bool PERM = true, COL64 = false;
    bf16_t* H; int skip;
    __device__ __forceinline__ bool operator()(AccRef acc, const g8::Unit& u, int wr, int wc, int fr, int fq) const { run(acc, u, wr, wc, fr, fq); return false; }
    __device__ __forceinline__ void run(AccRef acc, const g8::Unit& u, int wr, int wc, int fr, int fq) const {
        if (skip) return;
#pragma unroll
        for (int ai = 0; ai < 2; ++ai)
#pragma unroll
            for (int m = 0; m < 4; ++m) { bf16_t* rowp = H + (size_t)(u.e0 + ai * 128 + wr * 64 + m * 16 + fr) * FF + u.e1 + wc * 32 + 8 * fq;
                float r[8];
#pragma unroll
                for (int n = 0; n < 2; ++n)
#pragma unroll
                    for (int k = 0; k < 4; ++k) { const float a = acc[ai][0][m][n][k], b = acc[ai][1][m][n][k]; r[4 * n + k] = a * sigmoidf_fast(a) * b; }
                u32x4 w; w.x = pk2(r[0], r[1]); w.y = pk2(r[2], r[3]); w.z = pk2(r[4], r[5]); w.w = pk2(r[6], r[7]);
                *(u32x4*)rowp = w; }
    }
};
__device__ __forceinline__ void p0_transpose_item(const float* W, int K, int N, bf16_t* WT, int k0, int n0s, int n0d, LAS float* scr, int lane) {
#pragma unroll 8
    for (int i = 0; i < 32; ++i) { const int kk = 2 * i + (lane >> 5); scr[kk * 33 + (lane & 31)] = W[(size_t)(k0 + kk) * N + n0s + (lane & 31)]; }
    LDS_WAIT(); asm volatile("" ::: "memory");
    const int c = lane & 7;
#pragma unroll
    for (int j = 0; j < 4; ++j) { const int n = (lane >> 3) + 8 * j; const LAS float* s = scr + (8 * c) * 33 + n;
        u32x4 o; o.x = pk2(s[0 * 33], s[1 * 33]); o.y = pk2(s[2 * 33], s[3 * 33]); o.z = pk2(s[4 * 33], s[5 * 33]); o.w = pk2(s[6 * 33], s[7 * 33]);
        *(u32x4*)(WT + (size_t)(n0d + n) * K + k0 + 8 * c) = o; }
    LDS_WAIT(); asm volatile("" ::: "memory");
}
__device__ __forceinline__ int win_dst_row(int cg) {
    const int tile = cg >> 3, w = cg & 7;
    const bool qk = (tile < 6) || (tile >= 9 && tile < 13);
    if (tile >= 15) {
        const int isn = tile >= 19, c0 = (cg - (isn ? 152 : 120)) * 32;
        return (15 + (c0 >> 7)) * 256 + isn * 128 + ((c0 & 127) >> 5) * 32;
    }
    if (!qk) return cg * 32;
    const int wc = w >> 1, bj = w & 1;
    return tile * 256 + bj * 128 + wc * 32;
}
__device__ __forceinline__ double dsin_poly(double t) { const double t2 = t * t;
    return t * (1.0 + t2 * (-1.0 / 6 + t2 * (1.0 / 120 + t2 * (-1.0 / 5040 + t2 * (1.0 / 362880 + t2 * (-1.0 / 39916800 + t2 * (1.0 / 6227020800.0))))))); }
__device__ __forceinline__ double dcos_poly(double t) { const double t2 = t * t;
    return 1.0 + t2 * (-0.5 + t2 * (1.0 / 24 + t2 * (-1.0 / 720 + t2 * (1.0 / 40320 + t2 * (-1.0 / 3628800 + t2 * (1.0 / 479001600.0 + t2 * (-1.0 / 87178291200.0))))))); }

__device__ __forceinline__ void p0_prologue(Frame& F) {
    phase_ids(F);
    LAS float* scr = (LAS float*)(F.lds + F.wave * 16384);
    const int gw = F.vcu * 8 + F.wave, NGW = F.G * 8, lane = F.lane;
    bf16_t* WinT = (bf16_t*)(F.ws + WS_WIN); bf16_t* PAt = (bf16_t*)(F.ws + WS_PA); bf16_t* PBt = (bf16_t*)(F.ws + WS_PB); bf16_t* WoT = (bf16_t*)(F.ws + WS_WO);
    bf16_t* WguT = (bf16_t*)(F.ws + WS_WGU); bf16_t* WdT = (bf16_t*)(F.ws + WS_WD);
    const float* w_in = inptr(IN_WIN); const float* w_dil = inptr(IN_WDIL); const float* w_na = inptr(IN_WNA); const float* w_out = inptr(IN_WOUT);
    const float* w_gate = inptr(IN_WGATE); const float* w_up = inptr(IN_WUP); const float* w_down = inptr(IN_WDOWN);
    constexpr int I_IN = 16 * 184, I_PA = 4 * 32, I_PB = 8 * 32, I_WO = 16 * 32, I_E = 16 * 32;
    constexpr int NITEMS = I_IN + I_PA + I_PB + I_WO + NE * 3 * I_E;
    for (int it = gw; it < NITEMS; it += NGW) {
        int r = it;
        if (r < I_IN) { const int kb = r / 184, cg = r % 184; p0_transpose_item(w_in, D, INC, WinT, 64 * kb, 32 * cg, win_dst_row(cg), scr, lane); continue; } r -= I_IN;
        if (r < I_PA) { const int kb = r / 32, cg = r % 32; p0_transpose_item(w_dil, 256, D, PAt, 64 * kb, 32 * cg, 32 * cg, scr, lane); continue; } r -= I_PA;
        if (r < I_PB) { const int kb = r / 32, cg = r % 32; p0_transpose_item(w_na, 512, D, PBt, 64 * kb, 32 * cg, 32 * cg, scr, lane); continue; } r -= I_PB;
        if (r < I_WO) { const int kb = r / 32, cg = r % 32; p0_transpose_item(w_out, D, D, WoT, 64 * kb, 32 * cg, 32 * cg, scr, lane); continue; } r -= I_WO;
        const int e = r / (3 * I_E), q = r % (3 * I_E), wsel = q / I_E, rr = q % I_E, kb = rr / 32, cg = rr % 32;
        if (wsel == 2) { p0_transpose_item(w_down + (size_t)e * FF * D, FF, D, WdT + (size_t)e * D * FF, 64 * kb, 32 * cg, 32 * cg, scr, lane); continue; }
        const int pn = cg >> 2, wcg = cg & 3;
        p0_transpose_item((wsel ? w_up : w_gate) + (size_t)e * D * FF, D, FF, WguT + (size_t)e * 2048 * D, 64 * kb, 32 * cg, pn * 256 + wsel * 128 + wcg * 32, scr, lane);
    }
    bf16_t* HB = (bf16_t*)(F.ws + WS_HB);
    f32x4 gv[4];
#pragma unroll
    for (int j = 0; j < 4; ++j) gv[j] = *(const f32x4*)(inptr(IN_NORM1) + 4 * lane + 256 * j);
    const float* xin = inptr(IN_X);
    for (int m = gw; m < M; m += NGW) {
        const f32x4* xr = (const f32x4*)(xin + (size_t)m * D) + lane; f32x4 v[4]; float s = 0.f;
#pragma unroll
        for (int j = 0; j < 4; ++j) { v[j] = xr[64 * j]; s += (v[j][0] * v[j][0] + v[j][1] * v[j][1]) + (v[j][2] * v[j][2] + v[j][3] * v[j][3]); }
        const float rs = rsqrtf(wave_sum(s, lane) * (1.f / D) + EPS);
        u32x2* o8 = (u32x2*)(HB + (size_t)m * D) + lane;
#pragma unroll
        for (int j = 0; j < 4; ++j) { u32x2 w; w.x = pk2(v[j][0] * rs * gv[j][0], v[j][1] * rs * gv[j][1]); w.y = pk2(v[j][2] * rs * gv[j][2], v[j][3] * rs * gv[j][3]); o8[64 * j] = w; }
    }
    f32x2* rope = (f32x2*)(F.ws + WS_ROPE);
    for (int i = gw * 64 + lane; i < S * 32; i += NGW * 64) {
        const int pos = i >> 5, c = i & 31;
        const float inv = (float)exp2(-(double)c * (13.287712379549449 / 32.0));
        const double ang = (double)((float)pos * inv);
        const double kq = rint(ang * 0.6366197723675814);
        const double t = (ang - kq * 1.5707963267948966) - kq * 6.123233995736766e-17;
        const int q = ((int)kq) & 3;
        const double sv = dsin_poly(t), cv = dcos_poly(t);
        const double sn = (q == 0) ? sv : (q == 1 ? cv : (q == 2 ? -sv : -cv));
        const double cs = (q == 0) ? cv : (q == 1 ? -sv : (q == 2 ? -cv : sv));
        rope[i] = (f32x2){(float)cs, (float)sn};
    }
}
#define MFMA32(a, b, c) __builtin_amdgcn_mfma_f32_32x32x16_bf16((a), (b), (c), 0, 0, 0)
#define MFMA16(a, b, c) __builtin_amdgcn_mfma_f32_16x16x32_bf16((a), (b), (c), 0, 0, 0)
__device__ __forceinline__ int swz9(int tl) { return (tl & ~31) | ((tl ^ (tl >> 5)) & 31); }
__device__ __forceinline__ bf16x8 cat8(s16x4 lo, s16x4 hi) { return __builtin_shufflevector(lo, hi, 0, 1, 2, 3, 4, 5, 6, 7); }

#define SCHED_FENCE() __builtin_amdgcn_sched_barrier(0)
__device__ __forceinline__ void lds_fadd(LAS float* p, float v) { (void)__hip_atomic_fetch_add(p, v, __ATOMIC_RELAXED, __HIP_MEMORY_SCOPE_WORKGROUP); }

template <int NT>
__device__ __forceinline__ void dil_tile64(const bf16_t* Qp, const bf16_t* Kp, const bf16_t* Vp, int p0, int seg0, int seg1, float shift, f32x16 (&O)[NT][2], float (&lsum)[NT], int lane) {
    const int r = lane & 31, hf = lane >> 5;
    const bf16_t* ql = Qp + (size_t)p0 * 64 + lane * 8;
    const bf16_t* kl = Kp + lane * 8;
    const bf16_t* vl = Vp + lane * 8;
    bf16x8 qf[NT][4], kf[2][4], vf[2][2][2];
#pragma unroll
    for (int t = 0; t < NT; ++t)
#pragma unroll
        for (int s = 0; s < 4; ++s) qf[t][s] = *(const bf16x8*)(ql + 2048 * t + 512 * s);
#define DIL_KC(j) ((((p0 + 32 * ((j) - 2)) >= seg0) && ((p0 + 32 * ((j) - 2)) < seg1)) ? (p0 + 32 * ((j) - 2)) : p0)
#define DIL_TV(j) (((p0 + 32 * ((j) - 2)) >= seg0) && ((p0 + 32 * ((j) - 2)) < seg1))
#define DIL_LDK(j, slot) do { const bf16_t* _k = kl + (size_t)DIL_KC(j) * 64; _Pragma("unroll") for (int s = 0; s < 4; ++s) kf[slot][s] = *(const bf16x8*)(_k + 512 * s); } while (0)
#define DIL_LDV(j, slot) do { const bf16_t* _v = vl + (size_t)DIL_KC(j) * 64; _Pragma("unroll") for (int mt = 0; mt < 2; ++mt) _Pragma("unroll") for (int s2 = 0; s2 < 2; ++s2) vf[slot][mt][s2] = *(const bf16x8*)(_v + (mt * 2 + s2) * 512); } while (0)
    DIL_LDK(0, 0); DIL_LDV(0, 0);
    SCHED_FENCE();
#pragma unroll
    for (int t = 0; t < NT; ++t) { lsum[t] = 0.f;
#pragma unroll
        for (int i = 0; i < 16; ++i) { O[t][0][i] = 0.f; O[t][1][i] = 0.f; } }
#pragma unroll
    for (int j = 0; j < 4 + NT; ++j) {
        if (j + 1 < 4 + NT) { DIL_LDK(j + 1, (j + 1) & 1); DIL_LDV(j + 1, (j + 1) & 1); }
        SCHED_FENCE();
        const bool tv = DIL_TV(j);
#pragma unroll
        for (int t = 0; t < NT; ++t) {
            const int jj = j - t;
            if (jj >= 0 && jj <= 4) {
                f32x16 sa;
#pragma unroll
                for (int i = 0; i < 16; ++i) sa[i] = 0.f;
#pragma unroll
                for (int s = 0; s < 4; ++s) sa = MFMA32(kf[j & 1][s], qf[t][s], sa);
                float p[16];
#pragma unroll
                for (int reg = 0; reg < 16; ++reg) {
                    const int kk = (reg & 3) + 8 * (reg >> 2) + 4 * hf;
                    bool ok = tv;
                    if (jj == 0) ok = ok && (kk >= r);
                    if (jj == 4) ok = ok && (kk <= r);
                    const float e = __builtin_amdgcn_exp2f(sa[reg] - shift);
                    p[reg] = ok ? e : 0.f; lsum[t] += p[reg];
                }
#pragma unroll
                for (int s2 = 0; s2 < 2; ++s2) {
                    u32x4 pw; pw.x = pk2(p[8 * s2], p[8 * s2 + 1]); pw.y = pk2(p[8 * s2 + 2], p[8 * s2 + 3]); pw.z = pk2(p[8 * s2 + 4], p[8 * s2 + 5]); pw.w = pk2(p[8 * s2 + 6], p[8 * s2 + 7]);
                    const bf16x8 pb = __builtin_bit_cast(bf16x8, pw);
#pragma unroll
                    for (int mt = 0; mt < 2; ++mt) O[t][mt] = MFMA32(vf[j & 1][mt][s2], pb, O[t][mt]);
                }
            }
        }
        SCHED_FENCE();
    }
#undef DIL_KC
#undef DIL_TV
#undef DIL_LDK
#undef DIL_LDV
}

__device__ __forceinline__ void na_tile4(const bf16_t* Qp, const bf16_t* Kp, const bf16_t* Vp, bf16_t* yb, const LAS float* rpbl, int r0, int cb, float shift, int lane) {
    const int qi = lane & 15, q4 = lane >> 4;
    const int qc = 16 * cb + qi;
    const int kc0 = min(max(16 * cb - 8, 0), 32), ws = min(max(qc - 8, 0), 48);
    const int cA = kc0 + 4 * q4, cB = cA + 16;
    const int lo = (qi >> 3) * 512 + q4 * 64 + (qi & 7) * 8;
    const int mb = kc0 + 4 * q4 - ws;
    const int rs0 = min(max(r0 - 4, 0), 56);
    int off[4];
#pragma unroll
    for (int q = 0; q < 4; ++q) off[q] = min(max(r0 + q - 4, 0), 56) - rs0;
    const int nrows = off[3] + 8;
    const bf16_t* kl = Kp + (size_t)(rs0 * GW + kc0) * 64 + lo;
    const bf16_t* vlA = Vp + (size_t)(rs0 * GW + (cA & ~7)) * 64 + qi * 8 + (cA & 7);
    const bf16_t* vlB = Vp + (size_t)(rs0 * GW + (cB & ~7)) * 64 + qi * 8 + (cB & 7);
    const LAS float* bl = rpbl + (rs0 - r0 + 7) * 31 + (kc0 + 4 * q4 - qc + 15);
    bf16x8 qf[4][2], kf[3][2][2]; s16x4 vf[2][4][2];
#pragma unroll
    for (int q = 0; q < 4; ++q)
#pragma unroll
        for (int s = 0; s < 2; ++s) qf[q][s] = *(const bf16x8*)(Qp + (size_t)((r0 + q) * GW + 16 * cb) * 64 + lo + 256 * s);
#define NA_LDK(j, slot) do { const int _j = ((j) < nrows) ? (j) : (nrows - 1); _Pragma("unroll") for (int hh = 0; hh < 2; ++hh) _Pragma("unroll") for (int s = 0; s < 2; ++s) kf[slot][hh][s] = *(const bf16x8*)(kl + _j * 4096 + hh * 1024 + 256 * s); } while (0)
#define NA_LDV(j, slot) do { const int _j = ((j) < nrows) ? (j) : (nrows - 1); _Pragma("unroll") for (int mt = 0; mt < 4; ++mt) { vf[slot][mt][0] = *(const s16x4*)(vlA + _j * 4096 + mt * 128); vf[slot][mt][1] = *(const s16x4*)(vlB + _j * 4096 + mt * 128); } } while (0)
    NA_LDK(0, 0); NA_LDK(1, 1); NA_LDV(0, 0);
    SCHED_FENCE();
    bool okm[8];
#pragma unroll
    for (int e = 0; e < 8; ++e) okm[e] = (unsigned)(mb + 16 * (e >> 2) + (e & 3)) < 16u;
    f32x4 O[4][4]; float lsum[4];
#pragma unroll
    for (int q = 0; q < 4; ++q) { lsum[q] = 0.f;
#pragma unroll
        for (int mt = 0; mt < 4; ++mt) O[q][mt] = (f32x4){0.f, 0.f, 0.f, 0.f}; }
#pragma unroll
    for (int j = 0; j < 11; ++j) {
        if (j < nrows) {
            if (j + 2 < 11) { NA_LDK(j + 2, (j + 2) % 3); }
            if (j + 1 < 11) { NA_LDV(j + 1, (j + 1) & 1); }
            SCHED_FENCE();
#pragma unroll
            for (int q = 0; q < 4; ++q) {
                if (j - q >= -3 && j - q <= 10 && j >= off[q] && j < off[q] + 8) {
                    float p[8];
#pragma unroll
                    for (int hh = 0; hh < 2; ++hh) {
                        f32x4 sa = (f32x4){0.f, 0.f, 0.f, 0.f};
#pragma unroll
                        for (int s = 0; s < 2; ++s) sa = MFMA16(kf[j % 3][hh][s], qf[q][s], sa);
#pragma unroll
                        for (int v = 0; v < 4; ++v) {
                            const float e = __builtin_amdgcn_exp2f(sa[v] + bl[(j - q) * 31 + 16 * hh + v] - shift);
                            p[4 * hh + v] = okm[4 * hh + v] ? e : 0.f; lsum[q] += p[4 * hh + v];
                        }
                    }
                    u32x4 pw; pw.x = pk2(p[0], p[1]); pw.y = pk2(p[2], p[3]); pw.z = pk2(p[4], p[5]); pw.w = pk2(p[6], p[7]);
                    const bf16x8 pb = __builtin_bit_cast(bf16x8, pw);
#pragma unroll
                    for (int mt = 0; mt < 4; ++mt) O[q][mt] = MFMA16(cat8(vf[j & 1][mt][0], vf[j & 1][mt][1]), pb, O[q][mt]);
                }
            }
            SCHED_FENCE();
        }
    }
#undef NA_LDK
#undef NA_LDV
#pragma unroll
    for (int q = 0; q < 4; ++q) {
        float l = lsum[q]; l += shx(l, 16, lane); l += shx(l, 32, lane);
        const float inv = 1.0f / l;
#pragma unroll
        for (int mt = 0; mt < 4; ++mt) { u32x2 w; w.x = pk2(O[q][mt][0] * inv, O[q][mt][1] * inv); w.y = pk2(O[q][mt][2] * inv, O[q][mt][3] * inv);
            *(u32x2*)(yb + (size_t)((r0 + q) * GW + qc) * 512 + 16 * mt + 4 * q4) = w; }
    }
}

__device__ __forceinline__ void p2_attention(Frame& F, const int flags) {
    phase_ids(F);
    const int lane = F.lane, wave = F.wave, tid = F.tid;
    LAS float* Ol = (LAS float*)F.lds;
    LAS float* Ll = (LAS float*)(F.lds + LDS_L_OFF);
    const bf16_t* Qd = (const bf16_t*)(F.ws + WS_QD); const bf16_t* Kd = (const bf16_t*)(F.ws + WS_KD); const bf16_t* Vtd = (const bf16_t*)(F.ws + WS_VTD);
    const bf16_t* Qn = (const bf16_t*)(F.ws + WS_QN); const bf16_t* Kn = (const bf16_t*)(F.ws + WS_KN); const bf16_t* Vtn = (const bf16_t*)(F.ws + WS_VTN);
    bf16_t* YA = (bf16_t*)(F.ws + WS_YA); bf16_t* YB = (bf16_t*)(F.ws + WS_YB);
    const float shiftD = 8.0f * wave_max(fabsf(inptr(IN_DQG)[lane]), lane) * wave_max(fabsf(inptr(IN_DKG)[lane]), lane) * LOG2E;
    if (!(flags & 1))
    for (int su = F.vcu; su < 256; su += F.G) {
        const int b = su >> 5, h = (su >> 3) & 3, T0 = (su & 7) * 512;
#pragma unroll 1
        for (int g = 0; g < 3; ++g) {
            const int d = dil_of(g), L = S / d, sh = (g == 0) ? 3 : (g == 1 ? 1 : 0), head = g * 4 + h;
            const bf16_t* Qp = Qd + (size_t)(b * DILH + head) * S * 64; const bf16_t* Kp = Kd + (size_t)(b * DILH + head) * S * 64; const bf16_t* Vp = Vtd + (size_t)(b * DILH + head) * 64 * S;
            if (g < 2) {
                const int rres = wave >> sh, tq = wave & ((1 << sh) - 1);
                const int p0 = rres * L + T0 / d + tq * 64;
                f32x16 O[2][2]; float lsum[2];
                dil_tile64<2>(Qp, Kp, Vp, p0, rres * L, (rres + 1) * L, shiftD, O, lsum, lane);
                const int r = lane & 31, hf = lane >> 5;
#pragma unroll
                for (int t = 0; t < 2; ++t) {
                    const int sw = swz9((tq * 64 + 32 * t + r) * d + rres);
                    const float lt = lsum[t] + shx(lsum[t], 32, lane);
                    if (g == 0) {
#pragma unroll
                        for (int mt = 0; mt < 2; ++mt)
#pragma unroll
                            for (int reg = 0; reg < 16; ++reg) Ol[(32 * mt + (reg & 3) + 8 * (reg >> 2) + 4 * hf) * 512 + sw] = O[t][mt][reg];
                        if (hf == 0) Ll[sw] = lt;
                    } else {
#pragma unroll
                        for (int mt = 0; mt < 2; ++mt)
#pragma unroll
                            for (int reg = 0; reg < 16; ++reg) Ol[(32 * mt + (reg & 3) + 8 * (reg >> 2) + 4 * hf) * 512 + sw] += O[t][mt][reg];
                        if (hf == 0) Ll[sw] += lt;
                    }
                }
            } else {
#pragma unroll 1
                for (int tt = 0; tt < 2; ++tt) {
                    const int rres = wave + 8 * tt, p0 = rres * L + T0 / d;
                    f32x16 O[1][2]; float lsum[1];
                    dil_tile64<1>(Qp, Kp, Vp, p0, rres * L, (rres + 1) * L, shiftD, O, lsum, lane);
                    const int r = lane & 31, hf = lane >> 5;
                    const int sw = swz9(r * d + rres);
                    const float lt = lsum[0] + shx(lsum[0], 32, lane);
#pragma unroll
                    for (int mt = 0; mt < 2; ++mt)
#pragma unroll
                        for (int reg = 0; reg < 16; ++reg) Ol[(32 * mt + (reg & 3) + 8 * (reg >> 2) + 4 * hf) * 512 + sw] += O[0][mt][reg];
                    if (hf == 0) Ll[sw] += lt;
                }
            }
            __syncthreads();
        }
        {
            const int sw = swz9(tid); const float inv = 1.0f / Ll[sw];
            bf16_t* op = YA + ((size_t)b * S + T0 + tid) * 256 + h * 64;
#pragma unroll
            for (int c = 0; c < 8; ++c) { float v[8];
#pragma unroll
                for (int k = 0; k < 8; ++k) v[k] = Ol[(8 * c + k) * 512 + sw] * inv;
                u32x4 w; w.x = pk2(v[0], v[1]); w.y = pk2(v[2], v[3]); w.z = pk2(v[4], v[5]); w.w = pk2(v[6], v[7]);
                *(u32x4*)(op + 8 * c) = w; }
        }
        __syncthreads();
    }
    phase_ids(F);
    const int lane2 = F.lane, wave2 = F.wave, tid2 = F.tid;
    const float boundN = 8.0f * wave_max(fabsf(inptr(IN_NQG)[lane2]), lane2) * wave_max(fabsf(inptr(IN_NKG)[lane2]), lane2) * LOG2E;
    LAS float* rpbl = (LAS float*)(F.lds + 256);
    LAS float* red = (LAS float*)(F.lds + LDS_L_OFF);
    float mx = 0.f;
    const float* rpb = inptr(IN_RPB);
    for (int i = tid2; i < NAH * 465; i += 512) { const float v = rpb[i]; rpbl[i] = v * LOG2E; mx = fmaxf(mx, fabsf(v)); }
    mx = wave_max(mx, lane2);
    if (lane2 == 0) red[wave2] = mx;
    __syncthreads();
    float bmax = 0.f;
#pragma unroll
    for (int w = 0; w < 8; ++w) bmax = fmaxf(bmax, red[w]);
    const float shiftN = boundN + bmax * LOG2E;
    if (!(flags & 2))
    for (int su = F.vcu; su < 256; su += F.G) {
        const int b = su >> 5, head = (su >> 2) & 7, band = su & 3;
        const bf16_t* Qp = Qn + (size_t)(b * NAH + head) * S * 64; const bf16_t* Kp = Kn + (size_t)(b * NAH + head) * S * 64; const bf16_t* Vp = Vtn + (size_t)(b * NAH + head) * 64 * S;
        bf16_t* yb = YB + (size_t)b * S * 512 + head * 64;
#pragma unroll 1
        for (int t = 0; t < 2; ++t) na_tile4(Qp, Kp, Vp, yb, rpbl + head * 465, band * 16 + 4 * (wave2 >> 1), 2 * (wave2 & 1) + t, shiftN, lane2);
    }
    __syncthreads();
}

__device__ __forceinline__ void p5_norm_router(Frame& F) {
    phase_ids(F);
    const int lane = F.lane, tid = F.tid;
    const float* w_router = inptr(IN_WROUTER); const float* norm2_g = inptr(IN_NORM2); const float* xin = inptr(IN_X); const bf16_t* dlt = (const bf16_t*)(F.ws + WS_DLT);
    LAS float* wl = (LAS float*)F.lds;
    for (int i = tid; i < D * NE; i += 512) { const int d = i >> 4, e = i & 15, ln = (d & 255) >> 2, ii = d & 3, j = d >> 8, q = e >> 2, c = e & 3;
        wl[((((j * 4 + ii) * 4 + q) * 64 + ln) << 2) + c] = w_router[i]; }
    __syncthreads();
    const int gw = F.vcu * 8 + F.wave, NGW = F.G * 8;
    bf16_t* H2 = (bf16_t*)(F.ws + WS_HB); float* aff = (float*)(F.ws + WS_AFF);
    const int myexp = ((lane & 1) << 3) | ((lane & 2) << 1) | ((lane & 4) >> 1) | ((lane & 8) >> 3);
    f32x4 xn[2][4]; u32x2 dn[2][4];
#define P5_LOAD(mm) do { _Pragma("unroll") for (int r = 0; r < 2; ++r) { const f32x4* _x = (const f32x4*)(xin + (size_t)((mm) + r) * D) + lane; const u32x2* _d = (const u32x2*)(dlt + (size_t)((mm) + r) * D) + lane; \
        _Pragma("unroll") for (int j = 0; j < 4; ++j) { xn[r][j] = _x[64 * j]; dn[r][j] = _d[64 * j]; } } } while (0)
    if (gw * 2 < M) P5_LOAD(gw * 2);
    for (int m0 = gw * 2; m0 < M; m0 += NGW * 2) {
        f32x2 lg[16];
#pragma unroll
        for (int e = 0; e < 16; ++e) lg[e] = (f32x2){0.f, 0.f};
        float rs[2]; f32x4 v[2][4];
#pragma unroll
        for (int r = 0; r < 2; ++r) { float s = 0.f;
#pragma unroll
            for (int j = 0; j < 4; ++j) { const u32x2 dw = dn[r][j]; v[r][j] = xn[r][j] + (f32x4){bflo(dw.x), bfhi(dw.x), bflo(dw.y), bfhi(dw.y)};
                s += (v[r][j][0] * v[r][j][0] + v[r][j][1] * v[r][j][1]) + (v[r][j][2] * v[r][j][2] + v[r][j][3] * v[r][j][3]); }
            rs[r] = rsqrtf(wave_sum(s, lane) * (1.f / D) + EPS); }
        { const int mn = m0 + NGW * 2; P5_LOAD(mn < M ? mn : m0); }
        __builtin_amdgcn_sched_barrier(0);
#pragma unroll
        for (int j = 0; j < 4; ++j) {
            const f32x4 gj = *(const f32x4*)(norm2_g + 4 * lane + 256 * j);
#pragma unroll
            for (int r = 0; r < 2; ++r) { v[r][j] = v[r][j] * rs[r] * gj;
                u32x2 w; w.x = pk2(v[r][j][0], v[r][j][1]); w.y = pk2(v[r][j][2], v[r][j][3]); ((u32x2*)(H2 + (size_t)(m0 + r) * D) + lane)[64 * j] = w; }
#pragma unroll
            for (int i = 0; i < 4; ++i) {
                const f32x2 hv = {v[0][j][i], v[1][j][i]};
#pragma unroll
                for (int q = 0; q < 4; ++q) { const f32x4 w4 = *(const LAS f32x4*)(wl + ((((j * 4 + i) * 4 + q) * 64 + lane) << 2));
                    lg[4 * q + 0] += hv * w4[0]; lg[4 * q + 1] += hv * w4[1]; lg[4 * q + 2] += hv * w4[2]; lg[4 * q + 3] += hv * w4[3]; }
                __builtin_amdgcn_sched_barrier(0);
            }
        }
#pragma unroll
        for (int r = 0; r < 2; ++r) {
            float a8[8], a4[4], a2[2], a1;
            { const bool up = lane & 1;
#pragma unroll
              for (int k = 0; k < 8; ++k) { const float keep = up ? lg[8 + k][r] : lg[k][r], send = up ? lg[k][r] : lg[8 + k][r]; a8[k] = keep + shx(send, 1, lane); } }
            { const bool up = lane & 2;
#pragma unroll
              for (int k = 0; k < 4; ++k) { const float keep = up ? a8[4 + k] : a8[k], send = up ? a8[k] : a8[4 + k]; a4[k] = keep + shx(send, 2, lane); } }
            { const bool up = lane & 4;
#pragma unroll
              for (int k = 0; k < 2; ++k) { const float keep = up ? a4[2 + k] : a4[k], send = up ? a4[k] : a4[2 + k]; a2[k] = keep + shx(send, 4, lane); } }
            { const bool up = lane & 8; const float keep = up ? a2[1] : a2[0], send = up ? a2[0] : a2[1]; a1 = keep + shx(send, 8, lane); }
            a1 += shx(a1, 16, lane); a1 += shx(a1, 32, lane);
            float mx = a1;
#pragma unroll
            for (int o = 1; o < 16; o <<= 1) mx = fmaxf(mx, shx(mx, o, lane));
            const float p = __expf(a1 - mx); float den = p;
#pragma unroll
            for (int o = 1; o < 16; o <<= 1) den += shx(den, o, lane);
            const int m = m0 + r;
            if (lane < 16) aff[((size_t)((m >> 12) * NE + myexp) << 12) + (m & 4095)] = p / den;
        }
    }
#undef P5_LOAD
    __syncthreads();
}

__device__ __forceinline__ int wave_sum_i(int v, int lane) {
#pragma unroll
    for (int o = 1; o < 64; o <<= 1) v += shxi(v, o, lane);
    return v;
}
__device__ __forceinline__ void p6_topk(Frame& F) {
    phase_ids(F);
    const int lane = F.lane, tid = F.tid, wave = F.wave;
    LAS int* red = (LAS int*)F.lds;
    const float* aff = (const float*)(F.ws + WS_AFF); int* idx = (int*)(F.ws + WS_IDX); float* glist = (float*)(F.ws + WS_GLIST); int* tokslot = (int*)(F.ws + WS_TOKSLOT);
    for (int li = F.vcu; li < NB * NE; li += F.G) {
        const int b = li >> 4, e = li & 15;
        const float* ap = aff + (size_t)li * S + 8 * tid;
        const f32x4 a0 = *(const f32x4*)ap, a1 = *(const f32x4*)(ap + 4);
        const float av[8] = {a0[0], a0[1], a0[2], a0[3], a1[0], a1[1], a1[2], a1[3]};
        unsigned key[8];
#pragma unroll
        for (int k = 0; k < 8; ++k) key[k] = __builtin_bit_cast(unsigned, av[k]);
        unsigned tau = 0u; int par = 0;
        for (int bit = 30; bit >= 0; --bit) {
            const unsigned cand = tau | (1u << bit); int c = 0;
#pragma unroll
            for (int k = 0; k < 8; ++k) c += (key[k] >= cand) ? 1 : 0;
            c = wave_sum_i(c, lane);
            if (lane == 0) red[par * 8 + wave] = c;
            __syncthreads();
            int tot = 0;
#pragma unroll
            for (int w = 0; w < 8; ++w) tot += red[par * 8 + w];
            if (tot >= CAP) tau = cand;
            par ^= 1;
        }
        int cg = 0, ce = 0;
#pragma unroll
        for (int k = 0; k < 8; ++k) { cg += (key[k] > tau) ? 1 : 0; ce += (key[k] == tau) ? 1 : 0; }
        int pkc = cg | (ce << 16), incl = pkc;
#pragma unroll
        for (int o = 1; o < 64; o <<= 1) { const int t = __builtin_amdgcn_ds_bpermute((lane - o) << 2, incl); if (lane >= o) incl += t; }
        __syncthreads();
        if (lane == 63) red[64 + wave] = incl;
        __syncthreads();
        int wpre = 0, total = 0;
#pragma unroll
        for (int w = 0; w < 8; ++w) { const int t = red[64 + w]; if (w < wave) wpre += t; total += t; }
        const int excl = wpre + incl - pkc;
        int gt_before = excl & 0xffff, eq_before = excl >> 16;
        const int need = CAP - (total & 0xffff);
        const size_t rowbase = (size_t)(e * NB + b) * CAP;
#pragma unroll
        for (int k = 0; k < 8; ++k) {
            const bool isg = key[k] > tau, ise = key[k] == tau;
            const bool sel = isg || (ise && eq_before < need);
            const int slot = gt_before + min(eq_before, need);
            const int tok = 8 * tid + k;
            if (sel) { idx[rowbase + slot] = tok; glist[rowbase + slot] = av[k]; }
            tokslot[(size_t)li * S + tok] = sel ? slot : -1;
            gt_before += isg ? 1 : 0; eq_before += ise ? 1 : 0;
        }
        __syncthreads();
    }
}

__device__ __forceinline__ int p9_slot(const int (&ts)[4], int e, int t) {
    const int src = (e >> 2) * 16 + t, k = e & 3;
    const int v = (k == 0) ? ts[0] : (k == 1 ? ts[1] : (k == 2 ? ts[2] : ts[3]));
    return __builtin_amdgcn_readlane(v, src);
}
__device__ __forceinline__ void p9_combine(Frame& F, const int flags) {
    phase_ids(F);
    const int lane = F.lane; (void)flags;
    const int gw = F.vcu * 8 + F.wave, NGW = F.G * 8;
    const int* tokslot = (const int*)(F.ws + WS_TOKSLOT); const bf16_t* Y = (const bf16_t*)(F.ws + WS_Y); const float* glist = (const float*)(F.ws + WS_GLIST);
    const float* xin = inptr(IN_X); const bf16_t* dlt = (const bf16_t*)(F.ws + WS_DLT);
    for (int ch = gw; ch < M / 16; ch += NGW) {
        const int t0 = ch * 16, b = t0 >> 12, s0 = t0 & 4095;
        int ts[4];
        unsigned long long bal[4];
#pragma unroll
        for (int k = 0; k < 4; ++k) { ts[k] = tokslot[((size_t)(b * NE + 4 * (lane >> 4) + k) << 12) + s0 + (lane & 15)]; bal[k] = __ballot(ts[k] >= 0); }
        f32x4 bx[2][4]; u32x2 bd[2][4], by[2][3][4]; float wy[2][3]; unsigned rest[2];
#define P9_ISSUE(t, buf) do { const f32x4* _x = (const f32x4*)(xin + (size_t)(t0 + (t)) * D) + lane; const u32x2* _d = (const u32x2*)(dlt + (size_t)(t0 + (t)) * D) + lane; \
            _Pragma("unroll") for (int j = 0; j < 4; ++j) { bx[buf][j] = _x[64 * j]; bd[buf][j] = _d[64 * j]; } \
            unsigned _m = 0u; _Pragma("unroll") for (int k = 0; k < 4; ++k) _Pragma("unroll") for (int eg = 0; eg < 4; ++eg) _m |= (unsigned)((bal[k] >> (eg * 16 + (t))) & 1ull) << (4 * eg + k); \
            _Pragma("unroll") for (int i = 0; i < 3; ++i) { size_t _row = 0; float _w = 0.f; \
                if (_m) { const int _e = __builtin_ctz(_m); _m &= _m - 1u; const int _s = p9_slot(ts, _e, (t)); _row = (size_t)(_e * NB + b) * CAP + _s; _w = glist[_row]; } \
                const u32x2* _y = (const u32x2*)(Y + _row * D) + lane; _Pragma("unroll") for (int j = 0; j < 4; ++j) by[buf][i][j] = _y[64 * j]; wy[buf][i] = _w; } \
            rest[buf] = _m; } while (0)
#define P9_CONSUME(t, buf) do { f32x4 acc[4]; \
            _Pragma("unroll") for (int j = 0; j < 4; ++j) { const u32x2 dw = bd[buf][j]; acc[j] = bx[buf][j] + (f32x4){bflo(dw.x), bfhi(dw.x), bflo(dw.y), bfhi(dw.y)}; } \
            _Pragma("unroll") for (int i = 0; i < 3; ++i) { const float _w = wy[buf][i]; _Pragma("unroll") for (int j = 0; j < 4; ++j) { const u32x2 w = by[buf][i][j]; \
                acc[j][0] += _w * bflo(w.x); acc[j][1] += _w * bfhi(w.x); acc[j][2] += _w * bflo(w.y); acc[j][3] += _w * bfhi(w.y); } } \
            unsigned _m = rest[buf]; \
            while (_m) { const int _e = __builtin_ctz(_m); _m &= _m - 1u; const int _s = p9_slot(ts, _e, (t)); const size_t _r = (size_t)(_e * NB + b) * CAP + _s; const u32x2* _y = (const u32x2*)(Y + _r * D) + lane; const float _g = glist[_r]; \
                _Pragma("unroll") for (int j = 0; j < 4; ++j) { const u32x2 w = _y[64 * j]; acc[j][0] += _g * bflo(w.x); acc[j][1] += _g * bfhi(w.x); acc[j][2] += _g * bflo(w.y); acc[j][3] += _g * bfhi(w.y); } } \
            f32x4* _o = (f32x4*)(F.out + (size_t)(t0 + (t)) * D) + lane; _Pragma("unroll") for (int j = 0; j < 4; ++j) _o[64 * j] = acc[j]; } while (0)
        P9_ISSUE(0, 0);
#pragma unroll 1
        for (int t = 0; t < 16; t += 2) {
            P9_ISSUE(t + 1, 1); __builtin_amdgcn_sched_barrier(0);
            P9_CONSUME(t, 0); __builtin_amdgcn_sched_barrier(0);
            { const int tn = (t + 2 < 16) ? t + 2 : t; P9_ISSUE(tn, 0); } __builtin_amdgcn_sched_barrier(0);
            P9_CONSUME(t + 1, 1); __builtin_amdgcn_sched_barrier(0);
        }
#undef P9_ISSUE
#undef P9_CONSUME
    }
}

constexpr int N_PHASES = 10;
struct Args { const float* in[16]; float* out; unsigned char* ws; int ph_lo, ph_hi, flags, pad; };
__global__ void __launch_bounds__(512, 2) mk_fwd(Args args) {
    extern __shared__ __attribute__((aligned(16))) unsigned char lds_raw[];
    Frame F;
    F.lds = (LAS unsigned char*)lds_raw;
    { const int t0 = threadIdx.x; F.wave = __builtin_amdgcn_readfirstlane(t0 >> 6); } phase_ids(F);
    F.G = gridDim.x; { const int bx = blockIdx.x; F.vcu = (F.G % 8 == 0) ? (bx % 8) * (F.G / 8) + bx / 8 : bx; }
    F.out = args.out; F.ws = args.ws;
    volatile LAS unsigned* misc = (volatile LAS unsigned*)(F.lds + LDS_MISC_OFF);
    if (F.tid < 64) misc[F.tid] = 0u;
    __syncthreads();
    const int lo = args.ph_lo, hi = args.ph_hi;
    unsigned* ctl = (unsigned*)(F.ws + WS_CTL);
    XcdBarrier bar; bar.bar = ctl + CW_BAR; bar.x = 0; bar.st = misc + 8;
    if (hi - lo > 1) bar = xcd_barrier_post(ctl + CW_BAR, misc + 8, F.tid == 0);
#ifdef MK_ONLY_PHASE
#define IN(k) ((k) == MK_ONLY_PHASE && lo <= (k) && (k) < hi)
#else
#define IN(k) (lo <= (k) && (k) < hi)
#endif
#define SEAM(k) do { if (IN(k) && IN((k) + 1)) { phase_ids(F); xcd_barrier(bar, F.tid == 0); } } while (0)
    const int c = (int)blockIdx.x, G = F.G;
    const char* hb = (const char*)(F.ws + WS_HB); const char* win = (const char*)(F.ws + WS_WIN);
    bf16_t* gates = (bf16_t*)F.out;

    if (IN(0)) { p0_prologue(F); VM_WAIT(); __syncthreads(); }
    SEAM(0);
    if (IN(1)) {
        SchedP1 S1{ SchedQKd{hb, win, (char*)(F.ws + WS_QD), (char*)(F.ws + WS_KD), G, c}, SchedQKn{hb, win, (char*)(F.ws + WS_QN), (char*)(F.ws + WS_KN), G, c},
                    SchedGates{hb, win, G, c}, SchedVt{hb, win, (char*)(F.ws + WS_VTD), (char*)(F.ws + WS_VTN), G, c}, G, c };
        EpiP1 E1{ EpiQK<true>{inptr(IN_DQG), inptr(IN_DKG), (const f32x2*)(F.ws + WS_ROPE), 0.125f * LOG2E}, EpiQK<false>{inptr(IN_NQG), inptr(IN_NKG), nullptr, 0.125f * LOG2E},
                  EpiGates{gates}, EpiVt{}, (args.flags >> 8) & 15 };
        g8::gemm_phase<EpiP1, SchedP1, false>(F.lds, S1, E1, F.wave);
    }
    SEAM(1);
    if (IN(2)) p2_attention(F, args.flags);
    SEAM(2);
    if (IN(3)) {
        SchedP3 S3{(const char*)(F.ws + WS_YA), (const char*)(F.ws + WS_PA), (const char*)(F.ws + WS_YB), (const char*)(F.ws + WS_PB), G, c};
        EpiP3 E3{(bf16_t*)(F.ws + WS_HB), gates};
        g8::gemm_phase<EpiP3, SchedP3, false>(F.lds, S3, E3, F.wave);
    }
    SEAM(3);
    if (IN(4)) {
        SchedDense So{(const char*)(F.ws + WS_HB), (const char*)(F.ws + WS_WO), D * 2, D * 2, 128, 4, G, c, 16};
        EpiBf16<0> E{(bf16_t*)(F.ws + WS_DLT), D};
        g8::gemm_phase<EpiBf16<0>, SchedDense, false>(F.lds, So, E, F.wave);
    }
    SEAM(4);
    if (IN(5)) p5_norm_router(F);
    SEAM(5);
    if (IN(6)) p6_topk(F);
    SEAM(6);
    if (IN(7)) {
        SchedGU Sg{(const char*)(F.ws + WS_HB), (const char*)(F.ws + WS_WGU), (const int*)(F.ws + WS_IDX), G, c};
        EpiSwiGLU E{(bf16_t*)(F.ws + WS_H), args.flags & 64};
        g8::gemm_phase<EpiSwiGLU, SchedGU, true>(F.lds, Sg, E, F.wave);
    }
    SEAM(7);
    if (IN(8)) {
        SchedDown Sd{(const char*)(F.ws + WS_H), (const char*)(F.ws + WS_WD), G, c};
        EpiBf16<0> E{(bf16_t*)(F.ws + WS_Y), D};
        g8::gemm_phase<EpiBf16<0>, SchedDown, false>(F.lds, Sd, E, F.wave);
    }
    SEAM(8);
    if (IN(9)) p9_combine(F, args.flags);
#undef IN
#undef SEAM
}
#ifndef MK_HYB
#define MK_HYB 10
#endif
#ifndef MK_PER_PHASE
#define MK_PER_PHASE 0
#endif

#if MK_HYB < 10
namespace tail {
struct GemmArgs { const float* A; const float* Bm; float* C; const int* gather; int M, N, K, lda, ldb, ldc; long sA, sB, sC; int sG; };
__global__ void __launch_bounds__(256) k_gemm(GemmArgs g) {
    __shared__ float As[16][128 + 4];
    __shared__ float Bs[16][128 + 4];
    const int z = blockIdx.z;
    const float* A = g.A + (long)z * g.sA; const float* Bm = g.Bm + (long)z * g.sB; float* C = g.C + (long)z * g.sC;
    const int* gi = g.gather ? g.gather + (long)z * g.sG : nullptr;
    const int m0 = blockIdx.y * 128, n0 = blockIdx.x * 128, tid = threadIdx.x, tx = tid & 15, ty = tid >> 4;
    float acc[8][8];
#pragma unroll
    for (int i = 0; i < 8; ++i)
#pragma unroll
        for (int j = 0; j < 8; ++j) acc[i][j] = 0.f;
    const int ar = tid >> 1, ak = (tid & 1) * 8;
    const long arow = gi ? (long)gi[m0 + ar] : (long)(m0 + ar);
    const float* ap = A + arow * g.lda + ak;
    const int bk = tid >> 4, bn = (tid & 15) * 8;
    const float* bp = Bm + (long)bk * g.ldb + n0 + bn;
    for (int k0 = 0; k0 < g.K; k0 += 16) {
        const float4 a0 = *(const float4*)(ap + k0), a1 = *(const float4*)(ap + k0 + 4);
        const float4 b0 = *(const float4*)(bp + (long)k0 * g.ldb), b1 = *(const float4*)(bp + (long)k0 * g.ldb + 4);
        __syncthreads();
        As[ak + 0][ar] = a0.x; As[ak + 1][ar] = a0.y; As[ak + 2][ar] = a0.z; As[ak + 3][ar] = a0.w;
        As[ak + 4][ar] = a1.x; As[ak + 5][ar] = a1.y; As[ak + 6][ar] = a1.z; As[ak + 7][ar] = a1.w;
        *(float4*)&Bs[bk][bn] = b0; *(float4*)&Bs[bk][bn + 4] = b1;
        __syncthreads();
#pragma unroll
        for (int k = 0; k < 16; ++k) {
            float av[8], bv[8];
            const float4 x0 = *(const float4*)&As[k][ty * 4], x1 = *(const float4*)&As[k][64 + ty * 4];
            const float4 y0 = *(const float4*)&Bs[k][tx * 4], y1 = *(const float4*)&Bs[k][64 + tx * 4];
            av[0] = x0.x; av[1] = x0.y; av[2] = x0.z; av[3] = x0.w; av[4] = x1.x; av[5] = x1.y; av[6] = x1.z; av[7] = x1.w;
            bv[0] = y0.x; bv[1] = y0.y; bv[2] = y0.z; bv[3] = y0.w; bv[4] = y1.x; bv[5] = y1.y; bv[6] = y1.z; bv[7] = y1.w;
#pragma unroll
            for (int i = 0; i < 8; ++i)
#pragma unroll
                for (int j = 0; j < 8; ++j) acc[i][j] = fmaf(av[i], bv[j], acc[i][j]);
        }
    }
#pragma unroll
    for (int i = 0; i < 8; ++i) {
        const int m = m0 + (i < 4 ? ty * 4 + i : 64 + ty * 4 + (i - 4));
        float* cp = C + (long)m * g.ldc + n0;
        *(float4*)(cp + tx * 4) = make_float4(acc[i][0], acc[i][1], acc[i][2], acc[i][3]);
        *(float4*)(cp + 64 + tx * 4) = make_float4(acc[i][4], acc[i][5], acc[i][6], acc[i][7]);
    }
}
__device__ __forceinline__ float bf2f(bf16_t v) { return __builtin_bit_cast(float, (unsigned)v << 16); }
__device__ __forceinline__ size_t qd_ix(int pos, int dim) { return (size_t)(pos >> 5) * 2048 + (dim >> 4) * 512 + ((dim >> 3) & 1) * 256 + (pos & 31) * 8 + (dim & 7); }
__device__ __forceinline__ size_t vtd_ix(int pos, int dim) { const int kk = pos & 31, k16 = kk & 15; return (size_t)(pos >> 5) * 2048 + ((dim >> 5) * 2 + (kk >> 4)) * 512 + ((k16 >> 2) & 1) * 256 + (dim & 31) * 8 + (k16 >> 3) * 4 + (k16 & 3); }
__device__ __forceinline__ size_t qn_ix(int tok, int dim) { return (size_t)(tok >> 3) * 512 + (dim >> 5) * 256 + ((dim >> 3) & 3) * 64 + (tok & 7) * 8 + (dim & 7); }
__device__ __forceinline__ size_t vtn_ix(int tok, int dim) { return (size_t)(tok >> 3) * 512 + dim * 8 + (tok & 7); }
__global__ void __launch_bounds__(256) k_dil_attn(const bf16_t* Qd, const bf16_t* Kd, const bf16_t* Vtd, float* ya, int b) {
    const int w = blockIdx.x * 4 + (threadIdx.x >> 6), lane = threadIdx.x & 63, tok = w >> 2, h = w & 3, wi = threadIdx.x >> 6;
    __shared__ float qs[4][64]; __shared__ float ps[4][3 * 129 + 3];
    float sc[3][3]; float mx = -INFINITY;
#pragma unroll
    for (int g = 0; g < 3; ++g) {
        const int d = (g == 0) ? 1 : (g == 1 ? 4 : 16), L = S / d, head = g * 4 + h;
        const size_t hb = (size_t)(b * DILH + head) * S;
        qs[wi][lane] = bf2f(Qd[hb * 64 + qd_ix((tok % d) * L + tok / d, lane)]);
        __syncthreads();
#pragma unroll
        for (int rd = 0; rd < 3; ++rd) {
            const int j = rd * 64 + lane; float s = -INFINITY;
            if (j <= 128) { const int kt = tok + (j - 64) * d;
                if (kt >= 0 && kt < S) { const int kpos = (kt % d) * L + kt / d; float a = 0.f; for (int c = 0; c < 64; ++c) a += qs[wi][c] * bf2f(Kd[hb * 64 + qd_ix(kpos, c)]); s = a; } }
            sc[g][rd] = s; mx = fmaxf(mx, s);
        }
        __syncthreads();
    }
    mx = wave_max(mx);
    float den = 0.f;
#pragma unroll
    for (int g = 0; g < 3; ++g)
#pragma unroll
        for (int rd = 0; rd < 3; ++rd) { const int j = rd * 64 + lane; const float p = (sc[g][rd] == -INFINITY) ? 0.f : exp2f(sc[g][rd] - mx); den += p; if (j <= 128) ps[wi][g * 129 + j] = p; }
    den = wave_sum(den);
    __syncthreads();
    float o = 0.f;
    for (int g = 0; g < 3; ++g) {
        const int d = (g == 0) ? 1 : (g == 1 ? 4 : 16), L = S / d, head = g * 4 + h;
        const bf16_t* vp = Vtd + (size_t)(b * DILH + head) * 64 * S;
        for (int j = 0; j <= 128; ++j) { const int kt = tok + (j - 64) * d; if (kt >= 0 && kt < S) { const int pp = (kt % d) * L + kt / d; o += ps[wi][g * 129 + j] * bf2f(vp[vtd_ix(pp, lane)]); } }
    }
    ya[(long)tok * 256 + h * 64 + lane] = o / den;
}
__global__ void __launch_bounds__(256) k_na_attn(const bf16_t* Qn, const bf16_t* Kn, const bf16_t* Vtn, const float* rpb, float* yb, int b) {
    const int w = blockIdx.x * 4 + (threadIdx.x >> 6), lane = threadIdx.x & 63, tok = w >> 3, h = w & 7, wi = threadIdx.x >> 6;
    __shared__ float qs[4][64]; __shared__ float ps[4][128];
    const int r = tok / GW, c = tok % GW, rs = min(max(r - 4, 0), 56), ws = min(max(c - 8, 0), 48);
    const size_t hb = (size_t)(b * NAH + h) * S;
    qs[wi][lane] = bf2f(Qn[hb * 64 + qn_ix(tok, lane)]);
    __syncthreads();
    float sc[2]; float mx = -INFINITY;
#pragma unroll
    for (int rd = 0; rd < 2; ++rd) {
        const int j = rd * 64 + lane, kr = rs + (j >> 4), kc = ws + (j & 15);
        float a = 0.f;
        for (int cc = 0; cc < 64; ++cc) a += qs[wi][cc] * bf2f(Kn[hb * 64 + qn_ix(kr * GW + kc, cc)]);
        sc[rd] = a + rpb[(h * 15 + (kr - r + 7)) * 31 + (kc - c + 15)] * LOG2E; mx = fmaxf(mx, sc[rd]);
    }
    mx = wave_max(mx);
    float den = 0.f;
#pragma unroll
    for (int rd = 0; rd < 2; ++rd) { const float p = exp2f(sc[rd] - mx); den += p; ps[wi][rd * 64 + lane] = p; }
    den = wave_sum(den);
    __syncthreads();
    float o = 0.f;
    const bf16_t* vp = Vtn + (size_t)(b * NAH + h) * 64 * S;
    for (int j = 0; j < 128; ++j) { const int pp = (rs + (j >> 4)) * GW + ws + (j & 15); o += ps[wi][j] * bf2f(vp[vtn_ix(pp, lane)]); }
    yb[(long)tok * 512 + h * 64 + lane] = o / den;
}
__global__ void k_bf2f(const bf16_t* a, float* o, long n) { const long i = (long)blockIdx.x * blockDim.x + threadIdx.x; if (i < n) o[i] = bf2f(a[i]); }
__global__ void k_merge(const bf16_t* gates, const float* yap, const float* ybp, float* merged) {
    const long i = (long)blockIdx.x * blockDim.x + threadIdx.x; if (i >= (long)S * D) return;
    const int tok = (int)(i / D), c = (int)(i % D);
    const float sn = bf2f(gates[(long)tok * 2048 + 1024 + c]); merged[i] = (yap[i] * bf2f(gates[(long)tok * 2048 + c]) + ybp[i]) * sn;
}
__global__ void k_add(const float* a, const float* b, float* o, long n) { const long i = (long)blockIdx.x * blockDim.x + threadIdx.x; if (i < n) o[i] = a[i] + b[i]; }
__global__ void __launch_bounds__(256) k_norm_router(const float* x1, const float* g, const float* wr, float* h2, float* aff) {
    const int row = blockIdx.x * 4 + (threadIdx.x >> 6), lane = threadIdx.x & 63;
    const float* xp = x1 + (long)row * D; float v[16]; float ss = 0.f;
#pragma unroll
    for (int i = 0; i < 16; ++i) { v[i] = xp[lane + 64 * i]; ss += v[i] * v[i]; }
    ss = wave_sum(ss);
    const float rs = rsqrtf(ss * (1.0f / D) + EPS);
    float lg[16];
#pragma unroll
    for (int e = 0; e < 16; ++e) lg[e] = 0.f;
#pragma unroll
    for (int i = 0; i < 16; ++i) { const float hv = v[i] * rs * g[lane + 64 * i]; h2[(long)row * D + lane + 64 * i] = hv; const float* wp = wr + (long)(lane + 64 * i) * NE;
#pragma unroll
        for (int e = 0; e < 16; ++e) lg[e] += hv * wp[e]; }
    float mx = -INFINITY;
#pragma unroll
    for (int e = 0; e < 16; ++e) { lg[e] = wave_sum(lg[e]); mx = fmaxf(mx, lg[e]); }
    float den = 0.f;
#pragma unroll
    for (int e = 0; e < 16; ++e) { lg[e] = __expf(lg[e] - mx); den += lg[e]; }
    if (lane < 16) { float mine = 0.f;
#pragma unroll
        for (int e = 0; e < 16; ++e) mine = (lane == e) ? lg[e] : mine;
        aff[(long)lane * S + row] = mine / den; }
}
__global__ void __launch_bounds__(1024) k_topk(const float* aff, int* idx, float* gate) {
    __shared__ float a[S]; const int e = blockIdx.x;
    for (int i = threadIdx.x; i < S; i += 1024) a[i] = aff[(long)e * S + i];
    __syncthreads();
    for (int i = threadIdx.x; i < S; i += 1024) { const float v = a[i]; int rank = 0;
        for (int j = 0; j < S; ++j) { const float u = a[j]; rank += (u > v || (u == v && j < i)) ? 1 : 0; }
        if (rank < CAP) { idx[e * CAP + rank] = i; gate[e * CAP + rank] = v; } }
}
__global__ void k_swiglu(const float* a, const float* u, float* o, long n) { const long i = (long)blockIdx.x * blockDim.x + threadIdx.x; if (i < n) { const float x = a[i]; o[i] = x / (1.f + __expf(-x)) * u[i]; } }
__global__ void k_scatter(const float* y, const int* idx, const float* gate, int es, float* out) {
    const long i = (long)blockIdx.x * blockDim.x + threadIdx.x; if (i >= (long)NE * CAP * D) return;
    const int row = (int)(i / D), c = (int)(i % D), e = row / CAP, sl = row % CAP;
    atomicAdd(out + (long)idx[e * es + sl] * D + c, gate[e * es + sl] * y[i]);
}
static void gemm(hipStream_t st, const float* A, const float* Bm, float* C, int M_, int N, int K, int lda, int ldb, int ldc,
                 int nz = 1, long sA = 0, long sB = 0, long sC = 0, const int* gather = nullptr, int sG = 0) {
    GemmArgs g{}; g.A = A; g.Bm = Bm; g.C = C; g.gather = gather; g.M = M_; g.N = N; g.K = K; g.lda = lda; g.ldb = ldb; g.ldc = ldc; g.sA = sA; g.sB = sB; g.sC = sC; g.sG = sG;
    hipLaunchKernelGGL(k_gemm, dim3(N / 128, M_ / 128, nz), dim3(256), 0, st, g);
}
struct Bump { size_t lo[3], hi[3]; int n, cur; size_t at;
    float* take(size_t nfloats) { size_t bytes = ((nfloats * 4) + 255) & ~(size_t)255;
        while (cur < n && at + bytes > hi[cur]) { ++cur; if (cur < n) at = lo[cur]; }
        if (cur >= n) { fprintf(stderr, "tail scratch exhausted\n"); return nullptr; }
        float* p = (float*)at; at += bytes; return p; } };
}
#endif

extern "C" void kernel_launch(void* const* d_in, const int* in_sizes, int n_in, void* d_out, int out_size, void* d_ws, size_t ws_size, hipStream_t stream) {
    static int grid = 0;
    if (grid == 0) {
        if (n_in != 16 || out_size != M * D || ws_size < WS_END) { fprintf(stderr, "kernel_launch: unexpected problem (n_in %d, out %d, ws %zu)\n", n_in, out_size, ws_size); grid = -1; return; }
        int dev = 0, cus = 0, per_cu = 0;
        if (hipGetDevice(&dev) != hipSuccess || hipDeviceGetAttribute(&cus, hipDeviceAttributeMultiprocessorCount, dev) != hipSuccess) { grid = -1; return; }
        if (hipFuncSetAttribute((const void*)mk_fwd, hipFuncAttributeMaxDynamicSharedMemorySize, LDS_BYTES) != hipSuccess) { fprintf(stderr, "kernel_launch: hipFuncSetAttribute failed\n"); grid = -1; return; }
        if (hipOccupancyMaxActiveBlocksPerMultiprocessor(&per_cu, (const void*)mk_fwd, 512, LDS_BYTES) != hipSuccess || per_cu < 1)
            fprintf(stderr, "kernel_launch: occupancy query reports %d workgroups per CU\n", per_cu);
        (void)hipGetLastError();
        grid = cus;
    }
    if (grid < 0) return;
    (void)hipMemsetAsync((char*)d_ws + WS_CTL, 0, CTL_BYTES, stream);
    Args a{};
    for (int i = 0; i < 16; ++i) a.in[i] = (const float*)d_in[i];
    a.out = (float*)d_out; a.ws = (unsigned char*)d_ws;
#if MK_PER_PHASE
    for (int p = 0; p < MK_HYB; ++p) { a.ph_lo = p; a.ph_hi = p + 1; hipLaunchKernelGGL(mk_fwd, dim3(grid), dim3(512), LDS_BYTES, stream, a);
#ifdef MK_REPEAT_PHASE
        if (p == MK_REPEAT_PHASE) {
#ifdef MK_REPEAT_FLAGS
            a.flags = MK_REPEAT_FLAGS;
#endif
            hipLaunchKernelGGL(mk_fwd, dim3(grid), dim3(512), LDS_BYTES, stream, a); a.flags = 0; }
#endif
    }
#else
    a.ph_lo = 0; a.ph_hi = MK_HYB; hipLaunchKernelGGL(mk_fwd, dim3(grid), dim3(512), LDS_BYTES, stream, a);
#endif
#if MK_HYB < 10
    using namespace tail;
    unsigned char* ws = (unsigned char*)d_ws; float* out = (float*)d_out;
    Bump bp{};
#if MK_HYB <= 2
    bp.n = 3; bp.lo[0] = (size_t)(ws + 17 * MiB); bp.hi[0] = (size_t)(ws + 113 * MiB); bp.lo[1] = (size_t)(ws + 118 * MiB); bp.hi[1] = (size_t)(ws + 182 * MiB); bp.lo[2] = (size_t)(ws + 422 * MiB); bp.hi[2] = (size_t)(ws + 512 * MiB);
#elif MK_HYB <= 4
    bp.n = 3; bp.lo[0] = (size_t)(ws + 17 * MiB); bp.hi[0] = (size_t)(ws + 113 * MiB); bp.lo[1] = (size_t)(ws + 182 * MiB); bp.hi[1] = (size_t)(ws + 422 * MiB); bp.lo[2] = (size_t)(ws + 470 * MiB); bp.hi[2] = (size_t)(ws + 512 * MiB);
#elif MK_HYB <= 6
    bp.n = 1; bp.lo[0] = (size_t)(ws + 182 * MiB); bp.hi[0] = (size_t)(ws + 512 * MiB);
#else
    bp.n = 1; bp.lo[0] = (size_t)(ws + 182 * MiB); bp.hi[0] = (size_t)(ws + 512 * MiB);
#endif
    bp.cur = 0; bp.at = bp.lo[0];
    float* ya = bp.take((size_t)S * 256); float* yb = bp.take((size_t)S * 512);
    float* yap = bp.take((size_t)S * D); float* ybp = bp.take((size_t)S * D); float* merged = bp.take((size_t)S * D); float* tmp = bp.take((size_t)S * D);
    float* h2 = bp.take((size_t)S * D); float* aff = bp.take((size_t)NE * S); int* idx = (int*)bp.take((size_t)NE * CAP); float* gate = bp.take((size_t)NE * CAP);
    float* ea = bp.take((size_t)NE * CAP * FF); float* eu = bp.take((size_t)NE * CAP * FF);
    const float* x = a.in[0];
    for (int b = 0; b < NB; ++b) {
        const float* xb = x + (size_t)b * S * D; float* ob = out + (size_t)b * S * D;
        const bf16_t* gates_b = (const bf16_t*)d_out + (size_t)b * S * 2048;
#if MK_HYB <= 2
        hipLaunchKernelGGL(k_dil_attn, dim3(S), dim3(256), 0, stream, (const bf16_t*)(ws + WS_QD), (const bf16_t*)(ws + WS_KD), (const bf16_t*)(ws + WS_VTD), ya, b);
        hipLaunchKernelGGL(k_na_attn, dim3(S * 2), dim3(256), 0, stream, (const bf16_t*)(ws + WS_QN), (const bf16_t*)(ws + WS_KN), (const bf16_t*)(ws + WS_VTN), a.in[7], yb, b);
#elif MK_HYB <= 3
        hipLaunchKernelGGL(k_bf2f, dim3(S * 256 / 256), dim3(256), 0, stream, (const bf16_t*)(ws + WS_YA) + (size_t)b * S * 256, ya, (long)S * 256);
        hipLaunchKernelGGL(k_bf2f, dim3(S * 512 / 256), dim3(256), 0, stream, (const bf16_t*)(ws + WS_YB) + (size_t)b * S * 512, yb, (long)S * 512);
#endif
#if MK_HYB <= 3
        gemm(stream, ya, a.in[8], yap, S, D, 256, 256, D, D);
        gemm(stream, yb, a.in[9], ybp, S, D, 512, 512, D, D);
        hipLaunchKernelGGL(k_merge, dim3((S * D) / 256), dim3(256), 0, stream, gates_b, yap, ybp, merged);
        gemm(stream, merged, a.in[10], tmp, S, D, D, D, D, D);
        hipLaunchKernelGGL(k_add, dim3((S * D) / 256), dim3(256), 0, stream, xb, tmp, ob, (long)S * D);
#elif MK_HYB == 4
        hipLaunchKernelGGL(k_bf2f, dim3(S * D / 256), dim3(256), 0, stream, (const bf16_t*)(ws + WS_HB) + (size_t)b * S * D, merged, (long)S * D);
        gemm(stream, merged, a.in[10], tmp, S, D, D, D, D, D);
        hipLaunchKernelGGL(k_add, dim3((S * D) / 256), dim3(256), 0, stream, xb, tmp, ob, (long)S * D);
#endif
        const int* idx_b = idx; const float* gate_b = gate; int es = CAP;
#if MK_HYB <= 5
        hipLaunchKernelGGL(k_norm_router, dim3(S / 4), dim3(256), 0, stream, ob, a.in[11], a.in[12], h2, aff);
        hipLaunchKernelGGL(k_topk, dim3(NE), dim3(1024), 0, stream, aff, idx, gate);
#else
        hipLaunchKernelGGL(k_bf2f, dim3(S * D / 256), dim3(256), 0, stream, (const bf16_t*)(ws + WS_HB) + (size_t)b * S * D, h2, (long)S * D);
        idx_b = (const int*)(ws + WS_IDX) + (size_t)b * CAP; gate_b = (const float*)(ws + WS_GLIST) + (size_t)b * CAP; es = NB * CAP;
#endif
        gemm(stream, h2, a.in[13], ea, CAP, FF, D, D, FF, FF, NE, 0, (long)D * FF, (long)CAP * FF, idx_b, es);
        gemm(stream, h2, a.in[14], eu, CAP, FF, D, D, FF, FF, NE, 0, (long)D * FF, (long)CAP * FF, idx_b, es);
        hipLaunchKernelGGL(k_swiglu, dim3((NE * CAP * FF) / 256), dim3(256), 0, stream, ea, eu, ea, (long)NE * CAP * FF);
        gemm(stream, ea, a.in[15], eu, CAP, D, FF, FF, D, D, NE, (long)CAP * FF, (long)FF * D, (long)CAP * D);
        hipLaunchKernelGGL(k_scatter, dim3((NE * CAP * D) / 256), dim3(256), 0, stream, eu, idx_b, gate_b, es, ob);
    }
#endif
}
```

```cpp
#define MK_HYB 10
#define MK_PER_PHASE 0
#include <hip/hip_runtime.h>
#include <stdint.h>
#include <stdio.h>

#define LAS __attribute__((address_space(3)))
#define GAS __attribute__((address_space(1)))
typedef unsigned short bf16_t;
typedef short bf16x8 __attribute__((ext_vector_type(8)));
typedef short s16x4 __attribute__((ext_vector_type(4)));
typedef float f32x2 __attribute__((ext_vector_type(2)));
typedef float f32x4 __attribute__((ext_vector_type(4)));
typedef float f32x16 __attribute__((ext_vector_type(16)));
typedef unsigned u32x2 __attribute__((ext_vector_type(2)));
typedef unsigned u32x4 __attribute__((ext_vector_type(4)));
typedef __bf16 bf16x2_t __attribute__((ext_vector_type(2)));

constexpr int D = 1024, NB = 8, S = 4096, HD = 64, M = NB * S;
constexpr int DILH = 12, NAH = 8, GW = 64, NE = 16, CAP = 512, FF = 1024, INC = 5888;
constexpr float EPS = 1e-6f;
constexpr float LOG2E = 1.4426950408889634f;

constexpr size_t MiB = 1u << 20;
constexpr size_t WS_CTL = 0, CTL_BYTES = 1 * MiB;
constexpr size_t WS_ROPE = 1 * MiB;
constexpr size_t WS_WIN = 2 * MiB;
constexpr size_t WS_PA = WS_WIN + (size_t)INC * D * 2;
constexpr size_t WS_PB = 14 * MiB;
constexpr size_t WS_WO = 15 * MiB;
constexpr size_t WS_WGU = 17 * MiB;
constexpr size_t WS_WD = 81 * MiB;
constexpr size_t WS_AFF = 113 * MiB;
constexpr size_t WS_TOKSLOT = 115 * MiB;
constexpr size_t WS_IDX = 117 * MiB;
constexpr size_t WS_GLIST = WS_IDX + 256 * 1024;
constexpr size_t WS_HB = 118 * MiB;
constexpr size_t WS_QD = 182 * MiB, WS_KD = 230 * MiB, WS_VTD = 278 * MiB;
constexpr size_t WS_QN = 326 * MiB, WS_KN = 358 * MiB, WS_VTN = 390 * MiB;
constexpr size_t WS_H = 182 * MiB;
constexpr size_t WS_Y = 310 * MiB;
constexpr size_t WS_YA = 422 * MiB;
constexpr size_t WS_YB = 438 * MiB;
constexpr size_t WS_DLT = 438 * MiB;
constexpr size_t WS_END = 502 * MiB;
constexpr int CW_TMO = 0, CW_BAR = 4096;

constexpr int RING_BYTES = 131072;
constexpr int LDS_L_OFF = RING_BYTES;
constexpr int LDS_IDX_OFF = RING_BYTES + 2048;
constexpr int LDS_MISC_OFF = RING_BYTES + 4096;
constexpr int LDS_BYTES = 147456;

__device__ __forceinline__ unsigned pk2(float lo, float hi) { f32x2 v = {lo, hi}; return __builtin_bit_cast(unsigned, __builtin_convertvector(v, bf16x2_t)); }
__device__ __forceinline__ float bflo(unsigned w) { return __builtin_bit_cast(float, w << 16); }
__device__ __forceinline__ float bfhi(unsigned w) { return __builtin_bit_cast(float, w & 0xffff0000u); }
__device__ __forceinline__ float shx(float v, int mask, int lane) { return __builtin_bit_cast(float, __builtin_amdgcn_ds_bpermute((lane ^ mask) << 2, __builtin_bit_cast(int, v))); }
__device__ __forceinline__ int shxi(int v, int mask, int lane) { return __builtin_amdgcn_ds_bpermute((lane ^ mask) << 2, v); }
__device__ __forceinline__ float wave_sum(float v, int lane) {
#pragma unroll
    for (int o = 1; o < 64; o <<= 1) v += shx(v, o, lane);
    return v;
}
__device__ __forceinline__ float wave_max(float v, int lane) {
#pragma unroll
    for (int o = 1; o < 64; o <<= 1) v = fmaxf(v, shx(v, o, lane));
    return v;
}
__device__ __forceinline__ float sigmoidf_fast(float x) { return __builtin_amdgcn_rcpf(1.0f + __builtin_amdgcn_exp2f(-x * LOG2E)); }
__device__ __forceinline__ int fresh_lane() { int l; asm volatile("v_mbcnt_lo_u32_b32 %0, -1, 0\n\tv_mbcnt_hi_u32_b32 %0, -1, %0" : "=v"(l)); return l; }
#ifndef MK_WT
#define MK_WT 0
#endif
struct WtBuf { __amdgpu_buffer_rsrc_t r; const char* base; };
__device__ __forceinline__ WtBuf wt_make(const void* base, unsigned bytes) { WtBuf b; b.r = __builtin_amdgcn_make_buffer_rsrc((void*)base, 0, bytes, 0x00020000); b.base = (const char*)base; return b; }
__device__ __forceinline__ void wt_store16(const WtBuf& b, const void* p, u32x4 w) {
#if MK_WT
    __builtin_amdgcn_raw_buffer_store_b128(w, b.r, (unsigned)((const char*)p - b.base), 0, 16);
#else
    *(u32x4*)p = w;
#endif
}
__device__ __forceinline__ void wt_store8(const WtBuf& b, const void* p, u32x2 w) {
#if MK_WT
    __builtin_amdgcn_raw_buffer_store_b64(w, b.r, (unsigned)((const char*)p - b.base), 0, 16);
#else
    *(u32x2*)p = w;
#endif
}
#define LDS_WAIT() asm volatile("s_waitcnt lgkmcnt(0)" ::: "memory")
#define VM_WAIT() asm volatile("s_waitcnt vmcnt(0)" ::: "memory")

#define XB_TMO      128
#define XB_XCNT(j)  (256  + 64 * (j))
#define XB_XSUB(j)  (1280 + 64 * (j))
#define XB_XGEN(j)  (2304 + 64 * (j))
#define XB_TOP      3328
#define XB_TOPGEN   3392
#define XCD_BAR_WORDS 3456
#define XB_SPIN_CAP (1u << 18)
__device__ __forceinline__ unsigned xb_ld(unsigned* p)              { return __hip_atomic_load(p, __ATOMIC_RELAXED, __HIP_MEMORY_SCOPE_AGENT); }
__device__ __forceinline__ unsigned xb_add(unsigned* p, unsigned v) { return __hip_atomic_fetch_add(p, v, __ATOMIC_RELAXED, __HIP_MEMORY_SCOPE_AGENT); }
__device__ __forceinline__ unsigned xb_xcc_id() { return (unsigned)__builtin_amdgcn_s_getreg((3 << 11) | 20) & 0xFu; }
#define XB_SPIN(cond, bar) do { unsigned _sp = 0; while (cond) { __builtin_amdgcn_s_sleep(1); \
    if ((++_sp & 255u) == 0u) { if (xb_ld(&(bar)[XB_TMO])) break; if (_sp > XB_SPIN_CAP) { atomicAdd(&(bar)[XB_TMO], 1u); break; } } } } while (0)
struct XcdBarrier { unsigned* bar; unsigned x; volatile LAS unsigned* st; };
__device__ __forceinline__ XcdBarrier xcd_barrier_post(unsigned* bar, volatile LAS unsigned* st, const bool first) {
    XcdBarrier b; b.bar = bar; b.x = xb_xcc_id(); b.st = st;
    if (first) (void)xb_add(&bar[XB_XCNT(b.x)], 1u);
    return b;
}
__device__ __forceinline__ void xcd_barrier_complete(unsigned* bar, unsigned x, unsigned& nloc, unsigned& nx) {
    const unsigned G = gridDim.x * gridDim.y * gridDim.z;
    unsigned sum, cnt, mine, sp = 0u;
    for (;;) {
        sum = 0u; cnt = 0u; mine = 0u;
#pragma unroll
        for (unsigned j = 0; j < 16; ++j) { const unsigned c = xb_ld(&bar[XB_XCNT(j)]); sum += c; cnt += (c > 0u) ? 1u : 0u; mine = (j == x) ? c : mine; }
        if (sum == G) break;
        __builtin_amdgcn_s_sleep(1);
        if ((++sp & 255u) == 0u) { if (xb_ld(&bar[XB_TMO])) break; if (sp > XB_SPIN_CAP) { atomicAdd(&bar[XB_TMO], 1u); break; } }
    }
    nloc = mine > 0u ? mine : 1u; nx = cnt > 0u ? cnt : 1u;
}
__device__ __forceinline__ void xcd_barrier(const XcdBarrier& b, const bool first) {
    asm volatile("s_waitcnt vmcnt(0)" ::: "memory");
    __syncthreads();
    if (first) {
        unsigned* bar = b.bar;
        __builtin_amdgcn_s_waitcnt(0);
        unsigned nloc = b.st[0], nx = b.st[1];
        if (nloc == 0u) { xcd_barrier_complete(bar, b.x, nloc, nx); b.st[0] = nloc; b.st[1] = nx; }
        const unsigned old = xb_add(&bar[XB_XSUB(b.x)], 1u);
        const unsigned gen = old / nloc;
        if (old + 1u == (gen + 1u) * nloc) {
            __builtin_amdgcn_fence(__ATOMIC_RELEASE, "agent");
            asm volatile("s_waitcnt vmcnt(0)" ::: "memory");
            const unsigned og = xb_add(&bar[XB_TOP], 1u);
            const unsigned tg = og / nx;
            if (og + 1u == (tg + 1u) * nx) xb_add(&bar[XB_TOPGEN], 1u);
            else XB_SPIN(xb_ld(&bar[XB_TOPGEN]) == tg, bar);
            __builtin_amdgcn_fence(__ATOMIC_ACQUIRE, "agent");
            xb_add(&bar[XB_XGEN(b.x)], 1u);
            asm volatile("s_waitcnt vmcnt(0)" ::: "memory");
        } else {
            XB_SPIN(xb_ld(&bar[XB_XGEN(b.x)]) == gen, bar);
            __builtin_amdgcn_fence(__ATOMIC_ACQUIRE, "agent");
            asm volatile("s_waitcnt vmcnt(0)" ::: "memory");
        }
    }
    __syncthreads();
}

namespace g8 {
constexpr int BM = 256, BK = 64, HALF = 128, HTB = HALF * BK * 2, STAGE_BYTES = 8 * HTB;
__host__ __device__ __forceinline__ int lds_byte(int r, int c) { const int st = (r >> 4) * 2 + (c >> 5), rr = r & 15, cc = c & 31, ob = rr * 64 + cc * 2; return st * 1024 + (ob ^ (((ob >> 9) & 1) << 5)); }
__host__ __device__ __forceinline__ void stage_rc(int b, int& R, int& C) { const int st = b / 1024, sb = b % 1024, swz = sb ^ (((sb >> 9) & 1) << 5); R = (st >> 1) * 16 + swz / 64; C = (st & 1) * 32 + (swz % 64) / 2; }
__host__ __device__ __forceinline__ int perm32(int rho) { const int n = rho >> 4, i = rho & 15; return 8 * (i >> 2) + 4 * n + (i & 3); }

__device__ __forceinline__ bool tile_order(long L, int nM, int nN, int& pm, int& pn) {
    const int nwg = nM * nN; if (L >= nwg) return false;
    int wgid = (int)L; { const int q = nwg / 8, r = nwg % 8, xcd = wgid % 8, off = wgid / 8; wgid = (xcd < r ? xcd * (q + 1) : r * (q + 1) + (xcd - r) * q) + off; }
    const int nig = 8 * nN, gid = wgid / nig, fm = gid * 8, gsz = (nM - fm) < 8 ? (nM - fm) : 8;
    pm = fm + ((wgid % nig) % gsz); pn = (wgid % nig) / gsz; return true;
}

struct Unit {
    const char* A; const char* B;
    unsigned sA, sB;
    char* p;
    int nt, ty;
    int e0, e1, e2, e3;
};

#ifndef G8_ALIGN_EPI
#define G8_ALIGN_EPI true
#endif
template <class Epi, class Sched, bool GATHER>
__device__ __forceinline__ void gemm_phase(LAS unsigned char* lds, const Sched& S, const Epi& E, const int wid) {
    const int lane = fresh_lane();
    const int tid = wid * 64 + lane, wr = wid >> 2, wc = wid & 3, fr = lane & 15, fq = lane >> 4;
    unsigned rA[2], rB[2], c2[2];
#pragma unroll
    for (int i = 0; i < 2; ++i) { int R, C; stage_rc(tid * 16 + i * 8192, R, C); rA[i] = (unsigned)R; rB[i] = (unsigned)(Epi::PERM ? ((R & ~31) + perm32(R & 31)) : R); c2[i] = (unsigned)(C * 2);
        if constexpr (Epi::COL64) rB[i] = (unsigned)(64 * (R >> 5) + perm32(R & 31)); }
    const unsigned ldsw = (unsigned)wid * 1024u;
    const int aoff = lds_byte(wr * 64 + fr, fq * 8), boff = lds_byte(wc * 32 + fr, fq * 8);
    LAS int* idxbuf = (LAS int*)(lds + LDS_IDX_OFF);
#define G8_SA(b, h) (((b) * 2 + (h)) * HTB)
#define G8_SB(b, h) ((4 + (b) * 2 + (h)) * HTB)
#define G8_STAGE(bufoff, gbase, stride, rr) do { _Pragma("unroll") for (int _i = 0; _i < 2; ++_i) \
        __builtin_amdgcn_global_load_lds((const unsigned*)((const char*)(gbase) + ((rr)[_i] * (stride) + c2[_i])), (LAS unsigned*)(lds + (bufoff) + ldsw + _i * 8192), 16, 0, 0); } while (0)
#define G8_STAGE_G(bufoff, gbase, offs) do { _Pragma("unroll") for (int _i = 0; _i < 2; ++_i) \
        __builtin_amdgcn_global_load_lds((const unsigned*)((const char*)(gbase) + (offs)[_i]), (LAS unsigned*)(lds + (bufoff) + ldsw + _i * 8192), 16, 0, 0); } while (0)
#define G8_LDA(dst, b, h) do { _Pragma("unroll") for (int m = 0; m < 4; ++m) _Pragma("unroll") for (int k = 0; k < 2; ++k) dst[m][k] = *(const LAS bf16x8*)(lds + G8_SA(b, h) + aoff + m * 2048 + k * 1024); } while (0)
#define G8_LDB(dst, b, h) do { _Pragma("unroll") for (int n = 0; n < 2; ++n) _Pragma("unroll") for (int k = 0; k < 2; ++k) dst[n][k] = *(const LAS bf16x8*)(lds + G8_SB(b, h) + boff + n * 2048 + k * 1024); } while (0)
#define G8_MMA(ai, bj, At, Bt) do { __builtin_amdgcn_s_setprio(1); _Pragma("unroll") for (int m = 0; m < 4; ++m) _Pragma("unroll") for (int n = 0; n < 2; ++n) _Pragma("unroll") for (int k = 0; k < 2; ++k) \
        acc[ai][bj][m][n] = __builtin_amdgcn_mfma_f32_16x16x32_bf16(Bt[n][k], At[m][k], acc[ai][bj][m][n], 0, 0, 0); __builtin_amdgcn_s_setprio(0); } while (0)
#define G8_WAIT_V(n) asm volatile("s_waitcnt vmcnt(" #n ")" ::: "memory")
#define G8_WAIT_L(n) asm volatile("s_waitcnt lgkmcnt(" #n ")" ::: "memory")
#define G8_BAR __builtin_amdgcn_s_barrier()
#define G8_SCHED __builtin_amdgcn_sched_barrier(0)
#define G8_STA(bufoff, u, go, h, koff) do { if constexpr (GATHER) { G8_STAGE_G(bufoff, (u).A + (koff), (go)[h]); } else { G8_STAGE(bufoff, (u).A + (size_t)(h) * HALF * (u).sA + (koff), (u).sA, rA); } } while (0)
#define G8_STB(bufoff, u, h, koff) G8_STAGE(bufoff, (u).B + (size_t)(h) * (Epi::COL64 ? 32 : HALF) * (u).sB + (koff), (u).sB, rB)
    Unit cur, nxt; int ui = 0;
    if (!S.next(0, cur)) return;
    f32x4 acc[2][2][4][2];
#pragma unroll
    for (int a = 0; a < 2; ++a)
#pragma unroll
        for (int b = 0; b < 2; ++b)
#pragma unroll
            for (int m = 0; m < 4; ++m)
#pragma unroll
                for (int n = 0; n < 2; ++n) acc[a][b][m][n] = (f32x4){0.f, 0.f, 0.f, 0.f};
    bf16x8 At[4][2], B0[2][2], B1[2][2];
    unsigned gcur[2][2], gnxt[2][2];
    if constexpr (GATHER) {
        if (wid == 0) __builtin_amdgcn_global_load_lds((const unsigned*)((const int*)cur.p + lane * 4), (LAS unsigned*)(idxbuf), 16, 0, 0);
        G8_WAIT_V(0); G8_BAR;
#pragma unroll
        for (int h = 0; h < 2; ++h)
#pragma unroll
            for (int i = 0; i < 2; ++i) gcur[h][i] = (unsigned)idxbuf[h * HALF + (int)rA[i]] * cur.sA + c2[i];
        G8_WAIT_L(0);
    }
#define G8_KOFF(u, t) ((size_t)((t) * 128))
    { const size_t k0 = G8_KOFF(cur, 0); G8_STB(G8_SB(0, 0), cur, 0, k0); G8_STB(G8_SB(0, 1), cur, 1, k0); G8_STA(G8_SA(0, 0), cur, gcur, 0, k0); G8_STA(G8_SA(0, 1), cur, gcur, 1, k0); }
    if (wr == 1) G8_BAR;
    G8_WAIT_V(2); G8_BAR;
    { const size_t k1 = G8_KOFF(cur, 1); G8_STB(G8_SB(1, 0), cur, 0, k1); G8_STA(G8_SA(1, 0), cur, gcur, 0, k1); G8_STB(G8_SB(1, 1), cur, 1, k1); }
    G8_WAIT_V(6); G8_BAR;
    for (;;) {
        const bool has_next = S.next(ui + 1, nxt);
        if (!has_next) nxt = cur;
        if constexpr (GATHER) {
            if (has_next && wid == 0) __builtin_amdgcn_global_load_lds((const unsigned*)((const int*)nxt.p + lane * 4), (LAS unsigned*)(idxbuf + ((ui + 1) & 1) * 256), 16, 0, 0);
        }
        const int nt = cur.nt;
        for (int t = 0; t < nt; t += 2) {
            const bool last = (t == nt - 2);
            const size_t k1 = G8_KOFF(cur, t + 1);
            const size_t k2 = last ? G8_KOFF(nxt, 0) : G8_KOFF(cur, t + 2), k3 = last ? G8_KOFF(nxt, 1) : G8_KOFF(cur, t + 3);
            if constexpr (GATHER) {
                if (last) {
                    if (has_next) {
#pragma unroll
                        for (int h = 0; h < 2; ++h)
#pragma unroll
                            for (int i = 0; i < 2; ++i) gnxt[h][i] = (unsigned)idxbuf[((ui + 1) & 1) * 256 + h * HALF + (int)rA[i]] * nxt.sA + c2[i];
                    } else {
#pragma unroll
                        for (int h = 0; h < 2; ++h)
#pragma unroll
                            for (int i = 0; i < 2; ++i) gnxt[h][i] = gcur[h][i];
                    }
                }
            }
            G8_LDB(B0, 0, 0); G8_LDB(B1, 0, 1); G8_SCHED; G8_LDA(At, 0, 0); G8_STA(G8_SA(1, 1), cur, gcur, 1, k1);
            G8_WAIT_V(8); G8_WAIT_L(0); G8_BAR; G8_MMA(0, 0, At, B0); G8_MMA(0, 1, At, B1); G8_BAR; G8_SCHED;
            G8_LDA(At, 0, 1);
            if (last) { G8_STB(G8_SB(0, 0), nxt, 0, k2); G8_STB(G8_SB(0, 1), nxt, 1, k2); G8_STA(G8_SA(0, 0), nxt, gnxt, 0, k2); }
            else      { G8_STB(G8_SB(0, 0), cur, 0, k2); G8_STB(G8_SB(0, 1), cur, 1, k2); G8_STA(G8_SA(0, 0), cur, gcur, 0, k2); }
            G8_WAIT_V(8); G8_WAIT_L(0); G8_BAR; G8_MMA(1, 0, At, B0); G8_MMA(1, 1, At, B1); G8_BAR; G8_SCHED;
            G8_LDB(B0, 1, 0); G8_LDB(B1, 1, 1); G8_SCHED; G8_LDA(At, 1, 0);
            if (last) { G8_STA(G8_SA(0, 1), nxt, gnxt, 1, k2); } else { G8_STA(G8_SA(0, 1), cur, gcur, 1, k2); }
            G8_WAIT_V(8); G8_WAIT_L(0); G8_BAR; G8_MMA(0, 0, At, B0); G8_MMA(0, 1, At, B1); G8_BAR; G8_SCHED;
            G8_LDA(At, 1, 1);
            if (last) { G8_STB(G8_SB(1, 0), nxt, 0, k3); G8_STB(G8_SB(1, 1), nxt, 1, k3); G8_STA(G8_SA(1, 0), nxt, gnxt, 0, k3); }
            else      { G8_STB(G8_SB(1, 0), cur, 0, k3); G8_STB(G8_SB(1, 1), cur, 1, k3); G8_STA(G8_SA(1, 0), cur, gcur, 0, k3); }
            G8_WAIT_V(8); G8_WAIT_L(0); G8_BAR; G8_MMA(1, 0, At, B0); G8_MMA(1, 1, At, B1); G8_BAR; G8_SCHED;
        }
        if constexpr (G8_ALIGN_EPI) { if (wr == 0) G8_BAR; }
        const bool keep = E(acc, cur, wr, wc, fr, fq);
        if (!has_next) break;
        if (!keep) {
#pragma unroll
        for (int a = 0; a < 2; ++a)
#pragma unroll
            for (int b = 0; b < 2; ++b)
#pragma unroll
                for (int m = 0; m < 4; ++m)
#pragma unroll
                    for (int n = 0; n < 2; ++n) acc[a][b][m][n] = (f32x4){0.f, 0.f, 0.f, 0.f};
        }
        cur = nxt; ++ui;
        if constexpr (GATHER) {
#pragma unroll
            for (int h = 0; h < 2; ++h)
#pragma unroll
                for (int i = 0; i < 2; ++i) gcur[h][i] = gnxt[h][i];
        }
        if constexpr (G8_ALIGN_EPI) { if (wr == 1) G8_BAR; }
    }
    G8_WAIT_V(0);
    if constexpr (!G8_ALIGN_EPI) { if (wr == 0) G8_BAR; }
    G8_BAR;
#undef G8_SA
#undef G8_SB
#undef G8_STAGE
#undef G8_STAGE_G
#undef G8_LDA
#undef G8_LDB
#undef G8_MMA
#undef G8_WAIT_V
#undef G8_WAIT_L
#undef G8_BAR
#undef G8_SCHED
#undef G8_STA
#undef G8_STB
#undef G8_KOFF
}
}
struct Frame {
    LAS unsigned char* lds;
    int tid, lane, wave, vcu, G;
    float* out; unsigned char* ws;
};
__device__ __forceinline__ void phase_ids(Frame& F) { const int l = fresh_lane(); F.lane = l; F.tid = F.wave * 64 + l; }
enum { IN_X = 0, IN_NORM1 = 1, IN_WIN = 2, IN_DQG = 3, IN_DKG = 4, IN_NQG = 5, IN_NKG = 6, IN_RPB = 7, IN_WDIL = 8, IN_WNA = 9, IN_WOUT = 10, IN_NORM2 = 11, IN_WROUTER = 12, IN_WGATE = 13, IN_WUP = 14, IN_WDOWN = 15 };
__device__ __forceinline__ const float* inptr(int k) {
    int off = k * 8; asm volatile("" : "+s"(off));
    const __attribute__((address_space(4))) char* ka = (const __attribute__((address_space(4))) char*)__builtin_amdgcn_kernarg_segment_ptr();
    return *(const float* const __attribute__((address_space(4)))*)(ka + off);
}
__device__ __forceinline__ int dil_of(int g) { return g == 0 ? 1 : (g == 1 ? 4 : 16); }

constexpr int KT = 16;
struct SchedQKd {
    const char* hb; const char* win; char* qd; char* kd; int G, c;
    __device__ __forceinline__ bool next(int i, g8::Unit& u) const { return at((long)i * G + c, u); }
    __device__ __forceinline__ bool at(long Lu, g8::Unit& u) const {
        int pm, pn; if (!g8::tile_order(Lu, 128, 6, pm, pn)) return false;
        const int b = pm >> 4, j = pm & 15, which = pn / 3, g = pn % 3, d = dil_of(g), L = S / d, pos0 = j * 256, r = pos0 / L, u0 = pos0 % L;
        u.A = hb + ((size_t)b * S + (size_t)u0 * d + r) * (D * 2); u.sA = (unsigned)(d * D * 2);
        u.B = win + (size_t)pn * 256 * (D * 2); u.sB = D * 2;
        u.p = (which ? kd : qd) + ((size_t)(b * DILH + g * 4) * S + pos0) * (HD * 2);
        u.e0 = u0; u.e1 = d; u.e2 = r; u.e3 = which; u.nt = KT; u.ty = 0;
        return true;
    }
};
struct SchedQKn {
    const char* hb; const char* win; char* qn; char* kn; int G, c;
    __device__ __forceinline__ bool next(int i, g8::Unit& u) const { return at((long)i * G + c, u); }
    __device__ __forceinline__ bool at(long L, g8::Unit& u) const {
        int pm, pn; if (!g8::tile_order(L, 128, 4, pm, pn)) return false;
        const int b = pm >> 4, j = pm & 15, which = pn >> 1, hh = pn & 1;
        u.A = hb + (size_t)pm * 256 * (D * 2); u.sA = D * 2;
        u.B = win + (size_t)(9 + pn) * 256 * (D * 2); u.sB = D * 2;
        u.p = (which ? kn : qn) + ((size_t)(b * NAH + hh * 4) * S + j * 256) * (HD * 2);
        u.e0 = j * 256; u.e1 = 1; u.e2 = 0; u.e3 = which; u.nt = KT; u.ty = 1;
        return true;
    }
};
struct SchedVt {
    const char* hb; const char* win; char* vtd; char* vtn; int G, c;
    __device__ __forceinline__ bool next(int i, g8::Unit& u) const { return at((long)i * G + c, u); }
    __device__ __forceinline__ bool at(long Lu, g8::Unit& u) const {
        int pm, pn; if (!g8::tile_order(Lu, 5, 128, pm, pn)) return false;
        const int b = pn >> 4, j = pn & 15, pos0 = j * 256;
        const int d = pm < 3 ? dil_of(pm) : 1, L = S / d, r = pos0 / L, u0 = pos0 % L;
        u.A = win + (size_t)(pm < 3 ? 6 + pm : 10 + pm) * 256 * (D * 2); u.sA = D * 2;
        u.B = hb + ((size_t)b * S + (size_t)u0 * d + r) * (D * 2); u.sB = (unsigned)(d * D * 2);
        u.p = (pm < 3 ? vtd + ((size_t)(b * DILH + pm * 4) * HD * S + (size_t)pos0 * HD) * 2 : vtn + ((size_t)(b * NAH + (pm - 3) * 4) * HD * S + (size_t)pos0 * HD) * 2);
        u.e0 = 0; u.e1 = 0; u.e2 = 0; u.e3 = pm < 3 ? 0 : 1; u.nt = KT; u.ty = 3;
        return true;
    }
};
struct SchedDense {
    const char* A; const char* B; unsigned lda, ldb; int nM, nN, G, c, kt;
    __device__ __forceinline__ bool next(int i, g8::Unit& u) const {
        int pm, pn; if (!g8::tile_order((long)i * G + c, nM, nN, pm, pn)) return false;
        u.A = A + (size_t)pm * 256 * lda; u.sA = lda; u.B = B + (size_t)pn * 256 * ldb; u.sB = ldb;
        u.p = nullptr; u.e0 = pm * 256; u.e1 = pn * 256; u.e2 = 0; u.e3 = 0; u.nt = kt; u.ty = 0;
        return true;
    }
};
struct SchedGU {
    const char* h2; const char* wgu; const int* idx; int G, c;
    __device__ __forceinline__ bool next(int i, g8::Unit& u) const {
        int pm, pn; if (!g8::tile_order((long)i * G + c, 256, 8, pm, pn)) return false;
        const int e = pm >> 4, b = (pm >> 1) & 7;
        u.A = h2 + (size_t)b * S * (D * 2); u.sA = D * 2; u.p = (char*)(idx + (size_t)pm * 256);
        u.B = wgu + ((size_t)e * 2048 + (size_t)pn * 256) * (D * 2); u.sB = D * 2;
        u.e0 = pm * 256; u.e1 = pn * 128; u.e2 = 0; u.e3 = 0; u.nt = KT; u.ty = 0;
        return true;
    }
};
struct SchedDown {
    const char* hbuf; const char* wd; int G, c;
    __device__ __forceinline__ bool next(int i, g8::Unit& u) const {
        const long Lf = (long)i * G + c; if (Lf >= 1024) return false;
        int pm, pn; if (!g8::tile_order(1023 - Lf, 256, 4, pm, pn)) return false;
        const int e = pm >> 4;
        u.A = hbuf + (size_t)pm * 256 * (FF * 2); u.sA = FF * 2;
        u.B = wd + ((size_t)e * 1024 + (size_t)pn * 256) * (FF * 2); u.sB = FF * 2;
        u.p = nullptr; u.e0 = pm * 256; u.e1 = pn * 256; u.e2 = 0; u.e3 = 0; u.nt = KT; u.ty = 0;
        return true;
    }
};
struct SchedGates {
    const char* hb; const char* win; int G, c;
    __device__ __forceinline__ bool at(long L, g8::Unit& u) const {
        int pm, pn; if (!g8::tile_order(L, 128, 8, pm, pn)) return false;
        u.A = hb + (size_t)pm * 256 * (D * 2); u.sA = D * 2; u.B = win + (size_t)(15 + pn) * 256 * (D * 2); u.sB = D * 2;
        u.p = nullptr; u.e0 = pm * 256; u.e1 = pn * 128; u.e2 = 0; u.e3 = 0; u.nt = KT; u.ty = 2;
        return true;
    }
};
struct SchedP1 {
    SchedQKd a; SchedQKn b; SchedGates g; SchedVt v; int G, c;
    __device__ __forceinline__ bool next(int i, g8::Unit& u) const {
        long L = (long)i * G + c;
        if (L < 768) return a.at(L, u); L -= 768;
        if (L < 512) return b.at(L, u); L -= 512;
        if (L < 1024) return g.at(L, u); L -= 1024;
        return v.at(L, u);
    }
};
struct SchedP3 {
    const char* ya; const char* pa; const char* yb; const char* pb; int G, c;
    __device__ __forceinline__ bool next(int i, g8::Unit& u) const {
        int pm, pn; if (!g8::tile_order((long)(i >> 1) * G + c, 128, 4, pm, pn)) return false;
        if (i & 1) { u.A = yb + (size_t)pm * 256 * 1024; u.sA = 1024; u.B = pb + (size_t)pn * 256 * 1024; u.sB = 1024; u.nt = 8; u.ty = 1; }
        else       { u.A = ya + (size_t)pm * 256 * 512;  u.sA = 512;  u.B = pa + (size_t)pn * 256 * 512;  u.sB = 512;  u.nt = 4; u.ty = 0; }
        u.p = nullptr; u.e0 = pm * 256; u.e1 = pn * 256; u.e2 = 0; u.e3 = 0;
        return true;
    }
};

typedef f32x4 (&AccRef)[2][2][4][2];

template <bool ROT> struct EpiQK {
    static constexpr bool PERM = true, COL64 = false;
    const float* gq; const float* gk; const f32x2* rope; float qscale; WtBuf wb;
    __device__ __forceinline__ bool operator()(AccRef acc, const g8::Unit& u, int wr, int wc, int fr, int fq) const { run(acc, u, wr, wc, fr, fq); return false; }
    __device__ __forceinline__ void run(AccRef acc, const g8::Unit& u, int wr, int wc, int fr, int fq) const {
        asm volatile("" : "+v"(fq), "+v"(fr));
        const float* g = u.e3 ? gk : gq; const float sc = u.e3 ? 1.0f : qscale;
        f32x4 rp[2][4];
#define EQK_LOAD(grp, buf) do { const int _R = ((grp) >> 2) * 128 + wr * 64 + ((grp) & 3) * 16 + fr; const f32x4* _p = (const f32x4*)(rope + (size_t)((u.e0 + _R) * u.e1 + u.e2) * 32 + 8 * fq); \
        rp[buf][0] = _p[0]; rp[buf][1] = _p[1]; rp[buf][2] = _p[2]; rp[buf][3] = _p[3]; } while (0)
        if (ROT) { EQK_LOAD(0, 0); }
        float gl[2][8];
#pragma unroll
        for (int bj = 0; bj < 2; ++bj) { const f32x4 a = *(const f32x4*)(g + 32 * bj + 8 * fq), b = *(const f32x4*)(g + 32 * bj + 8 * fq + 4);
            gl[bj][0] = a[0] * sc; gl[bj][1] = a[1] * sc; gl[bj][2] = a[2] * sc; gl[bj][3] = a[3] * sc; gl[bj][4] = b[0] * sc; gl[bj][5] = b[1] * sc; gl[bj][6] = b[2] * sc; gl[bj][7] = b[3] * sc; }
        char* ob = u.p + (size_t)wc * S * (HD * 2);
        const int ln = fq * 16 + fr;
#pragma unroll
        for (int ai = 0; ai < 2; ++ai) {
            float rs[4];
#pragma unroll
            for (int m = 0; m < 4; ++m) { float ss = 0.f;
#pragma unroll
                for (int bj = 0; bj < 2; ++bj)
#pragma unroll
                    for (int n = 0; n < 2; ++n)
#pragma unroll
                        for (int k = 0; k < 4; ++k) { const float t = acc[ai][bj][m][n][k]; ss += t * t; }
                rs[m] = ss; }
#pragma unroll
            for (int m = 0; m < 4; ++m) rs[m] += shx(rs[m], 16, ln);
#pragma unroll
            for (int m = 0; m < 4; ++m) rs[m] += shx(rs[m], 32, ln);
#pragma unroll
            for (int m = 0; m < 4; ++m) rs[m] = rsqrtf(rs[m] * (1.0f / 64.0f) + EPS);
#pragma unroll
            for (int m = 0; m < 4; ++m) {
                const int grp = ai * 4 + m;
                if (ROT) { if (grp + 1 < 8) EQK_LOAD(grp + 1, (grp + 1) & 1); __builtin_amdgcn_sched_barrier(0); }
                const int R = ai * 128 + wr * 64 + m * 16 + fr;
                float v[2][8];
#pragma unroll
                for (int bj = 0; bj < 2; ++bj)
#pragma unroll
                    for (int n = 0; n < 2; ++n)
#pragma unroll
                        for (int k = 0; k < 4; ++k) v[bj][4 * n + k] = acc[ai][bj][m][n][k] * rs[m] * gl[bj][4 * n + k];
                float o[2][8];
                if (ROT) {
                    const f32x4 c0 = rp[grp & 1][0], c1 = rp[grp & 1][1], c2 = rp[grp & 1][2], c3 = rp[grp & 1][3];
                    const float cs[8] = {c0[0], c0[2], c1[0], c1[2], c2[0], c2[2], c3[0], c3[2]}, sn[8] = {c0[1], c0[3], c1[1], c1[3], c2[1], c2[3], c3[1], c3[3]};
#pragma unroll
                    for (int k = 0; k < 8; ++k) { o[0][k] = v[0][k] * cs[k] - v[1][k] * sn[k]; o[1][k] = v[1][k] * cs[k] + v[0][k] * sn[k]; }
                } else {
#pragma unroll
                    for (int k = 0; k < 8; ++k) { o[0][k] = v[0][k]; o[1][k] = v[1][k]; }
                }
#pragma unroll
                for (int bj = 0; bj < 2; ++bj) { u32x4 w; w.x = pk2(o[bj][0], o[bj][1]); w.y = pk2(o[bj][2], o[bj][3]); w.z = pk2(o[bj][4], o[bj][5]); w.w = pk2(o[bj][6], o[bj][7]);
                    char* dst = ROT ? ob + (size_t)(R >> 5) * 4096 + (2 * bj + (fq >> 1)) * 1024 + (fq & 1) * 512 + (R & 31) * 16
                                    : ob + (size_t)(R >> 3) * 1024 + bj * 512 + fq * 128 + (R & 7) * 16;
                    wt_store16(wb, dst, w); }
                if (ROT) __builtin_amdgcn_sched_barrier(0);
            }
        }
#undef EQK_LOAD
    }
};
struct EpiVt {
    static constexpr bool PERM = true, COL64 = false;
    WtBuf wb;
    __device__ __forceinline__ bool operator()(AccRef acc, const g8::Unit& u, int wr, int wc, int fr, int fq) const { run(acc, u, wr, wc, fr, fq); return false; }
    __device__ __forceinline__ void run(AccRef acc, const g8::Unit& u, int wr, int wc, int fr, int fq) const {
#pragma unroll
        for (int ai = 0; ai < 2; ++ai)
#pragma unroll
            for (int m = 0; m < 4; ++m) { const int dim = 16 * m + fr; char* hp = u.p + (size_t)(2 * ai + wr) * (S * HD * 2);
#pragma unroll
                for (int bj = 0; bj < 2; ++bj) { const f32x4 v0 = acc[ai][bj][m][0], v1 = acc[ai][bj][m][1];
                    u32x4 w; w.x = pk2(v0[0], v0[1]); w.y = pk2(v0[2], v0[3]); w.z = pk2(v1[0], v1[1]); w.w = pk2(v1[2], v1[3]);
                    if (u.e3) { wt_store16(wb, hp + (size_t)(16 * bj + 4 * wc + fq) * 1024 + dim * 16, w); }
                    else { char* q = hp + (size_t)(4 * bj + wc) * 4096 + ((dim >> 5) * 2 + (fq >> 1)) * 1024 + (dim & 31) * 16 + (fq & 1) * 8;
                        wt_store8(wb, q, (u32x2){w.x, w.y}); wt_store8(wb, q + 512, (u32x2){w.z, w.w}); } } }
    }
};
template <int ACT> struct EpiBf16 {
    static constexpr bool PERM = true, COL64 = false;
    bf16_t* O; int ldc; int probe; WtBuf wb;
    __device__ __forceinline__ bool operator()(AccRef acc, const g8::Unit& u, int wr, int wc, int fr, int fq) const { run(acc, u, wr, wc, fr, fq); return false; }
    __device__ __forceinline__ void run(AccRef acc, const g8::Unit& u, int wr, int wc, int fr, int fq) const {
        if (probe == 2) return;
#pragma unroll
        for (int ai = 0; ai < 2; ++ai)
#pragma unroll
            for (int m = 0; m < 4; ++m) { bf16_t* rowp = O + (size_t)(u.e0 + ai * 128 + wr * 64 + m * 16 + fr) * ldc + u.e1 + wc * 32 + 8 * fq;
                if (probe == 1) rowp = O + ((size_t)blockIdx.x * 256 + ai * 128 + wr * 64 + m * 16 + fr) * 256 + wc * 32 + 8 * fq;
                if (probe == 3) rowp = O + ((size_t)((blockIdx.x * 8 + wr * 4 + wc) * 8 + ai * 4 + m) * 2) * 512 + (fq * 16 + fr) * 8 - 0;
#pragma unroll
                for (int bj = 0; bj < 2; ++bj) { f32x4 v0 = acc[ai][bj][m][0], v1 = acc[ai][bj][m][1];
                    if (ACT == 1) {
#pragma unroll
                        for (int k = 0; k < 4; ++k) { v0[k] = sigmoidf_fast(v0[k]); v1[k] = sigmoidf_fast(v1[k]); } }
                    u32x4 w; w.x = pk2(v0[0], v0[1]); w.y = pk2(v0[2], v0[3]); w.z = pk2(v1[0], v1[1]); w.w = pk2(v1[2], v1[3]);
                    *(u32x4*)(rowp + bj * 128) = w; } }
    }
};
template <bool ADD> struct EpiGated {
    static constexpr bool PERM = true, COL64 = false;
    bf16_t* O; const bf16_t* gates; int gcol0;
    __device__ __forceinline__ bool operator()(AccRef acc, const g8::Unit& u, int wr, int wc, int fr, int fq) const { run(acc, u, wr, wc, fr, fq); return false; }
    __device__ __forceinline__ void run(AccRef acc, const g8::Unit& u, int wr, int wc, int fr, int fq) const {
        const int col = u.e1 + wc * 32 + 8 * fq;
        u32x4 gw[2][2], ow[2][2];
#define EG_LOAD(grp, buf) do { const size_t _row = (size_t)(u.e0 + ((grp) >> 2) * 128 + wr * 64 + ((grp) & 3) * 16 + fr); _Pragma("unroll") for (int bj = 0; bj < 2; ++bj) { \
        gw[buf][bj] = *(const u32x4*)(gates + _row * 2048 + gcol0 + col + bj * 128); if (ADD) ow[buf][bj] = *(const u32x4*)(O + _row * D + col + bj * 128); } } while (0)
        EG_LOAD(0, 0);
#pragma unroll
        for (int grp = 0; grp < 8; ++grp) {
            const int ai = grp >> 2, m = grp & 3;
            if (grp + 1 < 8) EG_LOAD(grp + 1, (grp + 1) & 1);
            __builtin_amdgcn_sched_barrier(0);
            const size_t row = (size_t)(u.e0 + ai * 128 + wr * 64 + m * 16 + fr);
#pragma unroll
            for (int bj = 0; bj < 2; ++bj) { const f32x4 v0 = acc[ai][bj][m][0], v1 = acc[ai][bj][m][1]; const u32x4 g = gw[grp & 1][bj];
                float r[8] = {v0[0] * bflo(g.x), v0[1] * bfhi(g.x), v0[2] * bflo(g.y), v0[3] * bfhi(g.y), v1[0] * bflo(g.z), v1[1] * bfhi(g.z), v1[2] * bflo(g.w), v1[3] * bfhi(g.w)};
                if (ADD) { const u32x4 o = ow[grp & 1][bj]; r[0] += bflo(o.x); r[1] += bfhi(o.x); r[2] += bflo(o.y); r[3] += bfhi(o.y); r[4] += bflo(o.z); r[5] += bfhi(o.z); r[6] += bflo(o.w); r[7] += bfhi(o.w); }
                u32x4 w; w.x = pk2(r[0], r[1]); w.y = pk2(r[2], r[3]); w.z = pk2(r[4], r[5]); w.w = pk2(r[6], r[7]);
                *(u32x4*)(O + row * D + col + bj * 128) = w; }
            __builtin_amdgcn_sched_barrier(0);
        }
#undef EG_LOAD
    }
};
struct EpiGates {
    static constexpr bool PERM = true, COL64 = false;
    bf16_t* Gt; WtBuf wb;
    __device__ __forceinline__ void run(AccRef acc, const g8::Unit& u, int wr, int wc, int fr, int fq) const {
#pragma unroll
        for (int ai = 0; ai < 2; ++ai)
#pragma unroll
            for (int m = 0; m < 4; ++m) { bf16_t* rowp = Gt + (size_t)(u.e0 + ai * 128 + wr * 64 + m * 16 + fr) * 2048 + u.e1 + wc * 32 + 8 * fq;
                float rho[8], sn[8];
#pragma unroll
                for (int n = 0; n < 2; ++n)
#pragma unroll
                    for (int k = 0; k < 4; ++k) { const float ea = __builtin_amdgcn_exp2f(-acc[ai][0][m][n][k] * LOG2E), en = __builtin_amdgcn_exp2f(-acc[ai][1][m][n][k] * LOG2E);
                        sn[4 * n + k] = __builtin_amdgcn_rcpf(1.0f + en); rho[4 * n + k] = (1.0f + en) * __builtin_amdgcn_rcpf(1.0f + ea); }
                u32x4 w; w.x = pk2(rho[0], rho[1]); w.y = pk2(rho[2], rho[3]); w.z = pk2(rho[4], rho[5]); w.w = pk2(rho[6], rho[7]); wt_store16(wb, rowp, w);
                w.x = pk2(sn[0], sn[1]); w.y = pk2(sn[2], sn[3]); w.z = pk2(sn[4], sn[5]); w.w = pk2(sn[6], sn[7]); wt_store16(wb, rowp + 1024, w); }
    }
};
struct EpiP1 {
    static constexpr bool PERM = true, COL64 = false;
    EpiQK<true> qkd; EpiQK<false> qkn; EpiGates gt; EpiVt vt; int skipmask;
    __device__ __forceinline__ bool operator()(AccRef acc, const g8::Unit& u, int wr, int wc, int fr, int fq) const {
        if ((skipmask >> u.ty) & 1) return false;
        if (u.ty == 0) qkd.run(acc, u, wr, wc, fr, fq);
        else if (u.ty == 1) qkn.run(acc, u, wr, wc, fr, fq);
        else if (u.ty == 2) gt.run(acc, u, wr, wc, fr, fq);
        else vt.run(acc, u, wr, wc, fr, fq);
        return false;
    }
};
struct EpiP3 {
    static constexpr bool PERM = true, COL64 = false;
    bf16_t* O; const bf16_t* Gt; WtBuf wb;
    __device__ __forceinline__ bool operator()(AccRef acc, const g8::Unit& u, int wr, int wc, int fr, int fq) const {
        const int col = u.e1 + wc * 32 + 8 * fq; const int gc = (u.ty ? 1024 : 0) + col;
        u32x4 gw[2][2];
#define EP3_LOAD(grp, buf) do { const size_t _row = (size_t)(u.e0 + ((grp) >> 2) * 128 + wr * 64 + ((grp) & 3) * 16 + fr); _Pragma("unroll") for (int bj = 0; bj < 2; ++bj) gw[buf][bj] = *(const u32x4*)(Gt + _row * 2048 + gc + bj * 128); } while (0)
        EP3_LOAD(0, 0);
#pragma unroll
        for (int grp = 0; grp < 8; ++grp) {
            const int ai = grp >> 2, m = grp & 3;
            if (grp + 1 < 8) EP3_LOAD(grp + 1, (grp + 1) & 1);
            __builtin_amdgcn_sched_barrier(0);
            const size_t row = (size_t)(u.e0 + ai * 128 + wr * 64 + m * 16 + fr);
#pragma unroll
            for (int bj = 0; bj < 2; ++bj) { const u32x4 g = gw[grp & 1][bj];
                const f32x4 s0 = {bflo(g.x), bfhi(g.x), bflo(g.y), bfhi(g.y)}, s1 = {bflo(g.z), bfhi(g.z), bflo(g.w), bfhi(g.w)};
                const f32x4 v0 = acc[ai][bj][m][0] * s0, v1 = acc[ai][bj][m][1] * s1;
                if (u.ty) { u32x4 w; w.x = pk2(v0[0], v0[1]); w.y = pk2(v0[2], v0[3]); w.z = pk2(v1[0], v1[1]); w.w = pk2(v1[2], v1[3]); wt_store16(wb, O + row * D + col + bj * 128, w); }
                else { acc[ai][bj][m][0] = v0; acc[ai][bj][m][1] = v1; } }
            __builtin_amdgcn_sched_barrier(0);
        }
#undef EP3_LOAD
        return u.ty == 0;
    }
};
struct EpiResid {
    static constexpr bool PERM = false, COL64 = false;
    const float* base; float* out;
    __device__ __forceinline__ bool operator()(AccRef acc, const g8::Unit& u, int wr, int wc, int fr, int fq) const { run(acc, u, wr, wc, fr, fq); return false; }
    __device__ __forceinline__ void run(AccRef acc, const g8::Unit& u, int wr, int wc, int fr, int fq) const {
        const int col = u.e1 + wc * 32 + 4 * fq;
        f32x4 bs[3][2][2];
#define ER_LOAD(grp, buf) do { const size_t _off = (size_t)(u.e0 + ((grp) >> 2) * 128 + wr * 64 + ((grp) & 3) * 16 + fr) * D + col; _Pragma("unroll") for (int bj = 0; bj < 2; ++bj) _Pragma("unroll") for (int n = 0; n < 2; ++n) \
        bs[buf][bj][n] = *(const f32x4*)(base + _off + bj * 128 + n * 16); } while (0)
        ER_LOAD(0, 0); ER_LOAD(1, 1);
#pragma unroll
        for (int grp = 0; grp < 8; ++grp) {
            const int ai = grp >> 2, m = grp & 3;
            if (grp + 2 < 8) ER_LOAD(grp + 2, (grp + 2) % 3);
            __builtin_amdgcn_sched_barrier(0);
            const size_t off = (size_t)(u.e0 + ai * 128 + wr * 64 + m * 16 + fr) * D + col;
#pragma unroll
            for (int bj = 0; bj < 2; ++bj)
#pragma unroll
                for (int n = 0; n < 2; ++n) *(f32x4*)(out + off + bj * 128 + n * 16) = bs[grp % 3][bj][n] + acc[ai][bj][m][n];
            __builtin_amdgcn_sched_barrier(0);
        }
#undef ER_LOAD
    }
};
struct EpiSwiGLU {
    static constexpr bool PERM = true, COL64 = false;
    bf16_t* H; int skip; WtBuf wb;
    __device__ __forceinline__ bool operator()(AccRef acc, const g8::Unit& u, int wr, int wc, int fr, int fq) const { run(acc, u, wr, wc, fr, fq); return false; }
    __device__ __forceinline__ void run(AccRef acc, const g8::Unit& u, int wr, int wc, int fr, int fq) const {
        if (skip) return;
#pragma unroll
        for (int ai = 0; ai < 2; ++ai)
#pragma unroll
            for (int m = 0; m < 4; ++m) { bf16_t* rowp = H + (size_t)(u.e0 + ai * 128 + wr * 64 + m * 16 + fr) * FF + u.e1 + wc * 32 + 8 * fq;
                float r[8];
#pragma unroll
                for (int n = 0; n < 2; ++n)
#pragma unroll
                    for (int k = 0; k < 4; ++k) { const float a = acc[ai][0][m][n][k], b = acc[ai][1][m][n][k]; r[4 * n + k] = a * sigmoidf_fast(a) * b; }
                u32x4 w; w.x = pk2(r[0], r[1]); w.y = pk2(r[2], r[3]); w.z = pk2(r[4], r[5]); w.w = pk2(r[6], r[7]);
                wt_store16(wb, rowp, w); }
    }
};
__device__ __forceinline__ void p0_transpose_item(const float* W, int K, int N, bf16_t* WT, int k0, int n0s, int n0d, LAS float* scr, int lane) {
#pragma unroll 8
    for (int i = 0; i < 32; ++i) { const int kk = 2 * i + (lane >> 5); scr[kk * 33 + (lane & 31)] = W[(size_t)(k0 + kk) * N + n0s + (lane & 31)]; }
    LDS_WAIT(); asm volatile("" ::: "memory");
    const int c = lane & 7;
#pragma unroll
    for (int j = 0; j < 4; ++j) { const int n = (lane >> 3) + 8 * j; const LAS float* s = scr + (8 * c) * 33 + n;
        u32x4 o; o.x = pk2(s[0 * 33], s[1 * 33]); o.y = pk2(s[2 * 33], s[3 * 33]); o.z = pk2(s[4 * 33], s[5 * 33]); o.w = pk2(s[6 * 33], s[7 * 33]);
        *(u32x4*)(WT + (size_t)(n0d + n) * K + k0 + 8 * c) = o; }
    LDS_WAIT(); asm volatile("" ::: "memory");
}
__device__ __forceinline__ int win_dst_row(int cg) {
    const int tile = cg >> 3, w = cg & 7;
    const bool qk = (tile < 6) || (tile >= 9 && tile < 13);
    if (tile >= 15) {
        const int isn = tile >= 19, c0 = (cg - (isn ? 152 : 120)) * 32;
        return (15 + (c0 >> 7)) * 256 + isn * 128 + ((c0 & 127) >> 5) * 32;
    }
    if (!qk) return cg * 32;
    const int wc = w >> 1, bj = w & 1;
    return tile * 256 + bj * 128 + wc * 32;
}
__device__ __forceinline__ double dsin_poly(double t) { const double t2 = t * t;
    return t * (1.0 + t2 * (-1.0 / 6 + t2 * (1.0 / 120 + t2 * (-1.0 / 5040 + t2 * (1.0 / 362880 + t2 * (-1.0 / 39916800 + t2 * (1.0 / 6227020800.0))))))); }
__device__ __forceinline__ double dcos_poly(double t) { const double t2 = t * t;
    return 1.0 + t2 * (-0.5 + t2 * (1.0 / 24 + t2 * (-1.0 / 720 + t2 * (1.0 / 40320 + t2 * (-1.0 / 3628800 + t2 * (1.0 / 479001600.0 + t2 * (-1.0 / 87178291200.0))))))); }

__device__ __forceinline__ void p0_prologue(Frame& F) {
    phase_ids(F);
    LAS float* scr = (LAS float*)(F.lds + F.wave * 16384);
    const int gw = F.vcu * 8 + F.wave, NGW = F.G * 8, lane = F.lane;
    bf16_t* WinT = (bf16_t*)(F.ws + WS_WIN); bf16_t* PAt = (bf16_t*)(F.ws + WS_PA); bf16_t* PBt = (bf16_t*)(F.ws + WS_PB); bf16_t* WoT = (bf16_t*)(F.ws + WS_WO);
    bf16_t* WguT = (bf16_t*)(F.ws + WS_WGU); bf16_t* WdT = (bf16_t*)(F.ws + WS_WD);
    const float* w_in = inptr(IN_WIN); const float* w_dil = inptr(IN_WDIL); const float* w_na = inptr(IN_WNA); const float* w_out = inptr(IN_WOUT);
    const float* w_gate = inptr(IN_WGATE); const float* w_up = inptr(IN_WUP); const float* w_down = inptr(IN_WDOWN);
    constexpr int I_IN = 16 * 184, I_PA = 4 * 32, I_PB = 8 * 32, I_WO = 16 * 32, I_E = 16 * 32;
    constexpr int NITEMS = I_IN + I_PA + I_PB + I_WO + NE * 3 * I_E;
    for (int it = gw; it < NITEMS; it += NGW) {
        int r = it;
        if (r < I_IN) { const int kb = r / 184, cg = r % 184; p0_transpose_item(w_in, D, INC, WinT, 64 * kb, 32 * cg, win_dst_row(cg), scr, lane); continue; } r -= I_IN;
        if (r < I_PA) { const int kb = r / 32, cg = r % 32; p0_transpose_item(w_dil, 256, D, PAt, 64 * kb, 32 * cg, 32 * cg, scr, lane); continue; } r -= I_PA;
        if (r < I_PB) { const int kb = r / 32, cg = r % 32; p0_transpose_item(w_na, 512, D, PBt, 64 * kb, 32 * cg, 32 * cg, scr, lane); continue; } r -= I_PB;
        if (r < I_WO) { const int kb = r / 32, cg = r % 32; p0_transpose_item(w_out, D, D, WoT, 64 * kb, 32 * cg, 32 * cg, scr, lane); continue; } r -= I_WO;
        const int e = r / (3 * I_E), q = r % (3 * I_E), wsel = q / I_E, rr = q % I_E, kb = rr / 32, cg = rr % 32;
        if (wsel == 2) { p0_transpose_item(w_down + (size_t)e * FF * D, FF, D, WdT + (size_t)e * D * FF, 64 * kb, 32 * cg, 32 * cg, scr, lane); continue; }
        const int pn = cg >> 2, wcg = cg & 3;
        p0_transpose_item((wsel ? w_up : w_gate) + (size_t)e * D * FF, D, FF, WguT + (size_t)e * 2048 * D, 64 * kb, 32 * cg, pn * 256 + wsel * 128 + wcg * 32, scr, lane);
    }
    bf16_t* HB = (bf16_t*)(F.ws + WS_HB);
    f32x4 gv[4];
#pragma unroll
    for (int j = 0; j < 4; ++j) gv[j] = *(const f32x4*)(inptr(IN_NORM1) + 4 * lane + 256 * j);
    const float* xin = inptr(IN_X);
    for (int m = gw; m < M; m += NGW) {
        const f32x4* xr = (const f32x4*)(xin + (size_t)m * D) + lane; f32x4 v[4]; float s = 0.f;
#pragma unroll
        for (int j = 0; j < 4; ++j) { v[j] = xr[64 * j]; s += (v[j][0] * v[j][0] + v[j][1] * v[j][1]) + (v[j][2] * v[j][2] + v[j][3] * v[j][3]); }
        const float rs = rsqrtf(wave_sum(s, lane) * (1.f / D) + EPS);
        u32x2* o8 = (u32x2*)(HB + (size_t)m * D) + lane;
#pragma unroll
        for (int j = 0; j < 4; ++j) { u32x2 w; w.x = pk2(v[j][0] * rs * gv[j][0], v[j][1] * rs * gv[j][1]); w.y = pk2(v[j][2] * rs * gv[j][2], v[j][3] * rs * gv[j][3]); o8[64 * j] = w; }
    }
    f32x2* rope = (f32x2*)(F.ws + WS_ROPE);
    for (int i = gw * 64 + lane; i < S * 32; i += NGW * 64) {
        const int pos = i >> 5, c = i & 31;
        const float inv = (float)exp2(-(double)c * (13.287712379549449 / 32.0));
        const double ang = (double)((float)pos * inv);
        const double kq = rint(ang * 0.6366197723675814);
        const double t = (ang - kq * 1.5707963267948966) - kq * 6.123233995736766e-17;
        const int q = ((int)kq) & 3;
        const double sv = dsin_poly(t), cv = dcos_poly(t);
        const double sn = (q == 0) ? sv : (q == 1 ? cv : (q == 2 ? -sv : -cv));
        const double cs = (q == 0) ? cv : (q == 1 ? -sv : (q == 2 ? -cv : sv));
        rope[i] = (f32x2){(float)cs, (float)sn};
    }
}
#define MFMA32(a, b, c) __builtin_amdgcn_mfma_f32_32x32x16_bf16((a), (b), (c), 0, 0, 0)
#define MFMA16(a, b, c) __builtin_amdgcn_mfma_f32_16x16x32_bf16((a), (b), (c), 0, 0, 0)
__device__ __forceinline__ int swz9(int tl) { return (tl & ~31) | ((tl ^ (tl >> 5)) & 31); }
__device__ __forceinline__ bf16x8 cat8(s16x4 lo, s16x4 hi) { return __builtin_shufflevector(lo, hi, 0, 1, 2, 3, 4, 5, 6, 7); }

#define SCHED_FENCE() __builtin_amdgcn_sched_barrier(0)
__device__ __forceinline__ void lds_fadd(LAS float* p, float v) { (void)__hip_atomic_fetch_add(p, v, __ATOMIC_RELAXED, __HIP_MEMORY_SCOPE_WORKGROUP); }

template <int NT>
__device__ __forceinline__ void dil_tile64(const bf16_t* Qp, const bf16_t* Kp, const bf16_t* Vp, int p0, int seg0, int seg1, float shift, f32x16 (&O)[NT][2], float (&lsum)[NT], int lane) {
    const int r = lane & 31, hf = lane >> 5;
    const bf16_t* ql = Qp + (size_t)p0 * 64 + lane * 8;
    const bf16_t* kl = Kp + lane * 8;
    const bf16_t* vl = Vp + lane * 8;
    bf16x8 qf[NT][4], kf[2][4], vf[2][2][2];
#pragma unroll
    for (int t = 0; t < NT; ++t)
#pragma unroll
        for (int s = 0; s < 4; ++s) qf[t][s] = *(const bf16x8*)(ql + 2048 * t + 512 * s);
#define DIL_KC(j) ((((p0 + 32 * ((j) - 2)) >= seg0) && ((p0 + 32 * ((j) - 2)) < seg1)) ? (p0 + 32 * ((j) - 2)) : p0)
#define DIL_TV(j) (((p0 + 32 * ((j) - 2)) >= seg0) && ((p0 + 32 * ((j) - 2)) < seg1))
#define DIL_LDK(j, slot) do { const bf16_t* _k = kl + (size_t)DIL_KC(j) * 64; _Pragma("unroll") for (int s = 0; s < 4; ++s) kf[slot][s] = *(const bf16x8*)(_k + 512 * s); } while (0)
#define DIL_LDV(j, slot) do { const bf16_t* _v = vl + (size_t)DIL_KC(j) * 64; _Pragma("unroll") for (int mt = 0; mt < 2; ++mt) _Pragma("unroll") for (int s2 = 0; s2 < 2; ++s2) vf[slot][mt][s2] = *(const bf16x8*)(_v + (mt * 2 + s2) * 512); } while (0)
    DIL_LDK(0, 0); DIL_LDV(0, 0);
    SCHED_FENCE();
#pragma unroll
    for (int t = 0; t < NT; ++t) { lsum[t] = 0.f;
#pragma unroll
        for (int i = 0; i < 16; ++i) { O[t][0][i] = 0.f; O[t][1][i] = 0.f; } }
#pragma unroll
    for (int j = 0; j < 4 + NT; ++j) {
        if (j + 1 < 4 + NT) { DIL_LDK(j + 1, (j + 1) & 1); DIL_LDV(j + 1, (j + 1) & 1); }
        SCHED_FENCE();
        const bool tv = DIL_TV(j);
#pragma unroll
        for (int t = 0; t < NT; ++t) {
            const int jj = j - t;
            if (jj >= 0 && jj <= 4) {
                f32x16 sa;
#pragma unroll
                for (int i = 0; i < 16; ++i) sa[i] = 0.f;
#pragma unroll
                for (int s = 0; s < 4; ++s) sa = MFMA32(kf[j & 1][s], qf[t][s], sa);
                float p[16];
#pragma unroll
                for (int reg = 0; reg < 16; ++reg) {
                    const int kk = (reg & 3) + 8 * (reg >> 2) + 4 * hf;
                    bool ok = tv;
                    if (jj == 0) ok = ok && (kk >= r);
                    if (jj == 4) ok = ok && (kk <= r);
                    const float e = __builtin_amdgcn_exp2f(sa[reg] - shift);
                    p[reg] = ok ? e : 0.f; lsum[t] += p[reg];
                }
#pragma unroll
                for (int s2 = 0; s2 < 2; ++s2) {
                    u32x4 pw; pw.x = pk2(p[8 * s2], p[8 * s2 + 1]); pw.y = pk2(p[8 * s2 + 2], p[8 * s2 + 3]); pw.z = pk2(p[8 * s2 + 4], p[8 * s2 + 5]); pw.w = pk2(p[8 * s2 + 6], p[8 * s2 + 7]);
                    const bf16x8 pb = __builtin_bit_cast(bf16x8, pw);
#pragma unroll
                    for (int mt = 0; mt < 2; ++mt) O[t][mt] = MFMA32(vf[j & 1][mt][s2], pb, O[t][mt]);
                }
            }
        }
        SCHED_FENCE();
    }
#undef DIL_KC
#undef DIL_TV
#undef DIL_LDK
#undef DIL_LDV
}

__device__ __forceinline__ void na_tile4(const bf16_t* Qp, const bf16_t* Kp, const bf16_t* Vp, bf16_t* yb, const LAS float* rpbl, int r0, int cb, float shift, int lane) {
    const int qi = lane & 15, q4 = lane >> 4;
    const int qc = 16 * cb + qi;
    const int kc0 = min(max(16 * cb - 8, 0), 32), ws = min(max(qc - 8, 0), 48);
    const int cA = kc0 + 4 * q4, cB = cA + 16;
    const int lo = (qi >> 3) * 512 + q4 * 64 + (qi & 7) * 8;
    const int mb = kc0 + 4 * q4 - ws;
    const int rs0 = min(max(r0 - 4, 0), 56);
    int off[4];
#pragma unroll
    for (int q = 0; q < 4; ++q) off[q] = min(max(r0 + q - 4, 0), 56) - rs0;
    const int nrows = off[3] + 8;
    const bf16_t* kl = Kp + (size_t)(rs0 * GW + kc0) * 64 + lo;
    const bf16_t* vlA = Vp + (size_t)(rs0 * GW + (cA & ~7)) * 64 + qi * 8 + (cA & 7);
    const bf16_t* vlB = Vp + (size_t)(rs0 * GW + (cB & ~7)) * 64 + qi * 8 + (cB & 7);
    const LAS float* bl = rpbl + (rs0 - r0 + 7) * 31 + (kc0 + 4 * q4 - qc + 15);
    bf16x8 qf[4][2], kf[3][2][2]; s16x4 vf[2][4][2];
#pragma unroll
    for (int q = 0; q < 4; ++q)
#pragma unroll
        for (int s = 0; s < 2; ++s) qf[q][s] = *(const bf16x8*)(Qp + (size_t)((r0 + q) * GW + 16 * cb) * 64 + lo + 256 * s);
#define NA_LDK(j, slot) do { const int _j = ((j) < nrows) ? (j) : (nrows - 1); _Pragma("unroll") for (int hh = 0; hh < 2; ++hh) _Pragma("unroll") for (int s = 0; s < 2; ++s) kf[slot][hh][s] = *(const bf16x8*)(kl + _j * 4096 + hh * 1024 + 256 * s); } while (0)
#define NA_LDV(j, slot) do { const int _j = ((j) < nrows) ? (j) : (nrows - 1); _Pragma("unroll") for (int mt = 0; mt < 4; ++mt) { vf[slot][mt][0] = *(const s16x4*)(vlA + _j * 4096 + mt * 128); vf[slot][mt][1] = *(const s16x4*)(vlB + _j * 4096 + mt * 128); } } while (0)
    NA_LDK(0, 0); NA_LDK(1, 1); NA_LDV(0, 0);
    SCHED_FENCE();
    bool okm[8];
#pragma unroll
    for (int e = 0; e < 8; ++e) okm[e] = (unsigned)(mb + 16 * (e >> 2) + (e & 3)) < 16u;
    f32x4 O[4][4]; float lsum[4];
#pragma unroll
    for (int q = 0; q < 4; ++q) { lsum[q] = 0.f;
#pragma unroll
        for (int mt = 0; mt < 4; ++mt) O[q][mt] = (f32x4){0.f, 0.f, 0.f, 0.f}; }
#pragma unroll
    for (int j = 0; j < 11; ++j) {
        if (j < nrows) {
            if (j + 2 < 11) { NA_LDK(j + 2, (j + 2) % 3); }
            if (j + 1 < 11) { NA_LDV(j + 1, (j + 1) & 1); }
            SCHED_FENCE();
#pragma unroll
            for (int q = 0; q < 4; ++q) {
                if (j - q >= -3 && j - q <= 10 && j >= off[q] && j < off[q] + 8) {
                    float p[8];
#pragma unroll
                    for (int hh = 0; hh < 2; ++hh) {
                        f32x4 sa = (f32x4){0.f, 0.f, 0.f, 0.f};
#pragma unroll
                        for (int s = 0; s < 2; ++s) sa = MFMA16(kf[j % 3][hh][s], qf[q][s], sa);
#pragma unroll
                        for (int v = 0; v < 4; ++v) {
                            const float e = __builtin_amdgcn_exp2f(sa[v] + bl[(j - q) * 31 + 16 * hh + v] - shift);
                            p[4 * hh + v] = okm[4 * hh + v] ? e : 0.f; lsum[q] += p[4 * hh + v];
                        }
                    }
                    u32x4 pw; pw.x = pk2(p[0], p[1]); pw.y = pk2(p[2], p[3]); pw.z = pk2(p[4], p[5]); pw.w = pk2(p[6], p[7]);
                    const bf16x8 pb = __builtin_bit_cast(bf16x8, pw);
#pragma unroll
                    for (int mt = 0; mt < 4; ++mt) O[q][mt] = MFMA16(cat8(vf[j & 1][mt][0], vf[j & 1][mt][1]), pb, O[q][mt]);
                }
            }
            SCHED_FENCE();
        }
    }
#undef NA_LDK
#undef NA_LDV
#pragma unroll
    for (int q = 0; q < 4; ++q) {
        float l = lsum[q]; l += shx(l, 16, lane); l += shx(l, 32, lane);
        const float inv = 1.0f / l;
#pragma unroll
        for (int mt = 0; mt < 4; ++mt) { u32x2 w; w.x = pk2(O[q][mt][0] * inv, O[q][mt][1] * inv); w.y = pk2(O[q][mt][2] * inv, O[q][mt][3] * inv);
            *(u32x2*)(yb + (size_t)((r0 + q) * GW + qc) * 512 + 16 * mt + 4 * q4) = w; }
    }
}

__device__ __forceinline__ void p2_attention(Frame& F, const int flags) {
    phase_ids(F);
    const int lane = F.lane, wave = F.wave, tid = F.tid;
    LAS float* Ol = (LAS float*)F.lds;
    LAS float* Ll = (LAS float*)(F.lds + LDS_L_OFF);
    const bf16_t* Qd = (const bf16_t*)(F.ws + WS_QD); const bf16_t* Kd = (const bf16_t*)(F.ws + WS_KD); const bf16_t* Vtd = (const bf16_t*)(F.ws + WS_VTD);
    const bf16_t* Qn = (const bf16_t*)(F.ws + WS_QN); const bf16_t* Kn = (const bf16_t*)(F.ws + WS_KN); const bf16_t* Vtn = (const bf16_t*)(F.ws + WS_VTN);
    bf16_t* YA = (bf16_t*)(F.ws + WS_YA); bf16_t* YB = (bf16_t*)(F.ws + WS_YB);
    const float shiftD = 8.0f * wave_max(fabsf(inptr(IN_DQG)[lane]), lane) * wave_max(fabsf(inptr(IN_DKG)[lane]), lane) * LOG2E;
    if (!(flags & 1))
    for (int su = F.vcu; su < 256; su += F.G) {
        const int b = su >> 5, h = (su >> 3) & 3, T0 = (su & 7) * 512;
#pragma unroll 1
        for (int g = 0; g < 3; ++g) {
            const int d = dil_of(g), L = S / d, sh = (g == 0) ? 3 : (g == 1 ? 1 : 0), head = g * 4 + h;
            const bf16_t* Qp = Qd + (size_t)(b * DILH + head) * S * 64; const bf16_t* Kp = Kd + (size_t)(b * DILH + head) * S * 64; const bf16_t* Vp = Vtd + (size_t)(b * DILH + head) * 64 * S;
            if (g < 2) {
                const int rres = wave >> sh, tq = wave & ((1 << sh) - 1);
                const int p0 = rres * L + T0 / d + tq * 64;
                f32x16 O[2][2]; float lsum[2];
                dil_tile64<2>(Qp, Kp, Vp, p0, rres * L, (rres + 1) * L, shiftD, O, lsum, lane);
                const int r = lane & 31, hf = lane >> 5;
#pragma unroll
                for (int t = 0; t < 2; ++t) {
                    const int sw = swz9((tq * 64 + 32 * t + r) * d + rres);
                    const float lt = lsum[t] + shx(lsum[t], 32, lane);
                    if (g == 0) {
#pragma unroll
                        for (int mt = 0; mt < 2; ++mt)
#pragma unroll
                            for (int reg = 0; reg < 16; ++reg) Ol[(32 * mt + (reg & 3) + 8 * (reg >> 2) + 4 * hf) * 512 + sw] = O[t][mt][reg];
                        if (hf == 0) Ll[sw] = lt;
                    } else {
#pragma unroll
                        for (int mt = 0; mt < 2; ++mt)
#pragma unroll
                            for (int reg = 0; reg < 16; ++reg) Ol[(32 * mt + (reg & 3) + 8 * (reg >> 2) + 4 * hf) * 512 + sw] += O[t][mt][reg];
                        if (hf == 0) Ll[sw] += lt;
                    }
                }
            } else {
#pragma unroll 1
                for (int tt = 0; tt < 2; ++tt) {
                    const int rres = wave + 8 * tt, p0 = rres * L + T0 / d;
                    f32x16 O[1][2]; float lsum[1];
                    dil_tile64<1>(Qp, Kp, Vp, p0, rres * L, (rres + 1) * L, shiftD, O, lsum, lane);
                    const int r = lane & 31, hf = lane >> 5;
                    const int sw = swz9(r * d + rres);
                    const float lt = lsum[0] + shx(lsum[0], 32, lane);
#pragma unroll
                    for (int mt = 0; mt < 2; ++mt)
#pragma unroll
                        for (int reg = 0; reg < 16; ++reg) Ol[(32 * mt + (reg & 3) + 8 * (reg >> 2) + 4 * hf) * 512 + sw] += O[0][mt][reg];
                    if (hf == 0) Ll[sw] += lt;
                }
            }
            __syncthreads();
        }
        {
            const int sw = swz9(tid); const float inv = 1.0f / Ll[sw];
            bf16_t* op = YA + ((size_t)b * S + T0 + tid) * 256 + h * 64;
#pragma unroll
            for (int c = 0; c < 8; ++c) { float v[8];
#pragma unroll
                for (int k = 0; k < 8; ++k) v[k] = Ol[(8 * c + k) * 512 + sw] * inv;
                u32x4 w; w.x = pk2(v[0], v[1]); w.y = pk2(v[2], v[3]); w.z = pk2(v[4], v[5]); w.w = pk2(v[6], v[7]);
                *(u32x4*)(op + 8 * c) = w; }
        }
        __syncthreads();
    }
    phase_ids(F);
    const int lane2 = F.lane, wave2 = F.wave, tid2 = F.tid;
    const float boundN = 8.0f * wave_max(fabsf(inptr(IN_NQG)[lane2]), lane2) * wave_max(fabsf(inptr(IN_NKG)[lane2]), lane2) * LOG2E;
    LAS float* rpbl = (LAS float*)(F.lds + 256);
    LAS float* red = (LAS float*)(F.lds + LDS_L_OFF);
    float mx = 0.f;
    const float* rpb = inptr(IN_RPB);
    for (int i = tid2; i < NAH * 465; i += 512) { const float v = rpb[i]; rpbl[i] = v * LOG2E; mx = fmaxf(mx, fabsf(v)); }
    mx = wave_max(mx, lane2);
    if (lane2 == 0) red[wave2] = mx;
    __syncthreads();
    float bmax = 0.f;
#pragma unroll
    for (int w = 0; w < 8; ++w) bmax = fmaxf(bmax, red[w]);
    const float shiftN = boundN + bmax * LOG2E;
    if (!(flags & 2))
    for (int su = F.vcu; su < 256; su += F.G) {
        const int b = su >> 5, head = (su >> 2) & 7, band = su & 3;
        const bf16_t* Qp = Qn + (size_t)(b * NAH + head) * S * 64; const bf16_t* Kp = Kn + (size_t)(b * NAH + head) * S * 64; const bf16_t* Vp = Vtn + (size_t)(b * NAH + head) * 64 * S;
        bf16_t* yb = YB + (size_t)b * S * 512 + head * 64;
#pragma unroll 1
        for (int t = 0; t < 2; ++t) na_tile4(Qp, Kp, Vp, yb, rpbl + head * 465, band * 16 + 4 * (wave2 >> 1), 2 * (wave2 & 1) + t, shiftN, lane2);
    }
    __syncthreads();
}

__device__ __forceinline__ void p5_norm_router(Frame& F) {
    phase_ids(F);
    const int lane = F.lane, tid = F.tid;
    const float* w_router = inptr(IN_WROUTER); const float* norm2_g = inptr(IN_NORM2); const float* xin = inptr(IN_X); const bf16_t* dlt = (const bf16_t*)(F.ws + WS_DLT);
    LAS float* wl = (LAS float*)F.lds;
    for (int i = tid; i < D * NE; i += 512) { const int d = i >> 4, e = i & 15, ln = (d & 255) >> 2, ii = d & 3, j = d >> 8, q = e >> 2, c = e & 3;
        wl[((((j * 4 + ii) * 4 + q) * 64 + ln) << 2) + c] = w_router[i]; }
    __syncthreads();
    const int gw = F.vcu * 8 + F.wave, NGW = F.G * 8;
    bf16_t* H2 = (bf16_t*)(F.ws + WS_HB); float* aff = (float*)(F.ws + WS_AFF);
    const int myexp = ((lane & 1) << 3) | ((lane & 2) << 1) | ((lane & 4) >> 1) | ((lane & 8) >> 3);
    f32x4 xn[2][4]; u32x2 dn[2][4];
#define P5_LOAD(mm) do { _Pragma("unroll") for (int r = 0; r < 2; ++r) { const f32x4* _x = (const f32x4*)(xin + (size_t)((mm) + r) * D) + lane; const u32x2* _d = (const u32x2*)(dlt + (size_t)((mm) + r) * D) + lane; \
        _Pragma("unroll") for (int j = 0; j < 4; ++j) { xn[r][j] = _x[64 * j]; dn[r][j] = _d[64 * j]; } } } while (0)
    if (gw * 2 < M) P5_LOAD(gw * 2);
    for (int m0 = gw * 2; m0 < M; m0 += NGW * 2) {
        f32x2 lg[16];
#pragma unroll
        for (int e = 0; e < 16; ++e) lg[e] = (f32x2){0.f, 0.f};
        float rs[2]; f32x4 v[2][4];
#pragma unroll
        for (int r = 0; r < 2; ++r) { float s = 0.f;
#pragma unroll
            for (int j = 0; j < 4; ++j) { const u32x2 dw = dn[r][j]; v[r][j] = xn[r][j] + (f32x4){bflo(dw.x), bfhi(dw.x), bflo(dw.y), bfhi(dw.y)};
                s += (v[r][j][0] * v[r][j][0] + v[r][j][1] * v[r][j][1]) + (v[r][j][2] * v[r][j][2] + v[r][j][3] * v[r][j][3]); }
            rs[r] = rsqrtf(wave_sum(s, lane) * (1.f / D) + EPS); }
        { const int mn = m0 + NGW * 2; P5_LOAD(mn < M ? mn : m0); }
        __builtin_amdgcn_sched_barrier(0);
#pragma unroll
        for (int j = 0; j < 4; ++j) {
            const f32x4 gj = *(const f32x4*)(norm2_g + 4 * lane + 256 * j);
#pragma unroll
            for (int r = 0; r < 2; ++r) { v[r][j] = v[r][j] * rs[r] * gj;
                u32x2 w; w.x = pk2(v[r][j][0], v[r][j][1]); w.y = pk2(v[r][j][2], v[r][j][3]); ((u32x2*)(H2 + (size_t)(m0 + r) * D) + lane)[64 * j] = w; }
#pragma unroll
            for (int i = 0; i < 4; ++i) {
                const f32x2 hv = {v[0][j][i], v[1][j][i]};
#pragma unroll
                for (int q = 0; q < 4; ++q) { const f32x4 w4 = *(const LAS f32x4*)(wl + ((((j * 4 + i) * 4 + q) * 64 + lane) << 2));
                    lg[4 * q + 0] += hv * w4[0]; lg[4 * q + 1] += hv * w4[1]; lg[4 * q + 2] += hv * w4[2]; lg[4 * q + 3] += hv * w4[3]; }
                __builtin_amdgcn_sched_barrier(0);
            }
        }
#pragma unroll
        for (int r = 0; r < 2; ++r) {
            float a8[8], a4[4], a2[2], a1;
            { const bool up = lane & 1;
#pragma unroll
              for (int k = 0; k < 8; ++k) { const float keep = up ? lg[8 + k][r] : lg[k][r], send = up ? lg[k][r] : lg[8 + k][r]; a8[k] = keep + shx(send, 1, lane); } }
            { const bool up = lane & 2;
#pragma unroll
              for (int k = 0; k < 4; ++k) { const float keep = up ? a8[4 + k] : a8[k], send = up ? a8[k] : a8[4 + k]; a4[k] = keep + shx(send, 2, lane); } }
            { const bool up = lane & 4;
#pragma unroll
              for (int k = 0; k < 2; ++k) { const float keep = up ? a4[2 + k] : a4[k], send = up ? a4[k] : a4[2 + k]; a2[k] = keep + shx(send, 4, lane); } }
            { const bool up = lane & 8; const float keep = up ? a2[1] : a2[0], send = up ? a2[0] : a2[1]; a1 = keep + shx(send, 8, lane); }
            a1 += shx(a1, 16, lane); a1 += shx(a1, 32, lane);
            float mx = a1;
#pragma unroll
            for (int o = 1; o < 16; o <<= 1) mx = fmaxf(mx, shx(mx, o, lane));
            const float p = __expf(a1 - mx); float den = p;
#pragma unroll
            for (int o = 1; o < 16; o <<= 1) den += shx(den, o, lane);
            const int m = m0 + r;
            if (lane < 16) aff[((size_t)((m >> 12) * NE + myexp) << 12) + (m & 4095)] = p / den;
        }
    }
#undef P5_LOAD
    __syncthreads();
}

__device__ __forceinline__ int wave_sum_i(int v, int lane) {
#pragma unroll
    for (int o = 1; o < 64; o <<= 1) v += shxi(v, o, lane);
    return v;
}
__device__ __forceinline__ void p6_topk(Frame& F) {
    phase_ids(F);
    const int lane = F.lane, tid = F.tid, wave = F.wave;
    LAS int* red = (LAS int*)F.lds;
    const float* aff = (const float*)(F.ws + WS_AFF); int* idx = (int*)(F.ws + WS_IDX); float* glist = (float*)(F.ws + WS_GLIST); int* tokslot = (int*)(F.ws + WS_TOKSLOT);
    for (int li = F.vcu; li < NB * NE; li += F.G) {
        const int b = li >> 4, e = li & 15;
        const float* ap = aff + (size_t)li * S + 8 * tid;
        const f32x4 a0 = *(const f32x4*)ap, a1 = *(const f32x4*)(ap + 4);
        const float av[8] = {a0[0], a0[1], a0[2], a0[3], a1[0], a1[1], a1[2], a1[3]};
        unsigned key[8];
#pragma unroll
        for (int k = 0; k < 8; ++k) key[k] = __builtin_bit_cast(unsigned, av[k]);
        unsigned tau = 0u; int par = 0;
        for (int bit = 30; bit >= 0; --bit) {
            const unsigned cand = tau | (1u << bit); int c = 0;
#pragma unroll
            for (int k = 0; k < 8; ++k) c += (key[k] >= cand) ? 1 : 0;
            c = wave_sum_i(c, lane);
            if (lane == 0) red[par * 8 + wave] = c;
            __syncthreads();
            int tot = 0;
#pragma unroll
            for (int w = 0; w < 8; ++w) tot += red[par * 8 + w];
            if (tot >= CAP) tau = cand;
            par ^= 1;
        }
        int cg = 0, ce = 0;
#pragma unroll
        for (int k = 0; k < 8; ++k) { cg += (key[k] > tau) ? 1 : 0; ce += (key[k] == tau) ? 1 : 0; }
        int pkc = cg | (ce << 16), incl = pkc;
#pragma unroll
        for (int o = 1; o < 64; o <<= 1) { const int t = __builtin_amdgcn_ds_bpermute((lane - o) << 2, incl); if (lane >= o) incl += t; }
        __syncthreads();
        if (lane == 63) red[64 + wave] = incl;
        __syncthreads();
        int wpre = 0, total = 0;
#pragma unroll
        for (int w = 0; w < 8; ++w) { const int t = red[64 + w]; if (w < wave) wpre += t; total += t; }
        const int excl = wpre + incl - pkc;
        int gt_before = excl & 0xffff, eq_before = excl >> 16;
        const int need = CAP - (total & 0xffff);
        const size_t rowbase = (size_t)(e * NB + b) * CAP;
#pragma unroll
        for (int k = 0; k < 8; ++k) {
            const bool isg = key[k] > tau, ise = key[k] == tau;
            const bool sel = isg || (ise && eq_before < need);
            const int slot = gt_before + min(eq_before, need);
            const int tok = 8 * tid + k;
            if (sel) { idx[rowbase + slot] = tok; glist[rowbase + slot] = av[k]; }
            tokslot[(size_t)li * S + tok] = sel ? slot : -1;
            gt_before += isg ? 1 : 0; eq_before += ise ? 1 : 0;
        }
        __syncthreads();
    }
}

__device__ __forceinline__ int p9_slot(const int (&ts)[4], int e, int t) {
    const int src = (e >> 2) * 16 + t, k = e & 3;
    const int v = (k == 0) ? ts[0] : (k == 1 ? ts[1] : (k == 2 ? ts[2] : ts[3]));
    return __builtin_amdgcn_readlane(v, src);
}
__device__ __forceinline__ void p9_combine(Frame& F, const int flags) {
    phase_ids(F);
    const int lane = F.lane; (void)flags;
    const int gw = F.vcu * 8 + F.wave, NGW = F.G * 8;
    const int* tokslot = (const int*)(F.ws + WS_TOKSLOT); const bf16_t* Y = (const bf16_t*)(F.ws + WS_Y); const float* glist = (const float*)(F.ws + WS_GLIST);
    const float* xin = inptr(IN_X); const bf16_t* dlt = (const bf16_t*)(F.ws + WS_DLT);
    for (int ch = gw; ch < M / 16; ch += NGW) {
        const int t0 = ch * 16, b = t0 >> 12, s0 = t0 & 4095;
        int ts[4];
        unsigned long long bal[4];
#pragma unroll
        for (int k = 0; k < 4; ++k) { ts[k] = tokslot[((size_t)(b * NE + 4 * (lane >> 4) + k) << 12) + s0 + (lane & 15)]; bal[k] = __ballot(ts[k] >= 0); }
        f32x4 bx[2][4]; u32x2 bd[2][4], by[2][3][4]; float wy[2][3]; unsigned rest[2];
#define P9_ISSUE(t, buf) do { const f32x4* _x = (const f32x4*)(xin + (size_t)(t0 + (t)) * D) + lane; const u32x2* _d = (const u32x2*)(dlt + (size_t)(t0 + (t)) * D) + lane; \
            _Pragma("unroll") for (int j = 0; j < 4; ++j) { bx[buf][j] = _x[64 * j]; bd[buf][j] = _d[64 * j]; } \
            unsigned _m = 0u; _Pragma("unroll") for (int k = 0; k < 4; ++k) _Pragma("unroll") for (int eg = 0; eg < 4; ++eg) _m |= (unsigned)((bal[k] >> (eg * 16 + (t))) & 1ull) << (4 * eg + k); \
            _Pragma("unroll") for (int i = 0; i < 3; ++i) { size_t _row = 0; float _w = 0.f; \
                if (_m) { const int _e = __builtin_ctz(_m); _m &= _m - 1u; const int _s = p9_slot(ts, _e, (t)); _row = (size_t)(_e * NB + b) * CAP + _s; _w = glist[_row]; } \
                const u32x2* _y = (const u32x2*)(Y + _row * D) + lane; _Pragma("unroll") for (int j = 0; j < 4; ++j) by[buf][i][j] = _y[64 * j]; wy[buf][i] = _w; } \
            rest[buf] = _m; } while (0)
#define P9_CONSUME(t, buf) do { f32x4 acc[4]; \
            _Pragma("unroll") for (int j = 0; j < 4; ++j) { const u32x2 dw = bd[buf][j]; acc[j] = bx[buf][j] + (f32x4){bflo(dw.x), bfhi(dw.x), bflo(dw.y), bfhi(dw.y)}; } \
            _Pragma("unroll") for (int i = 0; i < 3; ++i) { const float _w = wy[buf][i]; _Pragma("unroll") for (int j = 0; j < 4; ++j) { const u32x2 w = by[buf][i][j]; \
                acc[j][0] += _w * bflo(w.x); acc[j][1] += _w * bfhi(w.x); acc[j][2] += _w * bflo(w.y); acc[j][3] += _w * bfhi(w.y); } } \
            unsigned _m = rest[buf]; \
            while (_m) { const int _e = __builtin_ctz(_m); _m &= _m - 1u; const int _s = p9_slot(ts, _e, (t)); const size_t _r = (size_t)(_e * NB + b) * CAP + _s; const u32x2* _y = (const u32x2*)(Y + _r * D) + lane; const float _g = glist[_r]; \
                _Pragma("unroll") for (int j = 0; j < 4; ++j) { const u32x2 w = _y[64 * j]; acc[j][0] += _g * bflo(w.x); acc[j][1] += _g * bfhi(w.x); acc[j][2] += _g * bflo(w.y); acc[j][3] += _g * bfhi(w.y); } } \
            f32x4* _o = (f32x4*)(F.out + (size_t)(t0 + (t)) * D) + lane; _Pragma("unroll") for (int j = 0; j < 4; ++j) _o[64 * j] = acc[j]; } while (0)
        P9_ISSUE(0, 0);
#pragma unroll 1
        for (int t = 0; t < 16; t += 2) {
            P9_ISSUE(t + 1, 1); __builtin_amdgcn_sched_barrier(0);
            P9_CONSUME(t, 0); __builtin_amdgcn_sched_barrier(0);
            { const int tn = (t + 2 < 16) ? t + 2 : t; P9_ISSUE(tn, 0); } __builtin_amdgcn_sched_barrier(0);
            P9_CONSUME(t + 1, 1); __builtin_amdgcn_sched_barrier(0);
        }
#undef P9_ISSUE
#undef P9_CONSUME
    }
}

constexpr int N_PHASES = 10;
struct Args { const float* in[16]; float* out; unsigned char* ws; int ph_lo, ph_hi, flags, pad; };
__global__ void __launch_bounds__(512, 2) mk_fwd(Args args) {
    extern __shared__ __attribute__((aligned(16))) unsigned char lds_raw[];
    Frame F;
    F.lds = (LAS unsigned char*)lds_raw;
    { const int t0 = threadIdx.x; F.wave = __builtin_amdgcn_readfirstlane(t0 >> 6); } phase_ids(F);
    F.G = gridDim.x; { const int bx = blockIdx.x; F.vcu = (F.G % 8 == 0) ? (bx % 8) * (F.G / 8) + bx / 8 : bx; }
    F.out = args.out; F.ws = args.ws;
    volatile LAS unsigned* misc = (volatile LAS unsigned*)(F.lds + LDS_MISC_OFF);
    if (F.tid < 64) misc[F.tid] = 0u;
    __syncthreads();
    const int lo = args.ph_lo, hi = args.ph_hi;
    unsigned* ctl = (unsigned*)(F.ws + WS_CTL);
    XcdBarrier bar; bar.bar = ctl + CW_BAR; bar.x = 0; bar.st = misc + 8;
    if (hi - lo > 1) bar = xcd_barrier_post(ctl + CW_BAR, misc + 8, F.tid == 0);
#ifdef MK_ONLY_PHASE
#define IN(k) ((k) == MK_ONLY_PHASE && lo <= (k) && (k) < hi)
#else
#define IN(k) (lo <= (k) && (k) < hi)
#endif
#define SEAM(k) do { if (IN(k) && IN((k) + 1)) { phase_ids(F); xcd_barrier(bar, F.tid == 0); } } while (0)
    const int c = (int)blockIdx.x, G = F.G;
    const char* hb = (const char*)(F.ws + WS_HB); const char* win = (const char*)(F.ws + WS_WIN);
    const WtBuf wbws = wt_make(F.ws, 0x20000000u), wbout = wt_make(F.out, 0x08000000u);
    bf16_t* gates = (bf16_t*)F.out;

    if (IN(0)) { p0_prologue(F); VM_WAIT(); __syncthreads(); }
    SEAM(0);
    if (IN(1)) {
        SchedP1 S1{ SchedQKd{hb, win, (char*)(F.ws + WS_QD), (char*)(F.ws + WS_KD), G, c}, SchedQKn{hb, win, (char*)(F.ws + WS_QN), (char*)(F.ws + WS_KN), G, c},
                    SchedGates{hb, win, G, c}, SchedVt{hb, win, (char*)(F.ws + WS_VTD), (char*)(F.ws + WS_VTN), G, c}, G, c };
        EpiP1 E1{ EpiQK<true>{inptr(IN_DQG), inptr(IN_DKG), (const f32x2*)(F.ws + WS_ROPE), 0.125f * LOG2E, wbws}, EpiQK<false>{inptr(IN_NQG), inptr(IN_NKG), nullptr, 0.125f * LOG2E, wbws},
                  EpiGates{gates, wbout}, EpiVt{wbws}, (args.flags >> 8) & 15 };
        g8::gemm_phase<EpiP1, SchedP1, false>(F.lds, S1, E1, F.wave);
    }
    SEAM(1);
    if (IN(2)) p2_attention(F, args.flags);
    SEAM(2);
    if (IN(3)) {
        SchedP3 S3{(const char*)(F.ws + WS_YA), (const char*)(F.ws + WS_PA), (const char*)(F.ws + WS_YB), (const char*)(F.ws + WS_PB), G, c};
        EpiP3 E3{(bf16_t*)(F.ws + WS_HB), gates, wbws};
        g8::gemm_phase<EpiP3, SchedP3, false>(F.lds, S3, E3, F.wave);
    }
    SEAM(3);
    if (IN(4)) {
        SchedDense So{(const char*)(F.ws + WS_HB), (const char*)(F.ws + WS_WO), D * 2, D * 2, 128, 4, G, c, 16};
        EpiBf16<0> E{(bf16_t*)(F.ws + WS_DLT), D, 0, wbws};
        g8::gemm_phase<EpiBf16<0>, SchedDense, false>(F.lds, So, E, F.wave);
    }
    SEAM(4);
    if (IN(5)) p5_norm_router(F);
    SEAM(5);
    if (IN(6)) p6_topk(F);
    SEAM(6);
    if (IN(7)) {
        SchedGU Sg{(const char*)(F.ws + WS_HB), (const char*)(F.ws + WS_WGU), (const int*)(F.ws + WS_IDX), G, c};
        EpiSwiGLU E{(bf16_t*)(F.ws + WS_H), args.flags & 64, wbws};
        g8::gemm_phase<EpiSwiGLU, SchedGU, true>(F.lds, Sg, E, F.wave);
    }
    SEAM(7);
    if (IN(8)) {
        SchedDown Sd{(const char*)(F.ws + WS_H), (const char*)(F.ws + WS_WD), G, c};
        EpiBf16<0> E{(args.flags & 64) ? (bf16_t*)(F.ws + WS_HB) : (bf16_t*)(F.ws + WS_Y), D, (args.flags >> 6) & 3, wbws};
        g8::gemm_phase<EpiBf16<0>, SchedDown, false>(F.lds, Sd, E, F.wave);
    }
    SEAM(8);
    if (IN(9)) p9_combine(F, args.flags);
#undef IN
#undef SEAM
}
#ifndef MK_HYB
#define MK_HYB 10
#endif
#ifndef MK_PER_PHASE
#define MK_PER_PHASE 0
#endif

#if MK_HYB < 10
namespace tail {
struct GemmArgs { const float* A; const float* Bm; float* C; const int* gather; int M, N, K, lda, ldb, ldc; long sA, sB, sC; int sG; };
__global__ void __launch_bounds__(256) k_gemm(GemmArgs g) {
    __shared__ float As[16][128 + 4];
    __shared__ float Bs[16][128 + 4];
    const int z = blockIdx.z;
    const float* A = g.A + (long)z * g.sA; const float* Bm = g.Bm + (long)z * g.sB; float* C = g.C + (long)z * g.sC;
    const int* gi = g.gather ? g.gather + (long)z * g.sG : nullptr;
    const int m0 = blockIdx.y * 128, n0 = blockIdx.x * 128, tid = threadIdx.x, tx = tid & 15, ty = tid >> 4;
    float acc[8][8];
#pragma unroll
    for (int i = 0; i < 8; ++i)
#pragma unroll
        for (int j = 0; j < 8; ++j) acc[i][j] = 0.f;
    const int ar = tid >> 1, ak = (tid & 1) * 8;
    const long arow = gi ? (long)gi[m0 + ar] : (long)(m0 + ar);
    const float* ap = A + arow * g.lda + ak;
    const int bk = tid >> 4, bn = (tid & 15) * 8;
    const float* bp = Bm + (long)bk * g.ldb + n0 + bn;
    for (int k0 = 0; k0 < g.K; k0 += 16) {
        const float4 a0 = *(const float4*)(ap + k0), a1 = *(const float4*)(ap + k0 + 4);
        const float4 b0 = *(const float4*)(bp + (long)k0 * g.ldb), b1 = *(const float4*)(bp + (long)k0 * g.ldb + 4);
        __syncthreads();
        As[ak + 0][ar] = a0.x; As[ak + 1][ar] = a0.y; As[ak + 2][ar] = a0.z; As[ak + 3][ar] = a0.w;
        As[ak + 4][ar] = a1.x; As[ak + 5][ar] = a1.y; As[ak + 6][ar] = a1.z; As[ak + 7][ar] = a1.w;
        *(float4*)&Bs[bk][bn] = b0; *(float4*)&Bs[bk][bn + 4] = b1;
        __syncthreads();
#pragma unroll
        for (int k = 0; k < 16; ++k) {
            float av[8], bv[8];
            const float4 x0 = *(const float4*)&As[k][ty * 4], x1 = *(const float4*)&As[k][64 + ty * 4];
            const float4 y0 = *(const float4*)&Bs[k][tx * 4], y1 = *(const float4*)&Bs[k][64 + tx * 4];
            av[0] = x0.x; av[1] = x0.y; av[2] = x0.z; av[3] = x0.w; av[4] = x1.x; av[5] = x1.y; av[6] = x1.z; av[7] = x1.w;
            bv[0] = y0.x; bv[1] = y0.y; bv[2] = y0.z; bv[3] = y0.w; bv[4] = y1.x; bv[5] = y1.y; bv[6] = y1.z; bv[7] = y1.w;
#pragma unroll
            for (int i = 0; i < 8; ++i)
#pragma unroll
                for (int j = 0; j < 8; ++j) acc[i][j] = fmaf(av[i], bv[j], acc[i][j]);
        }
    }
#pragma unroll
    for (int i = 0; i < 8; ++i) {
        const int m = m0 + (i < 4 ? ty * 4 + i : 64 + ty * 4 + (i - 4));
        float* cp = C + (long)m * g.ldc + n0;
        *(float4*)(cp + tx * 4) = make_float4(acc[i][0], acc[i][1], acc[i][2], acc[i][3]);
        *(float4*)(cp + 64 + tx * 4) = make_float4(acc[i][4], acc[i][5], acc[i][6], acc[i][7]);
    }
}
__device__ __forceinline__ float bf2f(bf16_t v) { return __builtin_bit_cast(float, (unsigned)v << 16); }
__device__ __forceinline__ size_t qd_ix(int pos, int dim) { return (size_t)(pos >> 5) * 2048 + (dim >> 4) * 512 + ((dim >> 3) & 1) * 256 + (pos & 31) * 8 + (dim & 7); }
__device__ __forceinline__ size_t vtd_ix(int pos, int dim) { const int kk = pos & 31, k16 = kk & 15; return (size_t)(pos >> 5) * 2048 + ((dim >> 5) * 2 + (kk >> 4)) * 512 + ((k16 >> 2) & 1) * 256 + (dim & 31) * 8 + (k16 >> 3) * 4 + (k16 & 3); }
__device__ __forceinline__ size_t qn_ix(int tok, int dim) { return (size_t)(tok >> 3) * 512 + (dim >> 5) * 256 + ((dim >> 3) & 3) * 64 + (tok & 7) * 8 + (dim & 7); }
__device__ __forceinline__ size_t vtn_ix(int tok, int dim) { return (size_t)(tok >> 3) * 512 + dim * 8 + (tok & 7); }
__global__ void __launch_bounds__(256) k_dil_attn(const bf16_t* Qd, const bf16_t* Kd, const bf16_t* Vtd, float* ya, int b) {
    const int w = blockIdx.x * 4 + (threadIdx.x >> 6), lane = threadIdx.x & 63, tok = w >> 2, h = w & 3, wi = threadIdx.x >> 6;
    __shared__ float qs[4][64]; __shared__ float ps[4][3 * 129 + 3];
    float sc[3][3]; float mx = -INFINITY;
#pragma unroll
    for (int g = 0; g < 3; ++g) {
        const int d = (g == 0) ? 1 : (g == 1 ? 4 : 16), L = S / d, head = g * 4 + h;
        const size_t hb = (size_t)(b * DILH + head) * S;
        qs[wi][lane] = bf2f(Qd[hb * 64 + qd_ix((tok % d) * L + tok / d, lane)]);
        __syncthreads();
#pragma unroll
        for (int rd = 0; rd < 3; ++rd) {
            const int j = rd * 64 + lane; float s = -INFINITY;
            if (j <= 128) { const int kt = tok + (j - 64) * d;
                if (kt >= 0 && kt < S) { const int kpos = (kt % d) * L + kt / d; float a = 0.f; for (int c = 0; c < 64; ++c) a += qs[wi][c] * bf2f(Kd[hb * 64 + qd_ix(kpos, c)]); s = a; } }
            sc[g][rd] = s; mx = fmaxf(mx, s);
        }
        __syncthreads();
    }
    mx = wave_max(mx);
    float den = 0.f;
#pragma unroll
    for (int g = 0; g < 3; ++g)
#pragma unroll
        for (int rd = 0; rd < 3; ++rd) { const int j = rd * 64 + lane; const float p = (sc[g][rd] == -INFINITY) ? 0.f : exp2f(sc[g][rd] - mx); den += p; if (j <= 128) ps[wi][g * 129 + j] = p; }
    den = wave_sum(den);
    __syncthreads();
    float o = 0.f;
    for (int g = 0; g < 3; ++g) {
        const int d = (g == 0) ? 1 : (g == 1 ? 4 : 16), L = S / d, head = g * 4 + h;
        const bf16_t* vp = Vtd + (size_t)(b * DILH + head) * 64 * S;
        for (int j = 0; j <= 128; ++j) { const int kt = tok + (j - 64) * d; if (kt >= 0 && kt < S) { const int pp = (kt % d) * L + kt / d; o += ps[wi][g * 129 + j] * bf2f(vp[vtd_ix(pp, lane)]); } }
    }
    ya[(long)tok * 256 + h * 64 + lane] = o / den;
}
__global__ void __launch_bounds__(256) k_na_attn(const bf16_t* Qn, const bf16_t* Kn, const bf16_t* Vtn, const float* rpb, float* yb, int b) {
    const int w = blockIdx.x * 4 + (threadIdx.x >> 6), lane = threadIdx.x & 63, tok = w >> 3, h = w & 7, wi = threadIdx.x >> 6;
    __shared__ float qs[4][64]; __shared__ float ps[4][128];
    const int r = tok / GW, c = tok % GW, rs = min(max(r - 4, 0), 56), ws = min(max(c - 8, 0), 48);
    const size_t hb = (size_t)(b * NAH + h) * S;
    qs[wi][lane] = bf2f(Qn[hb * 64 + qn_ix(tok, lane)]);
    __syncthreads();
    float sc[2]; float mx = -INFINITY;
#pragma unroll
    for (int rd = 0; rd < 2; ++rd) {
        const int j = rd * 64 + lane, kr = rs + (j >> 4), kc = ws + (j & 15);
        float a = 0.f;
        for (int cc = 0; cc < 64; ++cc) a += qs[wi][cc] * bf2f(Kn[hb * 64 + qn_ix(kr * GW + kc, cc)]);
        sc[rd] = a + rpb[(h * 15 + (kr - r + 7)) * 31 + (kc - c + 15)] * LOG2E; mx = fmaxf(mx, sc[rd]);
    }
    mx = wave_max(mx);
    float den = 0.f;
#pragma unroll
    for (int rd = 0; rd < 2; ++rd) { const float p = exp2f(sc[rd] - mx); den += p; ps[wi][rd * 64 + lane] = p; }
    den = wave_sum(den);
    __syncthreads();
    float o = 0.f;
    const bf16_t* vp = Vtn + (size_t)(b * NAH + h) * 64 * S;
    for (int j = 0; j < 128; ++j) { const int pp = (rs + (j >> 4)) * GW + ws + (j & 15); o += ps[wi][j] * bf2f(vp[vtn_ix(pp, lane)]); }
    yb[(long)tok * 512 + h * 64 + lane] = o / den;
}
__global__ void k_bf2f(const bf16_t* a, float* o, long n) { const long i = (long)blockIdx.x * blockDim.x + threadIdx.x; if (i < n) o[i] = bf2f(a[i]); }
__global__ void k_merge(const bf16_t* gates, const float* yap, const float* ybp, float* merged) {
    const long i = (long)blockIdx.x * blockDim.x + threadIdx.x; if (i >= (long)S * D) return;
    const int tok = (int)(i / D), c = (int)(i % D);
    const float sn = bf2f(gates[(long)tok * 2048 + 1024 + c]); merged[i] = (yap[i] * bf2f(gates[(long)tok * 2048 + c]) + ybp[i]) * sn;
}
__global__ void k_add(const float* a, const float* b, float* o, long n) { const long i = (long)blockIdx.x * blockDim.x + threadIdx.x; if (i < n) o[i] = a[i] + b[i]; }
__global__ void __launch_bounds__(256) k_norm_router(const float* x1, const float* g, const float* wr, float* h2, float* aff) {
    const int row = blockIdx.x * 4 + (threadIdx.x >> 6), lane = threadIdx.x & 63;
    const float* xp = x1 + (long)row * D; float v[16]; float ss = 0.f;
#pragma unroll
    for (int i = 0; i < 16; ++i) { v[i] = xp[lane + 64 * i]; ss += v[i] * v[i]; }
    ss = wave_sum(ss);
    const float rs = rsqrtf(ss * (1.0f / D) + EPS);
    float lg[16];
#pragma unroll
    for (int e = 0; e < 16; ++e) lg[e] = 0.f;
#pragma unroll
    for (int i = 0; i < 16; ++i) { const float hv = v[i] * rs * g[lane + 64 * i]; h2[(long)row * D + lane + 64 * i] = hv; const float* wp = wr + (long)(lane + 64 * i) * NE;
#pragma unroll
        for (int e = 0; e < 16; ++e) lg[e] += hv * wp[e]; }
    float mx = -INFINITY;
#pragma unroll
    for (int e = 0; e < 16; ++e) { lg[e] = wave_sum(lg[e]); mx = fmaxf(mx, lg[e]); }
    float den = 0.f;
#pragma unroll
    for (int e = 0; e < 16; ++e) { lg[e] = __expf(lg[e] - mx); den += lg[e]; }
    if (lane < 16) { float mine = 0.f;
#pragma unroll
        for (int e = 0; e < 16; ++e) mine = (lane == e) ? lg[e] : mine;
        aff[(long)lane * S + row] = mine / den; }
}
__global__ void __launch_bounds__(1024) k_topk(const float* aff, int* idx, float* gate) {
    __shared__ float a[S]; const int e = blockIdx.x;
    for (int i = threadIdx.x; i < S; i += 1024) a[i] = aff[(long)e * S + i];
    __syncthreads();
    for (int i = threadIdx.x; i < S; i += 1024) { const float v = a[i]; int rank = 0;
        for (int j = 0; j < S; ++j) { const float u = a[j]; rank += (u > v || (u == v && j < i)) ? 1 : 0; }
        if (rank < CAP) { idx[e * CAP + rank] = i; gate[e * CAP + rank] = v; } }
}
__global__ void k_swiglu(const float* a, const float* u, float* o, long n) { const long i = (long)blockIdx.x * blockDim.x + threadIdx.x; if (i < n) { const float x = a[i]; o[i] = x / (1.f + __expf(-x)) * u[i]; } }
__global__ void k_scatter(const float* y, const int* idx, const float* gate, int es, float* out) {
    const long i = (long)blockIdx.x * blockDim.x + threadIdx.x; if (i >= (long)NE * CAP * D) return;
    const int row = (int)(i / D), c = (int)(i % D), e = row / CAP, sl = row % CAP;
    atomicAdd(out + (long)idx[e * es + sl] * D + c, gate[e * es + sl] * y[i]);
}
static void gemm(hipStream_t st, const float* A, const float* Bm, float* C, int M_, int N, int K, int lda, int ldb, int ldc,
                 int nz = 1, long sA = 0, long sB = 0, long sC = 0, const int* gather = nullptr, int sG = 0) {
    GemmArgs g{}; g.A = A; g.Bm = Bm; g.C = C; g.gather = gather; g.M = M_; g.N = N; g.K = K; g.lda = lda; g.ldb = ldb; g.ldc = ldc; g.sA = sA; g.sB = sB; g.sC = sC; g.sG = sG;
    hipLaunchKernelGGL(k_gemm, dim3(N / 128, M_ / 128, nz), dim3(256), 0, st, g);
}
struct Bump { size_t lo[3], hi[3]; int n, cur; size_t at;
    float* take(size_t nfloats) { size_t bytes = ((nfloats * 4) + 255) & ~(size_t)255;
        while (cur < n && at + bytes > hi[cur]) { ++cur; if (cur < n) at = lo[cur]; }
        if (cur >= n) { fprintf(stderr, "tail scratch exhausted\n"); return nullptr; }
        float* p = (float*)at; at += bytes; return p; } };
}
#endif

extern "C" void kernel_launch(void* const* d_in, const int* in_sizes, int n_in, void* d_out, int out_size, void* d_ws, size_t ws_size, hipStream_t stream) {
    static int grid = 0;
    if (grid == 0) {
        if (n_in != 16 || out_size != M * D || ws_size < WS_END) { fprintf(stderr, "kernel_launch: unexpected problem (n_in %d, out %d, ws %zu)\n", n_in, out_size, ws_size); grid = -1; return; }
        int dev = 0, cus = 0, per_cu = 0;
        if (hipGetDevice(&dev) != hipSuccess || hipDeviceGetAttribute(&cus, hipDeviceAttributeMultiprocessorCount, dev) != hipSuccess) { grid = -1; return; }
        if (hipFuncSetAttribute((const void*)mk_fwd, hipFuncAttributeMaxDynamicSharedMemorySize, LDS_BYTES) != hipSuccess) { fprintf(stderr, "kernel_launch: hipFuncSetAttribute failed\n"); grid = -1; return; }
        if (hipOccupancyMaxActiveBlocksPerMultiprocessor(&per_cu, (const void*)mk_fwd, 512, LDS_BYTES) != hipSuccess || per_cu < 1)
            fprintf(stderr, "kernel_launch: occupancy query reports %d workgroups per CU\n", per_cu);
        (void)hipGetLastError();
        grid = cus;
    }
    if (grid < 0) return;
    (void)hipMemsetAsync((char*)d_ws + WS_CTL, 0, CTL_BYTES, stream);
    Args a{};
    for (int i = 0; i < 16; ++i) a.in[i] = (const float*)d_in[i];
    a.out = (float*)d_out; a.ws = (unsigned char*)d_ws;
#if MK_PER_PHASE
    for (int p = 0; p < MK_HYB; ++p) { a.ph_lo = p; a.ph_hi = p + 1; hipLaunchKernelGGL(mk_fwd, dim3(grid), dim3(512), LDS_BYTES, stream, a);
#ifdef MK_REPEAT_PHASE
        if (p == MK_REPEAT_PHASE) {
#ifdef MK_REPEAT_FLAGS
            a.flags = MK_REPEAT_FLAGS;
#endif
            hipLaunchKernelGGL(mk_fwd, dim3(grid), dim3(512), LDS_BYTES, stream, a); a.flags = 0; }
#endif
    }
#else
    a.ph_lo = 0; a.ph_hi = MK_HYB; hipLaunchKernelGGL(mk_fwd, dim3(grid), dim3(512), LDS_BYTES, stream, a);
#endif
#if MK_HYB < 10
    using namespace tail;
    unsigned char* ws = (unsigned char*)d_ws; float* out = (float*)d_out;
    Bump bp{};
#if MK_HYB <= 2
    bp.n = 3; bp.lo[0] = (size_t)(ws + 17 * MiB); bp.hi[0] = (size_t)(ws + 113 * MiB); bp.lo[1] = (size_t)(ws + 118 * MiB); bp.hi[1] = (size_t)(ws + 182 * MiB); bp.lo[2] = (size_t)(ws + 422 * MiB); bp.hi[2] = (size_t)(ws + 512 * MiB);
#elif MK_HYB <= 4
    bp.n = 3; bp.lo[0] = (size_t)(ws + 17 * MiB); bp.hi[0] = (size_t)(ws + 113 * MiB); bp.lo[1] = (size_t)(ws + 182 * MiB); bp.hi[1] = (size_t)(ws + 422 * MiB); bp.lo[2] = (size_t)(ws + 470 * MiB); bp.hi[2] = (size_t)(ws + 512 * MiB);
#elif MK_HYB <= 6
    bp.n = 1; bp.lo[0] = (size_t)(ws + 182 * MiB); bp.hi[0] = (size_t)(ws + 512 * MiB);
#else
    bp.n = 1; bp.lo[0] = (size_t)(ws + 182 * MiB); bp.hi[0] = (size_t)(ws + 512 * MiB);
#endif
    bp.cur = 0; bp.at = bp.lo[0];
    float* ya = bp.take((size_t)S * 256); float* yb = bp.take((size_t)S * 512);
    float* yap = bp.take((size_t)S * D); float* ybp = bp.take((size_t)S * D); float* merged = bp.take((size_t)S * D); float* tmp = bp.take((size_t)S * D);
    float* h2 = bp.take((size_t)S * D); float* aff = bp.take((size_t)NE * S); int* idx = (int*)bp.take((size_t)NE * CAP); float* gate = bp.take((size_t)NE * CAP);
    float* ea = bp.take((size_t)NE * CAP * FF); float* eu = bp.take((size_t)NE * CAP * FF);
    const float* x = a.in[0];
    for (int b = 0; b < NB; ++b) {
        const float* xb = x + (size_t)b * S * D; float* ob = out + (size_t)b * S * D;
        const bf16_t* gates_b = (const bf16_t*)d_out + (size_t)b * S * 2048;
#if MK_HYB <= 2
        hipLaunchKernelGGL(k_dil_attn, dim3(S), dim3(256), 0, stream, (const bf16_t*)(ws + WS_QD), (const bf16_t*)(ws + WS_KD), (const bf16_t*)(ws + WS_VTD), ya, b);
        hipLaunchKernelGGL(k_na_attn, dim3(S * 2), dim3(256), 0, stream, (const bf16_t*)(ws + WS_QN), (const bf16_t*)(ws + WS_KN), (const bf16_t*)(ws + WS_VTN), a.in[7], yb, b);
#elif MK_HYB <= 3
        hipLaunchKernelGGL(k_bf2f, dim3(S * 256 / 256), dim3(256), 0, stream, (const bf16_t*)(ws + WS_YA) + (size_t)b * S * 256, ya, (long)S * 256);
        hipLaunchKernelGGL(k_bf2f, dim3(S * 512 / 256), dim3(256), 0, stream, (const bf16_t*)(ws + WS_YB) + (size_t)b * S * 512, yb, (long)S * 512);
#endif
#if MK_HYB <= 3
        gemm(stream, ya, a.in[8], yap, S, D, 256, 256, D, D);
        gemm(stream, yb, a.in[9], ybp, S, D, 512, 512, D, D);
        hipLaunchKernelGGL(k_merge, dim3((S * D) / 256), dim3(256), 0, stream, gates_b, yap, ybp, merged);
        gemm(stream, merged, a.in[10], tmp, S, D, D, D, D, D);
        hipLaunchKernelGGL(k_add, dim3((S * D) / 256), dim3(256), 0, stream, xb, tmp, ob, (long)S * D);
#elif MK_HYB == 4
        hipLaunchKernelGGL(k_bf2f, dim3(S * D / 256), dim3(256), 0, stream, (const bf16_t*)(ws + WS_HB) + (size_t)b * S * D, merged, (long)S * D);
        gemm(stream, merged, a.in[10], tmp, S, D, D, D, D, D);
        hipLaunchKernelGGL(k_add, dim3((S * D) / 256), dim3(256), 0, stream, xb, tmp, ob, (long)S * D);
#endif
        const int* idx_b = idx; const float* gate_b = gate; int es = CAP;
#if MK_HYB <= 5
        hipLaunchKernelGGL(k_norm_router, dim3(S / 4), dim3(256), 0, stream, ob, a.in[11], a.in[12], h2, aff);
        hipLaunchKernelGGL(k_topk, dim3(NE), dim3(1024), 0, stream, aff, idx, gate);
#else
        hipLaunchKernelGGL(k_bf2f, dim3(S * D / 256), dim3(256), 0, stream, (const bf16_t*)(ws + WS_HB) + (size_t)b * S * D, h2, (long)S * D);
        idx_b = (const int*)(ws + WS_IDX) + (size_t)b * CAP; gate_b = (const float*)(ws + WS_GLIST) + (size_t)b * CAP; es = NB * CAP;
#endif
        gemm(stream, h2, a.in[13], ea, CAP, FF, D, D, FF, FF, NE, 0, (long)D * FF, (long)CAP * FF, idx_b, es);
        gemm(stream, h2, a.in[14], eu, CAP, FF, D, D, FF, FF, NE, 0, (long)D * FF, (long)CAP * FF, idx_b, es);
        hipLaunchKernelGGL(k_swiglu, dim3((NE * CAP * FF) / 256), dim3(256), 0, stream, ea, eu, ea, (long)NE * CAP * FF);
        gemm(stream, ea, a.in[15], eu, CAP, D, FF, FF, D, D, NE, (long)CAP * FF, (long)FF * D, (long)CAP * D);
        hipLaunchKernelGGL(k_scatter, dim3((NE * CAP * D) / 256), dim3(256), 0, stream, eu, idx_b, gate_b, es, ob);
    }
#endif
}
```

```cpp
#define MK_HYB 10
#define MK_PER_PHASE 0
#include <hip/hip_runtime.h>
#include <stdint.h>
#include <stdio.h>

#define LAS __attribute__((address_space(3)))
#define GAS __attribute__((address_space(1)))
typedef unsigned short bf16_t;
typedef short bf16x8 __attribute__((ext_vector_type(8)));
typedef short s16x4 __attribute__((ext_vector_type(4)));
typedef float f32x2 __attribute__((ext_vector_type(2)));
typedef float f32x4 __attribute__((ext_vector_type(4)));
typedef float f32x16 __attribute__((ext_vector_type(16)));
typedef unsigned u32x2 __attribute__((ext_vector_type(2)));
typedef unsigned u32x4 __attribute__((ext_vector_type(4)));
typedef __bf16 bf16x2_t __attribute__((ext_vector_type(2)));

constexpr int D = 1024, NB = 8, S = 4096, HD = 64, M = NB * S;
constexpr int DILH = 12, NAH = 8, GW = 64, NE = 16, CAP = 512, FF = 1024, INC = 5888;
constexpr float EPS = 1e-6f;
constexpr float LOG2E = 1.4426950408889634f;

constexpr size_t MiB = 1u << 20;
constexpr size_t WS_CTL = 0, CTL_BYTES = 1 * MiB;
constexpr size_t WS_ROPE = 1 * MiB;
constexpr size_t WS_WIN = 2 * MiB;
constexpr size_t WS_PA = WS_WIN + (size_t)INC * D * 2;
constexpr size_t WS_PB = 14 * MiB;
constexpr size_t WS_WO = 15 * MiB;
constexpr size_t WS_WGU = 17 * MiB;
constexpr size_t WS_WD = 81 * MiB;
constexpr size_t WS_AFF = 113 * MiB;
constexpr size_t WS_TOKSLOT = 115 * MiB;
constexpr size_t WS_IDX = 117 * MiB;
constexpr size_t WS_GLIST = WS_IDX + 256 * 1024;
constexpr size_t WS_HB = 118 * MiB;
constexpr size_t WS_QD = 182 * MiB, WS_KD = 230 * MiB, WS_VTD = 278 * MiB;
constexpr size_t WS_QN = 326 * MiB, WS_KN = 358 * MiB, WS_VTN = 390 * MiB;
constexpr size_t WS_H = 182 * MiB;
constexpr size_t WS_Y = 310 * MiB;
constexpr size_t WS_YA = 422 * MiB;
constexpr size_t WS_YB = 438 * MiB;
constexpr size_t WS_DLT = 438 * MiB;
constexpr size_t WS_END = 502 * MiB;
constexpr int CW_TMO = 0, CW_BAR = 4096, CW_Q6 = 64;

constexpr int RING_BYTES = 131072;
constexpr int LDS_L_OFF = RING_BYTES;
constexpr int LDS_IDX_OFF = RING_BYTES + 2048;
constexpr int LDS_MISC_OFF = RING_BYTES + 4096;
constexpr int LDS_BYTES = 147456;

__device__ __forceinline__ unsigned pk2(float lo, float hi) { f32x2 v = {lo, hi}; return __builtin_bit_cast(unsigned, __builtin_convertvector(v, bf16x2_t)); }
__device__ __forceinline__ float bflo(unsigned w) { return __builtin_bit_cast(float, w << 16); }
__device__ __forceinline__ float bfhi(unsigned w) { return __builtin_bit_cast(float, w & 0xffff0000u); }
__device__ __forceinline__ float shx(float v, int mask, int lane) { return __builtin_bit_cast(float, __builtin_amdgcn_ds_bpermute((lane ^ mask) << 2, __builtin_bit_cast(int, v))); }
__device__ __forceinline__ int shxi(int v, int mask, int lane) { return __builtin_amdgcn_ds_bpermute((lane ^ mask) << 2, v); }
__device__ __forceinline__ float wave_sum(float v, int lane) {
#pragma unroll
    for (int o = 1; o < 64; o <<= 1) v += shx(v, o, lane);
    return v;
}
__device__ __forceinline__ float wave_max(float v, int lane) {
#pragma unroll
    for (int o = 1; o < 64; o <<= 1) v = fmaxf(v, shx(v, o, lane));
    return v;
}
__device__ __forceinline__ float sigmoidf_fast(float x) { return __builtin_amdgcn_rcpf(1.0f + __builtin_amdgcn_exp2f(-x * LOG2E)); }
__device__ __forceinline__ int fresh_lane() { int l; asm volatile("v_mbcnt_lo_u32_b32 %0, -1, 0\n\tv_mbcnt_hi_u32_b32 %0, -1, %0" : "=v"(l)); return l; }
#ifndef MK_WT
#define MK_WT 0
#endif
struct WtBuf { __amdgpu_buffer_rsrc_t r; const char* base; };
__device__ __forceinline__ WtBuf wt_make(const void* base, unsigned bytes) { WtBuf b; b.r = __builtin_amdgcn_make_buffer_rsrc((void*)base, 0, bytes, 0x00020000); b.base = (const char*)base; return b; }
__device__ __forceinline__ void wt_store16(const WtBuf& b, const void* p, u32x4 w) {
#if MK_WT
    __builtin_amdgcn_raw_buffer_store_b128(w, b.r, (unsigned)((const char*)p - b.base), 0, 16);
#else
    *(u32x4*)p = w;
#endif
}
__device__ __forceinline__ void wt_store8(const WtBuf& b, const void* p, u32x2 w) {
#if MK_WT
    __builtin_amdgcn_raw_buffer_store_b64(w, b.r, (unsigned)((const char*)p - b.base), 0, 16);
#else
    *(u32x2*)p = w;
#endif
}
#define LDS_WAIT() asm volatile("s_waitcnt lgkmcnt(0)" ::: "memory")
#define VM_WAIT() asm volatile("s_waitcnt vmcnt(0)" ::: "memory")

#define XB_TMO      128
#define XB_XCNT(j)  (256  + 64 * (j))
#define XB_XSUB(j)  (1280 + 64 * (j))
#define XB_XGEN(j)  (2304 + 64 * (j))
#define XB_TOP      3328
#define XB_TOPGEN   3392
#define XCD_BAR_WORDS 3456
#define XB_SPIN_CAP (1u << 18)
__device__ __forceinline__ unsigned xb_ld(unsigned* p)              { return __hip_atomic_load(p, __ATOMIC_RELAXED, __HIP_MEMORY_SCOPE_AGENT); }
__device__ __forceinline__ unsigned xb_add(unsigned* p, unsigned v) { return __hip_atomic_fetch_add(p, v, __ATOMIC_RELAXED, __HIP_MEMORY_SCOPE_AGENT); }
__device__ __forceinline__ unsigned xb_xcc_id() { return (unsigned)__builtin_amdgcn_s_getreg((3 << 11) | 20) & 0xFu; }
#define XB_SPIN(cond, bar) do { unsigned _sp = 0; while (cond) { __builtin_amdgcn_s_sleep(1); \
    if ((++_sp & 255u) == 0u) { if (xb_ld(&(bar)[XB_TMO])) break; if (_sp > XB_SPIN_CAP) { atomicAdd(&(bar)[XB_TMO], 1u); break; } } } } while (0)
struct XcdBarrier { unsigned* bar; unsigned x; volatile LAS unsigned* st; };
__device__ __forceinline__ XcdBarrier xcd_barrier_post(unsigned* bar, volatile LAS unsigned* st, const bool first) {
    XcdBarrier b; b.bar = bar; b.x = xb_xcc_id(); b.st = st;
    if (first) (void)xb_add(&bar[XB_XCNT(b.x)], 1u);
    return b;
}
__device__ __forceinline__ void xcd_barrier_complete(unsigned* bar, unsigned x, unsigned& nloc, unsigned& nx) {
    const unsigned G = gridDim.x * gridDim.y * gridDim.z;
    unsigned sum, cnt, mine, sp = 0u;
    for (;;) {
        sum = 0u; cnt = 0u; mine = 0u;
#pragma unroll
        for (unsigned j = 0; j < 16; ++j) { const unsigned c = xb_ld(&bar[XB_XCNT(j)]); sum += c; cnt += (c > 0u) ? 1u : 0u; mine = (j == x) ? c : mine; }
        if (sum == G) break;
        __builtin_amdgcn_s_sleep(1);
        if ((++sp & 255u) == 0u) { if (xb_ld(&bar[XB_TMO])) break; if (sp > XB_SPIN_CAP) { atomicAdd(&bar[XB_TMO], 1u); break; } }
    }
    nloc = mine > 0u ? mine : 1u; nx = cnt > 0u ? cnt : 1u;
}
__device__ __forceinline__ void xcd_barrier(const XcdBarrier& b, const bool first) {
    asm volatile("s_waitcnt vmcnt(0)" ::: "memory");
    __syncthreads();
    if (first) {
        unsigned* bar = b.bar;
        __builtin_amdgcn_s_waitcnt(0);
        unsigned nloc = b.st[0], nx = b.st[1];
        if (nloc == 0u) { xcd_barrier_complete(bar, b.x, nloc, nx); b.st[0] = nloc; b.st[1] = nx; }
        const unsigned old = xb_add(&bar[XB_XSUB(b.x)], 1u);
        const unsigned gen = old / nloc;
        if (old + 1u == (gen + 1u) * nloc) {
            __builtin_amdgcn_fence(__ATOMIC_RELEASE, "agent");
            asm volatile("s_waitcnt vmcnt(0)" ::: "memory");
            const unsigned og = xb_add(&bar[XB_TOP], 1u);
            const unsigned tg = og / nx;
            if (og + 1u == (tg + 1u) * nx) xb_add(&bar[XB_TOPGEN], 1u);
            else XB_SPIN(xb_ld(&bar[XB_TOPGEN]) == tg, bar);
            __builtin_amdgcn_fence(__ATOMIC_ACQUIRE, "agent");
            xb_add(&bar[XB_XGEN(b.x)], 1u);
            asm volatile("s_waitcnt vmcnt(0)" ::: "memory");
        } else {
            XB_SPIN(xb_ld(&bar[XB_XGEN(b.x)]) == gen, bar);
            __builtin_amdgcn_fence(__ATOMIC_ACQUIRE, "agent");
            asm volatile("s_waitcnt vmcnt(0)" ::: "memory");
        }
    }
    __syncthreads();
}

namespace g8 {
constexpr int BM = 256, BK = 64, HALF = 128, HTB = HALF * BK * 2, STAGE_BYTES = 8 * HTB;
__host__ __device__ __forceinline__ int lds_byte(int r, int c) { const int st = (r >> 4) * 2 + (c >> 5), rr = r & 15, cc = c & 31, ob = rr * 64 + cc * 2; return st * 1024 + (ob ^ (((ob >> 9) & 1) << 5)); }
__host__ __device__ __forceinline__ void stage_rc(int b, int& R, int& C) { const int st = b / 1024, sb = b % 1024, swz = sb ^ (((sb >> 9) & 1) << 5); R = (st >> 1) * 16 + swz / 64; C = (st & 1) * 32 + (swz % 64) / 2; }
__host__ __device__ __forceinline__ int perm32(int rho) { const int n = rho >> 4, i = rho & 15; return 8 * (i >> 2) + 4 * n + (i & 3); }

__device__ __forceinline__ bool tile_order(long L, int nM, int nN, int& pm, int& pn) {
    const int nwg = nM * nN; if (L >= nwg) return false;
    int wgid = (int)L; { const int q = nwg / 8, r = nwg % 8, xcd = wgid % 8, off = wgid / 8; wgid = (xcd < r ? xcd * (q + 1) : r * (q + 1) + (xcd - r) * q) + off; }
    const int nig = 8 * nN, gid = wgid / nig, fm = gid * 8, gsz = (nM - fm) < 8 ? (nM - fm) : 8;
    pm = fm + ((wgid % nig) % gsz); pn = (wgid % nig) / gsz; return true;
}

struct Unit {
    const char* A; const char* B;
    unsigned sA, sB;
    char* p;
    int nt, ty;
    int e0, e1, e2, e3;
};

#ifndef G8_ALIGN_EPI
#define G8_ALIGN_EPI true
#endif
template <class Epi, class Sched, bool GATHER>
__device__ __forceinline__ void gemm_phase(LAS unsigned char* lds, const Sched& S, const Epi& E, const int wid) {
    const int lane = fresh_lane();
    const int tid = wid * 64 + lane, wr = wid >> 2, wc = wid & 3, fr = lane & 15, fq = lane >> 4;
    unsigned rA[2], rB[2], c2[2];
#pragma unroll
    for (int i = 0; i < 2; ++i) { int R, C; stage_rc(tid * 16 + i * 8192, R, C); rA[i] = (unsigned)R; rB[i] = (unsigned)(Epi::PERM ? ((R & ~31) + perm32(R & 31)) : R); c2[i] = (unsigned)(C * 2);
        if constexpr (Epi::COL64) rB[i] = (unsigned)(64 * (R >> 5) + perm32(R & 31)); }
    const unsigned ldsw = (unsigned)wid * 1024u;
    const int aoff = lds_byte(wr * 64 + fr, fq * 8), boff = lds_byte(wc * 32 + fr, fq * 8);
    LAS int* idxbuf = (LAS int*)(lds + LDS_IDX_OFF);
#define G8_SA(b, h) (((b) * 2 + (h)) * HTB)
#define G8_SB(b, h) ((4 + (b) * 2 + (h)) * HTB)
#define G8_STAGE(bufoff, gbase, stride, rr) do { _Pragma("unroll") for (int _i = 0; _i < 2; ++_i) \
        __builtin_amdgcn_global_load_lds((const unsigned*)((const char*)(gbase) + ((rr)[_i] * (stride) + c2[_i])), (LAS unsigned*)(lds + (bufoff) + ldsw + _i * 8192), 16, 0, 0); } while (0)
#define G8_STAGE_G(bufoff, gbase, offs) do { _Pragma("unroll") for (int _i = 0; _i < 2; ++_i) \
        __builtin_amdgcn_global_load_lds((const unsigned*)((const char*)(gbase) + (offs)[_i]), (LAS unsigned*)(lds + (bufoff) + ldsw + _i * 8192), 16, 0, 0); } while (0)
#define G8_LDA(dst, b, h) do { _Pragma("unroll") for (int m = 0; m < 4; ++m) _Pragma("unroll") for (int k = 0; k < 2; ++k) dst[m][k] = *(const LAS bf16x8*)(lds + G8_SA(b, h) + aoff + m * 2048 + k * 1024); } while (0)
#define G8_LDB(dst, b, h) do { _Pragma("unroll") for (int n = 0; n < 2; ++n) _Pragma("unroll") for (int k = 0; k < 2; ++k) dst[n][k] = *(const LAS bf16x8*)(lds + G8_SB(b, h) + boff + n * 2048 + k * 1024); } while (0)
#define G8_MMA(ai, bj, At, Bt) do { __builtin_amdgcn_s_setprio(1); _Pragma("unroll") for (int m = 0; m < 4; ++m) _Pragma("unroll") for (int n = 0; n < 2; ++n) _Pragma("unroll") for (int k = 0; k < 2; ++k) \
        acc[ai][bj][m][n] = __builtin_amdgcn_mfma_f32_16x16x32_bf16(Bt[n][k], At[m][k], acc[ai][bj][m][n], 0, 0, 0); __builtin_amdgcn_s_setprio(0); } while (0)
#define G8_WAIT_V(n) asm volatile("s_waitcnt vmcnt(" #n ")" ::: "memory")
#define G8_WAIT_L(n) asm volatile("s_waitcnt lgkmcnt(" #n ")" ::: "memory")
#define G8_BAR __builtin_amdgcn_s_barrier()
#define G8_SCHED __builtin_amdgcn_sched_barrier(0)
#define G8_STA(bufoff, u, go, h, koff) do { if constexpr (GATHER) { G8_STAGE_G(bufoff, (u).A + (koff), (go)[h]); } else { G8_STAGE(bufoff, (u).A + (size_t)(h) * HALF * (u).sA + (koff), (u).sA, rA); } } while (0)
#define G8_STB(bufoff, u, h, koff) G8_STAGE(bufoff, (u).B + (size_t)(h) * (Epi::COL64 ? 32 : HALF) * (u).sB + (koff), (u).sB, rB)
    Unit cur, nxt; int ui = 0;
    if (!S.next(0, cur)) return;
    f32x4 acc[2][2][4][2];
#pragma unroll
    for (int a = 0; a < 2; ++a)
#pragma unroll
        for (int b = 0; b < 2; ++b)
#pragma unroll
            for (int m = 0; m < 4; ++m)
#pragma unroll
                for (int n = 0; n < 2; ++n) acc[a][b][m][n] = (f32x4){0.f, 0.f, 0.f, 0.f};
    bf16x8 At[4][2], B0[2][2], B1[2][2];
    unsigned gcur[2][2], gnxt[2][2];
    if constexpr (GATHER) {
        if (wid == 0) __builtin_amdgcn_global_load_lds((const unsigned*)((const int*)cur.p + lane * 4), (LAS unsigned*)(idxbuf), 16, 0, 0);
        G8_WAIT_V(0); G8_BAR;
#pragma unroll
        for (int h = 0; h < 2; ++h)
#pragma unroll
            for (int i = 0; i < 2; ++i) gcur[h][i] = (unsigned)idxbuf[h * HALF + (int)rA[i]] * cur.sA + c2[i];
        G8_WAIT_L(0);
    }
#define G8_KOFF(u, t) ((size_t)((t) * 128))
    { const size_t k0 = G8_KOFF(cur, 0); G8_STB(G8_SB(0, 0), cur, 0, k0); G8_STB(G8_SB(0, 1), cur, 1, k0); G8_STA(G8_SA(0, 0), cur, gcur, 0, k0); G8_STA(G8_SA(0, 1), cur, gcur, 1, k0); }
    if (wr == 1) G8_BAR;
    G8_WAIT_V(2); G8_BAR;
    { const size_t k1 = G8_KOFF(cur, 1); G8_STB(G8_SB(1, 0), cur, 0, k1); G8_STA(G8_SA(1, 0), cur, gcur, 0, k1); G8_STB(G8_SB(1, 1), cur, 1, k1); }
    G8_WAIT_V(6); G8_BAR;
    for (;;) {
        const bool has_next = S.next(ui + 1, nxt);
        if (!has_next) nxt = cur;
        if constexpr (GATHER) {
            if (has_next && wid == 0) __builtin_amdgcn_global_load_lds((const unsigned*)((const int*)nxt.p + lane * 4), (LAS unsigned*)(idxbuf + ((ui + 1) & 1) * 256), 16, 0, 0);
        }
        const int nt = cur.nt;
        for (int t = 0; t < nt; t += 2) {
            const bool last = (t == nt - 2);
            const size_t k1 = G8_KOFF(cur, t + 1);
            const size_t k2 = last ? G8_KOFF(nxt, 0) : G8_KOFF(cur, t + 2), k3 = last ? G8_KOFF(nxt, 1) : G8_KOFF(cur, t + 3);
            if constexpr (GATHER) {
                if (last) {
                    if (has_next) {
#pragma unroll
                        for (int h = 0; h < 2; ++h)
#pragma unroll
                            for (int i = 0; i < 2; ++i) gnxt[h][i] = (unsigned)idxbuf[((ui + 1) & 1) * 256 + h * HALF + (int)rA[i]] * nxt.sA + c2[i];
                    } else {
#pragma unroll
                        for (int h = 0; h < 2; ++h)
#pragma unroll
                            for (int i = 0; i < 2; ++i) gnxt[h][i] = gcur[h][i];
                    }
                }
            }
            G8_LDB(B0, 0, 0); G8_LDB(B1, 0, 1); G8_SCHED; G8_LDA(At, 0, 0); G8_STA(G8_SA(1, 1), cur, gcur, 1, k1);
            G8_WAIT_V(8); G8_WAIT_L(0); G8_BAR; G8_MMA(0, 0, At, B0); G8_MMA(0, 1, At, B1); G8_BAR; G8_SCHED;
            G8_LDA(At, 0, 1);
            if (last) { G8_STB(G8_SB(0, 0), nxt, 0, k2); G8_STB(G8_SB(0, 1), nxt, 1, k2); G8_STA(G8_SA(0, 0), nxt, gnxt, 0, k2); }
            else      { G8_STB(G8_SB(0, 0), cur, 0, k2); G8_STB(G8_SB(0, 1), cur, 1, k2); G8_STA(G8_SA(0, 0), cur, gcur, 0, k2); }
            G8_WAIT_V(8); G8_WAIT_L(0); G8_BAR; G8_MMA(1, 0, At, B0); G8_MMA(1, 1, At, B1); G8_BAR; G8_SCHED;
            G8_LDB(B0, 1, 0); G8_LDB(B1, 1, 1); G8_SCHED; G8_LDA(At, 1, 0);
            if (last) { G8_STA(G8_SA(0, 1), nxt, gnxt, 1, k2); } else { G8_STA(G8_SA(0, 1), cur, gcur, 1, k2); }
            G8_WAIT_V(8); G8_WAIT_L(0); G8_BAR; G8_MMA(0, 0, At, B0); G8_MMA(0, 1, At, B1); G8_BAR; G8_SCHED;
            G8_LDA(At, 1, 1);
            if (last) { G8_STB(G8_SB(1, 0), nxt, 0, k3); G8_STB(G8_SB(1, 1), nxt, 1, k3); G8_STA(G8_SA(1, 0), nxt, gnxt, 0, k3); }
            else      { G8_STB(G8_SB(1, 0), cur, 0, k3); G8_STB(G8_SB(1, 1), cur, 1, k3); G8_STA(G8_SA(1, 0), cur, gcur, 0, k3); }
            G8_WAIT_V(8); G8_WAIT_L(0); G8_BAR; G8_MMA(1, 0, At, B0); G8_MMA(1, 1, At, B1); G8_BAR; G8_SCHED;
        }
        if constexpr (G8_ALIGN_EPI) { if (wr == 0) G8_BAR; }
        const bool keep = E(acc, cur, wr, wc, fr, fq);
        if (!has_next) break;
        if (!keep) {
#pragma unroll
        for (int a = 0; a < 2; ++a)
#pragma unroll
            for (int b = 0; b < 2; ++b)
#pragma unroll
                for (int m = 0; m < 4; ++m)
#pragma unroll
                    for (int n = 0; n < 2; ++n) acc[a][b][m][n] = (f32x4){0.f, 0.f, 0.f, 0.f};
        }
        cur = nxt; ++ui;
        if constexpr (GATHER) {
#pragma unroll
            for (int h = 0; h < 2; ++h)
#pragma unroll
                for (int i = 0; i < 2; ++i) gcur[h][i] = gnxt[h][i];
        }
        if constexpr (G8_ALIGN_EPI) { if (wr == 1) G8_BAR; }
    }
    G8_WAIT_V(0);
    if constexpr (!G8_ALIGN_EPI) { if (wr == 0) G8_BAR; }
    G8_BAR;
#undef G8_SA
#undef G8_SB
#undef G8_STAGE
#undef G8_STAGE_G
#undef G8_LDA
#undef G8_LDB
#undef G8_MMA
#undef G8_WAIT_V
#undef G8_WAIT_L
#undef G8_BAR
#undef G8_SCHED
#undef G8_STA
#undef G8_STB
#undef G8_KOFF
}
}
struct Frame {
    LAS unsigned char* lds;
    int tid, lane, wave, vcu, G;
    float* out; unsigned char* ws;
};
__device__ __forceinline__ void phase_ids(Frame& F) { const int l = fresh_lane(); F.lane = l; F.tid = F.wave * 64 + l; }
enum { IN_X = 0, IN_NORM1 = 1, IN_WIN = 2, IN_DQG = 3, IN_DKG = 4, IN_NQG = 5, IN_NKG = 6, IN_RPB = 7, IN_WDIL = 8, IN_WNA = 9, IN_WOUT = 10, IN_NORM2 = 11, IN_WROUTER = 12, IN_WGATE = 13, IN_WUP = 14, IN_WDOWN = 15 };
__device__ __forceinline__ const float* inptr(int k) {
    int off = k * 8; asm volatile("" : "+s"(off));
    const __attribute__((address_space(4))) char* ka = (const __attribute__((address_space(4))) char*)__builtin_amdgcn_kernarg_segment_ptr();
    return *(const float* const __attribute__((address_space(4)))*)(ka + off);
}
__device__ __forceinline__ int dil_of(int g) { return g == 0 ? 1 : (g == 1 ? 4 : 16); }

constexpr int KT = 16;
struct SchedQKd {
    const char* hb; const char* win; char* qd; char* kd; int G, c;
    __device__ __forceinline__ bool next(int i, g8::Unit& u) const { return at((long)i * G + c, u); }
    __device__ __forceinline__ bool at(long Lu, g8::Unit& u) const {
        int pm, pn; if (!g8::tile_order(Lu, 128, 6, pm, pn)) return false;
        const int b = pm >> 4, j = pm & 15, which = pn / 3, g = pn % 3, d = dil_of(g), L = S / d, pos0 = j * 256, r = pos0 / L, u0 = pos0 % L;
        u.A = hb + ((size_t)b * S + (size_t)u0 * d + r) * (D * 2); u.sA = (unsigned)(d * D * 2);
        u.B = win + (size_t)pn * 256 * (D * 2); u.sB = D * 2;
        u.p = (which ? kd : qd) + ((size_t)(b * DILH + g * 4) * S + pos0) * (HD * 2);
        u.e0 = u0; u.e1 = d; u.e2 = r; u.e3 = which; u.nt = KT; u.ty = 0;
        return true;
    }
};
struct SchedQKn {
    const char* hb; const char* win; char* qn; char* kn; int G, c;
    __device__ __forceinline__ bool next(int i, g8::Unit& u) const { return at((long)i * G + c, u); }
    __device__ __forceinline__ bool at(long L, g8::Unit& u) const {
        int pm, pn; if (!g8::tile_order(L, 128, 4, pm, pn)) return false;
        const int b = pm >> 4, j = pm & 15, which = pn >> 1, hh = pn & 1;
        u.A = hb + (size_t)pm * 256 * (D * 2); u.sA = D * 2;
        u.B = win + (size_t)(9 + pn) * 256 * (D * 2); u.sB = D * 2;
        u.p = (which ? kn : qn) + ((size_t)(b * NAH + hh * 4) * S + j * 256) * (HD * 2);
        u.e0 = j * 256; u.e1 = 1; u.e2 = 0; u.e3 = which; u.nt = KT; u.ty = 1;
        return true;
    }
};
struct SchedVt {
    const char* hb; const char* win; char* vtd; char* vtn; int G, c;
    __device__ __forceinline__ bool next(int i, g8::Unit& u) const { return at((long)i * G + c, u); }
    __device__ __forceinline__ bool at(long Lu, g8::Unit& u) const {
        int pm, pn; if (!g8::tile_order(Lu, 5, 128, pm, pn)) return false;
        const int b = pn >> 4, j = pn & 15, pos0 = j * 256;
        const int d = pm < 3 ? dil_of(pm) : 1, L = S / d, r = pos0 / L, u0 = pos0 % L;
        u.A = win + (size_t)(pm < 3 ? 6 + pm : 10 + pm) * 256 * (D * 2); u.sA = D * 2;
        u.B = hb + ((size_t)b * S + (size_t)u0 * d + r) * (D * 2); u.sB = (unsigned)(d * D * 2);
        u.p = (pm < 3 ? vtd + ((size_t)(b * DILH + pm * 4) * HD * S + (size_t)pos0 * HD) * 2 : vtn + ((size_t)(b * NAH + (pm - 3) * 4) * HD * S + (size_t)pos0 * HD) * 2);
        u.e0 = 0; u.e1 = 0; u.e2 = 0; u.e3 = pm < 3 ? 0 : 1; u.nt = KT; u.ty = 3;
        return true;
    }
};
struct SchedDense {
    const char* A; const char* B; unsigned lda, ldb; int nM, nN, G, c, kt;
    __device__ __forceinline__ bool next(int i, g8::Unit& u) const {
        int pm, pn; if (!g8::tile_order((long)i * G + c, nM, nN, pm, pn)) return false;
        u.A = A + (size_t)pm * 256 * lda; u.sA = lda; u.B = B + (size_t)pn * 256 * ldb; u.sB = ldb;
        u.p = nullptr; u.e0 = pm * 256; u.e1 = pn * 256; u.e2 = 0; u.e3 = 0; u.nt = kt; u.ty = 0;
        return true;
    }
};
struct SchedGU {
    const char* h2; const char* wgu; const int* idx; int G, c;
    __device__ __forceinline__ bool next(int i, g8::Unit& u) const {
        int pm, pn; if (!g8::tile_order((long)i * G + c, 256, 8, pm, pn)) return false;
        const int e = pm >> 4, b = (pm >> 1) & 7;
        u.A = h2 + (size_t)b * S * (D * 2); u.sA = D * 2; u.p = (char*)(idx + (size_t)pm * 256);
        u.B = wgu + ((size_t)e * 2048 + (size_t)pn * 256) * (D * 2); u.sB = D * 2;
        u.e0 = pm * 256; u.e1 = pn * 128; u.e2 = 0; u.e3 = 0; u.nt = KT; u.ty = 0;
        return true;
    }
};
struct SchedDown {
    const char* hbuf; const char* wd; int G, c;
    __device__ __forceinline__ bool next(int i, g8::Unit& u) const {
        const long Lf = (long)i * G + c; if (Lf >= 1024) return false;
        int pm, pn; if (!g8::tile_order(1023 - Lf, 256, 4, pm, pn)) return false;
        const int e = pm >> 4;
        u.A = hbuf + (size_t)pm * 256 * (FF * 2); u.sA = FF * 2;
        u.B = wd + ((size_t)e * 1024 + (size_t)pn * 256) * (FF * 2); u.sB = FF * 2;
        u.p = nullptr; u.e0 = pm * 256; u.e1 = pn * 256; u.e2 = 0; u.e3 = 0; u.nt = KT; u.ty = 0;
        return true;
    }
};
struct SchedGates {
    const char* hb; const char* win; int G, c;
    __device__ __forceinline__ bool at(long L, g8::Unit& u) const {
        int pm, pn; if (!g8::tile_order(L, 128, 8, pm, pn)) return false;
        u.A = hb + (size_t)pm * 256 * (D * 2); u.sA = D * 2; u.B = win + (size_t)(15 + pn) * 256 * (D * 2); u.sB = D * 2;
        u.p = nullptr; u.e0 = pm * 256; u.e1 = pn * 128; u.e2 = 0; u.e3 = 0; u.nt = KT; u.ty = 2;
        return true;
    }
};
struct SchedP1 {
    SchedQKd a; SchedQKn b; SchedGates g; SchedVt v; int G, c;
    __device__ __forceinline__ bool next(int i, g8::Unit& u) const {
        long L = (long)i * G + c;
        if (L < 768) return a.at(L, u); L -= 768;
        if (L < 512) return b.at(L, u); L -= 512;
        if (L < 1024) return g.at(L, u); L -= 1024;
        return v.at(L, u);
    }
};
struct SchedP3 {
    const char* ya; const char* pa; const char* yb; const char* pb; int G, c;
    __device__ __forceinline__ bool next(int i, g8::Unit& u) const {
        int pm, pn; if (!g8::tile_order((long)(i >> 1) * G + c, 128, 4, pm, pn)) return false;
        if (i & 1) { u.A = yb + (size_t)pm * 256 * 1024; u.sA = 1024; u.B = pb + (size_t)pn * 256 * 1024; u.sB = 1024; u.nt = 8; u.ty = 1; }
        else       { u.A = ya + (size_t)pm * 256 * 512;  u.sA = 512;  u.B = pa + (size_t)pn * 256 * 512;  u.sB = 512;  u.nt = 4; u.ty = 0; }
        u.p = nullptr; u.e0 = pm * 256; u.e1 = pn * 256; u.e2 = 0; u.e3 = 0;
        return true;
    }
};

typedef f32x4 (&AccRef)[2][2][4][2];

template <bool ROT> struct EpiQK {
    static constexpr bool PERM = true, COL64 = false;
    const float* gq; const float* gk; const f32x2* rope; float qscale; WtBuf wb;
    __device__ __forceinline__ bool operator()(AccRef acc, const g8::Unit& u, int wr, int wc, int fr, int fq) const { run(acc, u, wr, wc, fr, fq); return false; }
    __device__ __forceinline__ void run(AccRef acc, const g8::Unit& u, int wr, int wc, int fr, int fq) const {
        asm volatile("" : "+v"(fq), "+v"(fr));
        const float* g = u.e3 ? gk : gq; const float sc = u.e3 ? 1.0f : qscale;
        f32x4 rp[2][4];
#define EQK_LOAD(grp, buf) do { const int _R = ((grp) >> 2) * 128 + wr * 64 + ((grp) & 3) * 16 + fr; const f32x4* _p = (const f32x4*)(rope + (size_t)((u.e0 + _R) * u.e1 + u.e2) * 32 + 8 * fq); \
        rp[buf][0] = _p[0]; rp[buf][1] = _p[1]; rp[buf][2] = _p[2]; rp[buf][3] = _p[3]; } while (0)
        if (ROT) { EQK_LOAD(0, 0); }
        float gl[2][8];
#pragma unroll
        for (int bj = 0; bj < 2; ++bj) { const f32x4 a = *(const f32x4*)(g + 32 * bj + 8 * fq), b = *(const f32x4*)(g + 32 * bj + 8 * fq + 4);
            gl[bj][0] = a[0] * sc; gl[bj][1] = a[1] * sc; gl[bj][2] = a[2] * sc; gl[bj][3] = a[3] * sc; gl[bj][4] = b[0] * sc; gl[bj][5] = b[1] * sc; gl[bj][6] = b[2] * sc; gl[bj][7] = b[3] * sc; }
        char* ob = u.p + (size_t)wc * S * (HD * 2);
        const int ln = fq * 16 + fr;
#pragma unroll
        for (int ai = 0; ai < 2; ++ai) {
            float rs[4];
#pragma unroll
            for (int m = 0; m < 4; ++m) { float ss = 0.f;
#pragma unroll
                for (int bj = 0; bj < 2; ++bj)
#pragma unroll
                    for (int n = 0; n < 2; ++n)
#pragma unroll
                        for (int k = 0; k < 4; ++k) { const float t = acc[ai][bj][m][n][k]; ss += t * t; }
                rs[m] = ss; }
#pragma unroll
            for (int m = 0; m < 4; ++m) rs[m] += shx(rs[m], 16, ln);
#pragma unroll
            for (int m = 0; m < 4; ++m) rs[m] += shx(rs[m], 32, ln);
#pragma unroll
            for (int m = 0; m < 4; ++m) rs[m] = rsqrtf(rs[m] * (1.0f / 64.0f) + EPS);
#pragma unroll
            for (int m = 0; m < 4; ++m) {
                const int grp = ai * 4 + m;
                if (ROT) { if (grp + 1 < 8) EQK_LOAD(grp + 1, (grp + 1) & 1); __builtin_amdgcn_sched_barrier(0); }
                const int R = ai * 128 + wr * 64 + m * 16 + fr;
                float v[2][8];
#pragma unroll
                for (int bj = 0; bj < 2; ++bj)
#pragma unroll
                    for (int n = 0; n < 2; ++n)
#pragma unroll
                        for (int k = 0; k < 4; ++k) v[bj][4 * n + k] = acc[ai][bj][m][n][k] * rs[m] * gl[bj][4 * n + k];
                float o[2][8];
                if (ROT) {
                    const f32x4 c0 = rp[grp & 1][0], c1 = rp[grp & 1][1], c2 = rp[grp & 1][2], c3 = rp[grp & 1][3];
                    const float cs[8] = {c0[0], c0[2], c1[0], c1[2], c2[0], c2[2], c3[0], c3[2]}, sn[8] = {c0[1], c0[3], c1[1], c1[3], c2[1], c2[3], c3[1], c3[3]};
#pragma unroll
                    for (int k = 0; k < 8; ++k) { o[0][k] = v[0][k] * cs[k] - v[1][k] * sn[k]; o[1][k] = v[1][k] * cs[k] + v[0][k] * sn[k]; }
                } else {
#pragma unroll
                    for (int k = 0; k < 8; ++k) { o[0][k] = v[0][k]; o[1][k] = v[1][k]; }
                }
#pragma unroll
                for (int bj = 0; bj < 2; ++bj) { u32x4 w; w.x = pk2(o[bj][0], o[bj][1]); w.y = pk2(o[bj][2], o[bj][3]); w.z = pk2(o[bj][4], o[bj][5]); w.w = pk2(o[bj][6], o[bj][7]);
                    char* dst = ROT ? ob + (size_t)(R >> 5) * 4096 + (2 * bj + (fq >> 1)) * 1024 + (fq & 1) * 512 + (R & 31) * 16
                                    : ob + (size_t)(R >> 3) * 1024 + bj * 512 + fq * 128 + (R & 7) * 16;
                    wt_store16(wb, dst, w); }
                if (ROT) __builtin_amdgcn_sched_barrier(0);
            }
        }
#undef EQK_LOAD
    }
};
struct EpiVt {
    static constexpr bool PERM = true, COL64 = false;
    WtBuf wb;
    __device__ __forceinline__ bool operator()(AccRef acc, const g8::Unit& u, int wr, int wc, int fr, int fq) const { run(acc, u, wr, wc, fr, fq); return false; }
    __device__ __forceinline__ void run(AccRef acc, const g8::Unit& u, int wr, int wc, int fr, int fq) const {
#pragma unroll
        for (int ai = 0; ai < 2; ++ai)
#pragma unroll
            for (int m = 0; m < 4; ++m) { const int dim = 16 * m + fr; char* hp = u.p + (size_t)(2 * ai + wr) * (S * HD * 2);
#pragma unroll
                for (int bj = 0; bj < 2; ++bj) { const f32x4 v0 = acc[ai][bj][m][0], v1 = acc[ai][bj][m][1];
                    u32x4 w; w.x = pk2(v0[0], v0[1]); w.y = pk2(v0[2], v0[3]); w.z = pk2(v1[0], v1[1]); w.w = pk2(v1[2], v1[3]);
                    if (u.e3) { wt_store16(wb, hp + (size_t)(16 * bj + 4 * wc + fq) * 1024 + dim * 16, w); }
                    else { char* q = hp + (size_t)(4 * bj + wc) * 4096 + ((dim >> 5) * 2 + (fq >> 1)) * 1024 + (dim & 31) * 16 + (fq & 1) * 8;
                        wt_store8(wb, q, (u32x2){w.x, w.y}); wt_store8(wb, q + 512, (u32x2){w.z, w.w}); } } }
    }
};
template <int ACT> struct EpiBf16 {
    static constexpr bool PERM = true, COL64 = false;
    bf16_t* O; int ldc; int probe; WtBuf wb;
    __device__ __forceinline__ bool operator()(AccRef acc, const g8::Unit& u, int wr, int wc, int fr, int fq) const { run(acc, u, wr, wc, fr, fq); return false; }
    __device__ __forceinline__ void run(AccRef acc, const g8::Unit& u, int wr, int wc, int fr, int fq) const {
        if (probe == 2) return;
#pragma unroll
        for (int ai = 0; ai < 2; ++ai)
#pragma unroll
            for (int m = 0; m < 4; ++m) { bf16_t* rowp = O + (size_t)(u.e0 + ai * 128 + wr * 64 + m * 16 + fr) * ldc + u.e1 + wc * 32 + 8 * fq;
                if (probe == 1) rowp = O + ((size_t)blockIdx.x * 256 + ai * 128 + wr * 64 + m * 16 + fr) * 256 + wc * 32 + 8 * fq;
                if (probe == 3) rowp = O + ((size_t)((blockIdx.x * 8 + wr * 4 + wc) * 8 + ai * 4 + m) * 2) * 512 + (fq * 16 + fr) * 8 - 0;
#pragma unroll
                for (int bj = 0; bj < 2; ++bj) { f32x4 v0 = acc[ai][bj][m][0], v1 = acc[ai][bj][m][1];
                    if (ACT == 1) {
#pragma unroll
                        for (int k = 0; k < 4; ++k) { v0[k] = sigmoidf_fast(v0[k]); v1[k] = sigmoidf_fast(v1[k]); } }
                    u32x4 w; w.x = pk2(v0[0], v0[1]); w.y = pk2(v0[2], v0[3]); w.z = pk2(v1[0], v1[1]); w.w = pk2(v1[2], v1[3]);
                    *(u32x4*)(rowp + bj * 128) = w; } }
    }
};
template <bool ADD> struct EpiGated {
    static constexpr bool PERM = true, COL64 = false;
    bf16_t* O; const bf16_t* gates; int gcol0;
    __device__ __forceinline__ bool operator()(AccRef acc, const g8::Unit& u, int wr, int wc, int fr, int fq) const { run(acc, u, wr, wc, fr, fq); return false; }
    __device__ __forceinline__ void run(AccRef acc, const g8::Unit& u, int wr, int wc, int fr, int fq) const {
        const int col = u.e1 + wc * 32 + 8 * fq;
        u32x4 gw[2][2], ow[2][2];
#define EG_LOAD(grp, buf) do { const size_t _row = (size_t)(u.e0 + ((grp) >> 2) * 128 + wr * 64 + ((grp) & 3) * 16 + fr); _Pragma("unroll") for (int bj = 0; bj < 2; ++bj) { \
        gw[buf][bj] = *(const u32x4*)(gates + _row * 2048 + gcol0 + col + bj * 128); if (ADD) ow[buf][bj] = *(const u32x4*)(O + _row * D + col + bj * 128); } } while (0)
        EG_LOAD(0, 0);
#pragma unroll
        for (int grp = 0; grp < 8; ++grp) {
            const int ai = grp >> 2, m = grp & 3;
            if (grp + 1 < 8) EG_LOAD(grp + 1, (grp + 1) & 1);
            __builtin_amdgcn_sched_barrier(0);
            const size_t row = (size_t)(u.e0 + ai * 128 + wr * 64 + m * 16 + fr);
#pragma unroll
            for (int bj = 0; bj < 2; ++bj) { const f32x4 v0 = acc[ai][bj][m][0], v1 = acc[ai][bj][m][1]; const u32x4 g = gw[grp & 1][bj];
                float r[8] = {v0[0] * bflo(g.x), v0[1] * bfhi(g.x), v0[2] * bflo(g.y), v0[3] * bfhi(g.y), v1[0] * bflo(g.z), v1[1] * bfhi(g.z), v1[2] * bflo(g.w), v1[3] * bfhi(g.w)};
                if (ADD) { const u32x4 o = ow[grp & 1][bj]; r[0] += bflo(o.x); r[1] += bfhi(o.x); r[2] += bflo(o.y); r[3] += bfhi(o.y); r[4] += bflo(o.z); r[5] += bfhi(o.z); r[6] += bflo(o.w); r[7] += bfhi(o.w); }
                u32x4 w; w.x = pk2(r[0], r[1]); w.y = pk2(r[2], r[3]); w.z = pk2(r[4], r[5]); w.w = pk2(r[6], r[7]);
                *(u32x4*)(O + row * D + col + bj * 128) = w; }
            __builtin_amdgcn_sched_barrier(0);
        }
#undef EG_LOAD
    }
};
struct EpiGates {
    static constexpr bool PERM = true, COL64 = false;
    bf16_t* Gt; WtBuf wb;
    __device__ __forceinline__ void run(AccRef acc, const g8::Unit& u, int wr, int wc, int fr, int fq) const {
#pragma unroll
        for (int ai = 0; ai < 2; ++ai)
#pragma unroll
            for (int m = 0; m < 4; ++m) { bf16_t* rowp = Gt + (size_t)(u.e0 + ai * 128 + wr * 64 + m * 16 + fr) * 2048 + u.e1 + wc * 32 + 8 * fq;
                float rho[8], sn[8];
#pragma unroll
                for (int n = 0; n < 2; ++n)
#pragma unroll
                    for (int k = 0; k < 4; ++k) { const float ea = __builtin_amdgcn_exp2f(-acc[ai][0][m][n][k] * LOG2E), en = __builtin_amdgcn_exp2f(-acc[ai][1][m][n][k] * LOG2E);
                        sn[4 * n + k] = __builtin_amdgcn_rcpf(1.0f + en); rho[4 * n + k] = (1.0f + en) * __builtin_amdgcn_rcpf(1.0f + ea); }
                u32x4 w; w.x = pk2(rho[0], rho[1]); w.y = pk2(rho[2], rho[3]); w.z = pk2(rho[4], rho[5]); w.w = pk2(rho[6], rho[7]); wt_store16(wb, rowp, w);
                w.x = pk2(sn[0], sn[1]); w.y = pk2(sn[2], sn[3]); w.z = pk2(sn[4], sn[5]); w.w = pk2(sn[6], sn[7]); wt_store16(wb, rowp + 1024, w); }
    }
};
struct EpiP1 {
    static constexpr bool PERM = true, COL64 = false;
    EpiQK<true> qkd; EpiQK<false> qkn; EpiGates gt; EpiVt vt; int skipmask;
    __device__ __forceinline__ bool operator()(AccRef acc, const g8::Unit& u, int wr, int wc, int fr, int fq) const {
        if ((skipmask >> u.ty) & 1) return false;
        if (u.ty == 0) qkd.run(acc, u, wr, wc, fr, fq);
        else if (u.ty == 1) qkn.run(acc, u, wr, wc, fr, fq);
        else if (u.ty == 2) gt.run(acc, u, wr, wc, fr, fq);
        else vt.run(acc, u, wr, wc, fr, fq);
        return false;
    }
};
struct EpiP3 {
    static constexpr bool PERM = true, COL64 = false;
    bf16_t* O; const bf16_t* Gt; WtBuf wb;
    __device__ __forceinline__ bool operator()(AccRef acc, const g8::Unit& u, int wr, int wc, int fr, int fq) const {
        const int col = u.e1 + wc * 32 + 8 * fq; const int gc = (u.ty ? 1024 : 0) + col;
        u32x4 gw[2][2];
#define EP3_LOAD(grp, buf) do { const size_t _row = (size_t)(u.e0 + ((grp) >> 2) * 128 + wr * 64 + ((grp) & 3) * 16 + fr); _Pragma("unroll") for (int bj = 0; bj < 2; ++bj) gw[buf][bj] = *(const u32x4*)(Gt + _row * 2048 + gc + bj * 128); } while (0)
        EP3_LOAD(0, 0);
#pragma unroll
        for (int grp = 0; grp < 8; ++grp) {
            const int ai = grp >> 2, m = grp & 3;
            if (grp + 1 < 8) EP3_LOAD(grp + 1, (grp + 1) & 1);
            __builtin_amdgcn_sched_barrier(0);
            const size_t row = (size_t)(u.e0 + ai * 128 + wr * 64 + m * 16 + fr);
#pragma unroll
            for (int bj = 0; bj < 2; ++bj) { const u32x4 g = gw[grp & 1][bj];
                const f32x4 s0 = {bflo(g.x), bfhi(g.x), bflo(g.y), bfhi(g.y)}, s1 = {bflo(g.z), bfhi(g.z), bflo(g.w), bfhi(g.w)};
                const f32x4 v0 = acc[ai][bj][m][0] * s0, v1 = acc[ai][bj][m][1] * s1;
                if (u.ty) { u32x4 w; w.x = pk2(v0[0], v0[1]); w.y = pk2(v0[2], v0[3]); w.z = pk2(v1[0], v1[1]); w.w = pk2(v1[2], v1[3]); wt_store16(wb, O + row * D + col + bj * 128, w); }
                else { acc[ai][bj][m][0] = v0; acc[ai][bj][m][1] = v1; } }
            __builtin_amdgcn_sched_barrier(0);
        }
#undef EP3_LOAD
        return u.ty == 0;
    }
};
struct EpiResid {
    static constexpr bool PERM = false, COL64 = false;
    const float* base; float* out;
    __device__ __forceinline__ bool operator()(AccRef acc, const g8::Unit& u, int wr, int wc, int fr, int fq) const { run(acc, u, wr, wc, fr, fq); return false; }
    __device__ __forceinline__ void run(AccRef acc, const g8::Unit& u, int wr, int wc, int fr, int fq) const {
        const int col = u.e1 + wc * 32 + 4 * fq;
        f32x4 bs[3][2][2];
#define ER_LOAD(grp, buf) do { const size_t _off = (size_t)(u.e0 + ((grp) >> 2) * 128 + wr * 64 + ((grp) & 3) * 16 + fr) * D + col; _Pragma("unroll") for (int bj = 0; bj < 2; ++bj) _Pragma("unroll") for (int n = 0; n < 2; ++n) \
        bs[buf][bj][n] = *(const f32x4*)(base + _off + bj * 128 + n * 16); } while (0)
        ER_LOAD(0, 0); ER_LOAD(1, 1);
#pragma unroll
        for (int grp = 0; grp < 8; ++grp) {
            const int ai = grp >> 2, m = grp & 3;
            if (grp + 2 < 8) ER_LOAD(grp + 2, (grp + 2) % 3);
            __builtin_amdgcn_sched_barrier(0);
            const size_t off = (size_t)(u.e0 + ai * 128 + wr * 64 + m * 16 + fr) * D + col;
#pragma unroll
            for (int bj = 0; bj < 2; ++bj)
#pragma unroll
                for (int n = 0; n < 2; ++n) *(f32x4*)(out + off + bj * 128 + n * 16) = bs[grp % 3][bj][n] + acc[ai][bj][m][n];
            __builtin_amdgcn_sched_barrier(0);
        }
#undef ER_LOAD
    }
};
struct EpiSwiGLU {
    static constexpr bool PERM = true, COL64 = false;
    bf16_t* H; int skip; WtBuf wb;
    __device__ __forceinline__ bool operator()(AccRef acc, const g8::Unit& u, int wr, int wc, int fr, int fq) const { run(acc, u, wr, wc, fr, fq); return false; }
    __device__ __forceinline__ void run(AccRef acc, const g8::Unit& u, int wr, int wc, int fr, int fq) const {
        if (skip) return;
#pragma unroll
        for (int ai = 0; ai < 2; ++ai)
#pragma unroll
            for (int m = 0; m < 4; ++m) { bf16_t* rowp = H + (size_t)(u.e0 + ai * 128 + wr * 64 + m * 16 + fr) * FF + u.e1 + wc * 32 + 8 * fq;
                float r[8];
#pragma unroll
                for (int n = 0; n < 2; ++n)
#pragma unroll
                    for (int k = 0; k < 4; ++k) { const float a = acc[ai][0][m][n][k], b = acc[ai][1][m][n][k]; r[4 * n + k] = a * sigmoidf_fast(a) * b; }
                u32x4 w; w.x = pk2(r[0], r[1]); w.y = pk2(r[2], r[3]); w.z = pk2(r[4], r[5]); w.w = pk2(r[6], r[7]);
                wt_store16(wb, rowp, w); }
    }
};
__device__ __forceinline__ void p0_transpose_item(const float* W, int K, int N, bf16_t* WT, int k0, int n0s, int n0d, LAS float* scr, int lane) {
#pragma unroll 8
    for (int i = 0; i < 32; ++i) { const int kk = 2 * i + (lane >> 5); scr[kk * 33 + (lane & 31)] = W[(size_t)(k0 + kk) * N + n0s + (lane & 31)]; }
    LDS_WAIT(); asm volatile("" ::: "memory");
    const int c = lane & 7;
#pragma unroll
    for (int j = 0; j < 4; ++j) { const int n = (lane >> 3) + 8 * j; const LAS float* s = scr + (8 * c) * 33 + n;
        u32x4 o; o.x = pk2(s[0 * 33], s[1 * 33]); o.y = pk2(s[2 * 33], s[3 * 33]); o.z = pk2(s[4 * 33], s[5 * 33]); o.w = pk2(s[6 * 33], s[7 * 33]);
        *(u32x4*)(WT + (size_t)(n0d + n) * K + k0 + 8 * c) = o; }
    LDS_WAIT(); asm volatile("" ::: "memory");
}
__device__ __forceinline__ int win_dst_row(int cg) {
    const int tile = cg >> 3, w = cg & 7;
    const bool qk = (tile < 6) || (tile >= 9 && tile < 13);
    if (tile >= 15) {
        const int isn = tile >= 19, c0 = (cg - (isn ? 152 : 120)) * 32;
        return (15 + (c0 >> 7)) * 256 + isn * 128 + ((c0 & 127) >> 5) * 32;
    }
    if (!qk) return cg * 32;
    const int wc = w >> 1, bj = w & 1;
    return tile * 256 + bj * 128 + wc * 32;
}
__device__ __forceinline__ double dsin_poly(double t) { const double t2 = t * t;
    return t * (1.0 + t2 * (-1.0 / 6 + t2 * (1.0 / 120 + t2 * (-1.0 / 5040 + t2 * (1.0 / 362880 + t2 * (-1.0 / 39916800 + t2 * (1.0 / 6227020800.0))))))); }
__device__ __forceinline__ double dcos_poly(double t) { const double t2 = t * t;
    return 1.0 + t2 * (-0.5 + t2 * (1.0 / 24 + t2 * (-1.0 / 720 + t2 * (1.0 / 40320 + t2 * (-1.0 / 3628800 + t2 * (1.0 / 479001600.0 + t2 * (-1.0 / 87178291200.0))))))); }

#ifndef MK_EXP_P0
#define MK_EXP_P0 8
#endif
#ifndef MK_EXP_P1
#define MK_EXP_P1 11
#endif
constexpr int EXP_P0 = MK_EXP_P0, EXP_P1 = MK_EXP_P1;
__device__ __forceinline__ void convert_experts(Frame& F, int e_lo, int e_hi, int rank, int nranks, unsigned* queue = nullptr) {
    LAS float* scr = (LAS float*)(F.lds + F.wave * 16384);
    const int lane = F.lane;
    bf16_t* WguT = (bf16_t*)(F.ws + WS_WGU); bf16_t* WdT = (bf16_t*)(F.ws + WS_WD);
    const float* w_gate = inptr(IN_WGATE); const float* w_up = inptr(IN_WUP); const float* w_down = inptr(IN_WDOWN);
    constexpr int I_E = 16 * 32;
    const int nit = (e_hi - e_lo) * 3 * I_E;
    for (int it = rank * 8 + F.wave;; it += nranks * 8) {
        if (queue) { unsigned t = 0; if (lane == 0) t = __hip_atomic_fetch_add(queue, 1u, __ATOMIC_RELAXED, __HIP_MEMORY_SCOPE_AGENT); it = (int)__builtin_amdgcn_readfirstlane(t); }
        if (it >= nit) break;
        const int e = e_lo + it / (3 * I_E), q = it % (3 * I_E), wsel = q / I_E, rr = q % I_E, kb = rr / 32, cg = rr % 32;
        if (wsel == 2) { p0_transpose_item(w_down + (size_t)e * FF * D, FF, D, WdT + (size_t)e * D * FF, 64 * kb, 32 * cg, 32 * cg, scr, lane); continue; }
        const int pn = cg >> 2, wcg = cg & 3;
        p0_transpose_item((wsel ? w_up : w_gate) + (size_t)e * D * FF, D, FF, WguT + (size_t)e * 2048 * D, 64 * kb, 32 * cg, pn * 256 + wsel * 128 + wcg * 32, scr, lane);
    }
}
__device__ __forceinline__ void p0_prologue(Frame& F) {
    phase_ids(F);
    LAS float* scr = (LAS float*)(F.lds + F.wave * 16384);
    const int gw = F.vcu * 8 + F.wave, NGW = F.G * 8, lane = F.lane;
    bf16_t* WinT = (bf16_t*)(F.ws + WS_WIN); bf16_t* PAt = (bf16_t*)(F.ws + WS_PA); bf16_t* PBt = (bf16_t*)(F.ws + WS_PB); bf16_t* WoT = (bf16_t*)(F.ws + WS_WO);
    const float* w_in = inptr(IN_WIN); const float* w_dil = inptr(IN_WDIL); const float* w_na = inptr(IN_WNA); const float* w_out = inptr(IN_WOUT);
    constexpr int I_IN = 16 * 184, I_PA = 4 * 32, I_PB = 8 * 32, I_WO = 16 * 32;
    constexpr int NITEMS = I_IN + I_PA + I_PB + I_WO;
    for (int it = gw; it < NITEMS; it += NGW) {
        int r = it;
        if (r < I_IN) { const int kb = r / 184, cg = r % 184; p0_transpose_item(w_in, D, INC, WinT, 64 * kb, 32 * cg, win_dst_row(cg), scr, lane); continue; } r -= I_IN;
        if (r < I_PA) { const int kb = r / 32, cg = r % 32; p0_transpose_item(w_dil, 256, D, PAt, 64 * kb, 32 * cg, 32 * cg, scr, lane); continue; } r -= I_PA;
        if (r < I_PB) { const int kb = r / 32, cg = r % 32; p0_transpose_item(w_na, 512, D, PBt, 64 * kb, 32 * cg, 32 * cg, scr, lane); continue; } r -= I_PB;
        p0_transpose_item(w_out, D, D, WoT, 64 * (r / 32), 32 * (r % 32), 32 * (r % 32), scr, lane);
    }
    convert_experts(F, 0, EXP_P0, F.vcu, F.G);
    bf16_t* HB = (bf16_t*)(F.ws + WS_HB);
    f32x4 gv[4];
#pragma unroll
    for (int j = 0; j < 4; ++j) gv[j] = *(const f32x4*)(inptr(IN_NORM1) + 4 * lane + 256 * j);
    const float* xin = inptr(IN_X);
    for (int m = gw; m < M; m += NGW) {
        const f32x4* xr = (const f32x4*)(xin + (size_t)m * D) + lane; f32x4 v[4]; float s = 0.f;
#pragma unroll
        for (int j = 0; j < 4; ++j) { v[j] = xr[64 * j]; s += (v[j][0] * v[j][0] + v[j][1] * v[j][1]) + (v[j][2] * v[j][2] + v[j][3] * v[j][3]); }
        const float rs = rsqrtf(wave_sum(s, lane) * (1.f / D) + EPS);
        u32x2* o8 = (u32x2*)(HB + (size_t)m * D) + lane;
#pragma unroll
        for (int j = 0; j < 4; ++j) { u32x2 w; w.x = pk2(v[j][0] * rs * gv[j][0], v[j][1] * rs * gv[j][1]); w.y = pk2(v[j][2] * rs * gv[j][2], v[j][3] * rs * gv[j][3]); o8[64 * j] = w; }
    }
    f32x2* rope = (f32x2*)(F.ws + WS_ROPE);
    for (int i = gw * 64 + lane; i < S * 32; i += NGW * 64) {
        const int pos = i >> 5, c = i & 31;
        const float inv = (float)exp2(-(double)c * (13.287712379549449 / 32.0));
        const double ang = (double)((float)pos * inv);
        const double kq = rint(ang * 0.6366197723675814);
        const double t = (ang - kq * 1.5707963267948966) - kq * 6.123233995736766e-17;
        const int q = ((int)kq) & 3;
        const double sv = dsin_poly(t), cv = dcos_poly(t);
        const double sn = (q == 0) ? sv : (q == 1 ? cv : (q == 2 ? -sv : -cv));
        const double cs = (q == 0) ? cv : (q == 1 ? -sv : (q == 2 ? -cv : sv));
        rope[i] = (f32x2){(float)cs, (float)sn};
    }
}
#define MFMA32(a, b, c) __builtin_amdgcn_mfma_f32_32x32x16_bf16((a), (b), (c), 0, 0, 0)
#define MFMA16(a, b, c) __builtin_amdgcn_mfma_f32_16x16x32_bf16((a), (b), (c), 0, 0, 0)
__device__ __forceinline__ int swz9(int tl) { return (tl & ~31) | ((tl ^ (tl >> 5)) & 31); }
__device__ __forceinline__ bf16x8 cat8(s16x4 lo, s16x4 hi) { return __builtin_shufflevector(lo, hi, 0, 1, 2, 3, 4, 5, 6, 7); }

#define SCHED_FENCE() __builtin_amdgcn_sched_barrier(0)
__device__ __forceinline__ void lds_fadd(LAS float* p, float v) { (void)__hip_atomic_fetch_add(p, v, __ATOMIC_RELAXED, __HIP_MEMORY_SCOPE_WORKGROUP); }

template <int NT>
__device__ __forceinline__ void dil_tile64(const bf16_t* Qp, const bf16_t* Kp, const bf16_t* Vp, int p0, int seg0, int seg1, float shift, f32x16 (&O)[NT][2], float (&lsum)[NT], int lane) {
    const int r = lane & 31, hf = lane >> 5;
    const bf16_t* ql = Qp + (size_t)p0 * 64 + lane * 8;
    const bf16_t* kl = Kp + lane * 8;
    const bf16_t* vl = Vp + lane * 8;
    bf16x8 qf[NT][4], kf[2][4], vf[2][2][2];
#pragma unroll
    for (int t = 0; t < NT; ++t)
#pragma unroll
        for (int s = 0; s < 4; ++s) qf[t][s] = *(const bf16x8*)(ql + 2048 * t + 512 * s);
#define DIL_KC(j) ((((p0 + 32 * ((j) - 2)) >= seg0) && ((p0 + 32 * ((j) - 2)) < seg1)) ? (p0 + 32 * ((j) - 2)) : p0)
#define DIL_TV(j) (((p0 + 32 * ((j) - 2)) >= seg0) && ((p0 + 32 * ((j) - 2)) < seg1))
#define DIL_LDK(j, slot) do { const bf16_t* _k = kl + (size_t)DIL_KC(j) * 64; _Pragma("unroll") for (int s = 0; s < 4; ++s) kf[slot][s] = *(const bf16x8*)(_k + 512 * s); } while (0)
#define DIL_LDV(j, slot) do { const bf16_t* _v = vl + (size_t)DIL_KC(j) * 64; _Pragma("unroll") for (int mt = 0; mt < 2; ++mt) _Pragma("unroll") for (int s2 = 0; s2 < 2; ++s2) vf[slot][mt][s2] = *(const bf16x8*)(_v + (mt * 2 + s2) * 512); } while (0)
    DIL_LDK(0, 0); DIL_LDV(0, 0);
    SCHED_FENCE();
#pragma unroll
    for (int t = 0; t < NT; ++t) { lsum[t] = 0.f;
#pragma unroll
        for (int i = 0; i < 16; ++i) { O[t][0][i] = 0.f; O[t][1][i] = 0.f; } }
#pragma unroll
    for (int j = 0; j < 4 + NT; ++j) {
        if (j + 1 < 4 + NT) { DIL_LDK(j + 1, (j + 1) & 1); DIL_LDV(j + 1, (j + 1) & 1); }
        SCHED_FENCE();
        const bool tv = DIL_TV(j);
#pragma unroll
        for (int t = 0; t < NT; ++t) {
            const int jj = j - t;
            if (jj >= 0 && jj <= 4) {
                f32x16 sa;
#pragma unroll
                for (int i = 0; i < 16; ++i) sa[i] = 0.f;
#pragma unroll
                for (int s = 0; s < 4; ++s) sa = MFMA32(kf[j & 1][s], qf[t][s], sa);
                float p[16];
#pragma unroll
                for (int reg = 0; reg < 16; ++reg) {
                    const int kk = (reg & 3) + 8 * (reg >> 2) + 4 * hf;
                    bool ok = tv;
                    if (jj == 0) ok = ok && (kk >= r);
                    if (jj == 4) ok = ok && (kk <= r);
                    const float e = __builtin_amdgcn_exp2f(sa[reg] - shift);
                    p[reg] = ok ? e : 0.f; lsum[t] += p[reg];
                }
#pragma unroll
                for (int s2 = 0; s2 < 2; ++s2) {
                    u32x4 pw; pw.x = pk2(p[8 * s2], p[8 * s2 + 1]); pw.y = pk2(p[8 * s2 + 2], p[8 * s2 + 3]); pw.z = pk2(p[8 * s2 + 4], p[8 * s2 + 5]); pw.w = pk2(p[8 * s2 + 6], p[8 * s2 + 7]);
                    const bf16x8 pb = __builtin_bit_cast(bf16x8, pw);
#pragma unroll
                    for (int mt = 0; mt < 2; ++mt) O[t][mt] = MFMA32(vf[j & 1][mt][s2], pb, O[t][mt]);
                }
            }
        }
        SCHED_FENCE();
    }
#undef DIL_KC
#undef DIL_TV
#undef DIL_LDK
#undef DIL_LDV
}

__device__ __forceinline__ void na_tile4(const bf16_t* Qp, const bf16_t* Kp, const bf16_t* Vp, bf16_t* yb, const LAS float* rpbl, int r0, int cb, float shift, int lane) {
    const int qi = lane & 15, q4 = lane >> 4;
    const int qc = 16 * cb + qi;
    const int kc0 = min(max(16 * cb - 8, 0), 32), ws = min(max(qc - 8, 0), 48);
    const int cA = kc0 + 4 * q4, cB = cA + 16;
    const int lo = (qi >> 3) * 512 + q4 * 64 + (qi & 7) * 8;
    const int mb = kc0 + 4 * q4 - ws;
    const int rs0 = min(max(r0 - 4, 0), 56);
    int off[4];
#pragma unroll
    for (int q = 0; q < 4; ++q) off[q] = min(max(r0 + q - 4, 0), 56) - rs0;
    const int nrows = off[3] + 8;
    const bf16_t* kl = Kp + (size_t)(rs0 * GW + kc0) * 64 + lo;
    const bf16_t* vlA = Vp + (size_t)(rs0 * GW + (cA & ~7)) * 64 + qi * 8 + (cA & 7);
    const bf16_t* vlB = Vp + (size_t)(rs0 * GW + (cB & ~7)) * 64 + qi * 8 + (cB & 7);
    const LAS float* bl = rpbl + (rs0 - r0 + 7) * 31 + (kc0 + 4 * q4 - qc + 15);
    bf16x8 qf[4][2], kf[3][2][2]; s16x4 vf[2][4][2];
#pragma unroll
    for (int q = 0; q < 4; ++q)
#pragma unroll
        for (int s = 0; s < 2; ++s) qf[q][s] = *(const bf16x8*)(Qp + (size_t)((r0 + q) * GW + 16 * cb) * 64 + lo + 256 * s);
#define NA_LDK(j, slot) do { const int _j = ((j) < nrows) ? (j) : (nrows - 1); _Pragma("unroll") for (int hh = 0; hh < 2; ++hh) _Pragma("unroll") for (int s = 0; s < 2; ++s) kf[slot][hh][s] = *(const bf16x8*)(kl + _j * 4096 + hh * 1024 + 256 * s); } while (0)
#define NA_LDV(j, slot) do { const int _j = ((j) < nrows) ? (j) : (nrows - 1); _Pragma("unroll") for (int mt = 0; mt < 4; ++mt) { vf[slot][mt][0] = *(const s16x4*)(vlA + _j * 4096 + mt * 128); vf[slot][mt][1] = *(const s16x4*)(vlB + _j * 4096 + mt * 128); } } while (0)
    NA_LDK(0, 0); NA_LDK(1, 1); NA_LDV(0, 0);
    SCHED_FENCE();
    bool okm[8];
#pragma unroll
    for (int e = 0; e < 8; ++e) okm[e] = (unsigned)(mb + 16 * (e >> 2) + (e & 3)) < 16u;
    f32x4 O[4][4]; float lsum[4];
#pragma unroll
    for (int q = 0; q < 4; ++q) { lsum[q] = 0.f;
#pragma unroll
        for (int mt = 0; mt < 4; ++mt) O[q][mt] = (f32x4){0.f, 0.f, 0.f, 0.f}; }
#pragma unroll
    for (int j = 0; j < 11; ++j) {
        if (j < nrows) {
            if (j + 2 < 11) { NA_LDK(j + 2, (j + 2) % 3); }
            if (j + 1 < 11) { NA_LDV(j + 1, (j + 1) & 1); }
            SCHED_FENCE();
#pragma unroll
            for (int q = 0; q < 4; ++q) {
                if (j - q >= -3 && j - q <= 10 && j >= off[q] && j < off[q] + 8) {
                    float p[8];
#pragma unroll
                    for (int hh = 0; hh < 2; ++hh) {
                        f32x4 sa = (f32x4){0.f, 0.f, 0.f, 0.f};
#pragma unroll
                        for (int s = 0; s < 2; ++s) sa = MFMA16(kf[j % 3][hh][s], qf[q][s], sa);
#pragma unroll
                        for (int v = 0; v < 4; ++v) {
                            const float e = __builtin_amdgcn_exp2f(sa[v] + bl[(j - q) * 31 + 16 * hh + v] - shift);
                            p[4 * hh + v] = okm[4 * hh + v] ? e : 0.f; lsum[q] += p[4 * hh + v];
                        }
                    }
                    u32x4 pw; pw.x = pk2(p[0], p[1]); pw.y = pk2(p[2], p[3]); pw.z = pk2(p[4], p[5]); pw.w = pk2(p[6], p[7]);
                    const bf16x8 pb = __builtin_bit_cast(bf16x8, pw);
#pragma unroll
                    for (int mt = 0; mt < 4; ++mt) O[q][mt] = MFMA16(cat8(vf[j & 1][mt][0], vf[j & 1][mt][1]), pb, O[q][mt]);
                }
            }
            SCHED_FENCE();
        }
    }
#undef NA_LDK
#undef NA_LDV
#pragma unroll
    for (int q = 0; q < 4; ++q) {
        float l = lsum[q]; l += shx(l, 16, lane); l += shx(l, 32, lane);
        const float inv = 1.0f / l;
#pragma unroll
        for (int mt = 0; mt < 4; ++mt) { u32x2 w; w.x = pk2(O[q][mt][0] * inv, O[q][mt][1] * inv); w.y = pk2(O[q][mt][2] * inv, O[q][mt][3] * inv);
            *(u32x2*)(yb + (size_t)((r0 + q) * GW + qc) * 512 + 16 * mt + 4 * q4) = w; }
    }
}

__device__ __forceinline__ void p2_attention(Frame& F, const int flags) {
    phase_ids(F);
    const int lane = F.lane, wave = F.wave, tid = F.tid;
    LAS float* Ol = (LAS float*)F.lds;
    LAS float* Ll = (LAS float*)(F.lds + LDS_L_OFF);
    const bf16_t* Qd = (const bf16_t*)(F.ws + WS_QD); const bf16_t* Kd = (const bf16_t*)(F.ws + WS_KD); const bf16_t* Vtd = (const bf16_t*)(F.ws + WS_VTD);
    const bf16_t* Qn = (const bf16_t*)(F.ws + WS_QN); const bf16_t* Kn = (const bf16_t*)(F.ws + WS_KN); const bf16_t* Vtn = (const bf16_t*)(F.ws + WS_VTN);
    bf16_t* YA = (bf16_t*)(F.ws + WS_YA); bf16_t* YB = (bf16_t*)(F.ws + WS_YB);
    const float shiftD = 8.0f * wave_max(fabsf(inptr(IN_DQG)[lane]), lane) * wave_max(fabsf(inptr(IN_DKG)[lane]), lane) * LOG2E;
    if (!(flags & 1))
    for (int su = F.vcu; su < 256; su += F.G) {
        const int b = su >> 5, h = (su >> 3) & 3, T0 = (su & 7) * 512;
#pragma unroll 1
        for (int g = 0; g < 3; ++g) {
            const int d = dil_of(g), L = S / d, sh = (g == 0) ? 3 : (g == 1 ? 1 : 0), head = g * 4 + h;
            const bf16_t* Qp = Qd + (size_t)(b * DILH + head) * S * 64; const bf16_t* Kp = Kd + (size_t)(b * DILH + head) * S * 64; const bf16_t* Vp = Vtd + (size_t)(b * DILH + head) * 64 * S;
            if (g < 2) {
                const int rres = wave >> sh, tq = wave & ((1 << sh) - 1);
                const int p0 = rres * L + T0 / d + tq * 64;
                f32x16 O[2][2]; float lsum[2];
                dil_tile64<2>(Qp, Kp, Vp, p0, rres * L, (rres + 1) * L, shiftD, O, lsum, lane);
                const int r = lane & 31, hf = lane >> 5;
#pragma unroll
                for (int t = 0; t < 2; ++t) {
                    const int sw = swz9((tq * 64 + 32 * t + r) * d + rres);
                    const float lt = lsum[t] + shx(lsum[t], 32, lane);
                    if (g == 0) {
#pragma unroll
                        for (int mt = 0; mt < 2; ++mt)
#pragma unroll
                            for (int reg = 0; reg < 16; ++reg) Ol[(32 * mt + (reg & 3) + 8 * (reg >> 2) + 4 * hf) * 512 + sw] = O[t][mt][reg];
                        if (hf == 0) Ll[sw] = lt;
                    } else {
#pragma unroll
                        for (int mt = 0; mt < 2; ++mt)
#pragma unroll
                            for (int reg = 0; reg < 16; ++reg) Ol[(32 * mt + (reg & 3) + 8 * (reg >> 2) + 4 * hf) * 512 + sw] += O[t][mt][reg];
                        if (hf == 0) Ll[sw] += lt;
                    }
                }
            } else {
#pragma unroll 1
                for (int tt = 0; tt < 2; ++tt) {
                    const int rres = wave + 8 * tt, p0 = rres * L + T0 / d;
                    f32x16 O[1][2]; float lsum[1];
                    dil_tile64<1>(Qp, Kp, Vp, p0, rres * L, (rres + 1) * L, shiftD, O, lsum, lane);
                    const int r = lane & 31, hf = lane >> 5;
                    const int sw = swz9(r * d + rres);
                    const float lt = lsum[0] + shx(lsum[0], 32, lane);
#pragma unroll
                    for (int mt = 0; mt < 2; ++mt)
#pragma unroll
                        for (int reg = 0; reg < 16; ++reg) Ol[(32 * mt + (reg & 3) + 8 * (reg >> 2) + 4 * hf) * 512 + sw] += O[0][mt][reg];
                    if (hf == 0) Ll[sw] += lt;
                }
            }
            __syncthreads();
        }
        {
            const int sw = swz9(tid); const float inv = 1.0f / Ll[sw];
            bf16_t* op = YA + ((size_t)b * S + T0 + tid) * 256 + h * 64;
#pragma unroll
            for (int c = 0; c < 8; ++c) { float v[8];
#pragma unroll
                for (int k = 0; k < 8; ++k) v[k] = Ol[(8 * c + k) * 512 + sw] * inv;
                u32x4 w; w.x = pk2(v[0], v[1]); w.y = pk2(v[2], v[3]); w.z = pk2(v[4], v[5]); w.w = pk2(v[6], v[7]);
                *(u32x4*)(op + 8 * c) = w; }
        }
        __syncthreads();
    }
    phase_ids(F);
    const int lane2 = F.lane, wave2 = F.wave, tid2 = F.tid;
    const float boundN = 8.0f * wave_max(fabsf(inptr(IN_NQG)[lane2]), lane2) * wave_max(fabsf(inptr(IN_NKG)[lane2]), lane2) * LOG2E;
    LAS float* rpbl = (LAS float*)(F.lds + 256);
    LAS float* red = (LAS float*)(F.lds + LDS_L_OFF);
    float mx = 0.f;
    const float* rpb = inptr(IN_RPB);
    for (int i = tid2; i < NAH * 465; i += 512) { const float v = rpb[i]; rpbl[i] = v * LOG2E; mx = fmaxf(mx, fabsf(v)); }
    mx = wave_max(mx, lane2);
    if (lane2 == 0) red[wave2] = mx;
    __syncthreads();
    float bmax = 0.f;
#pragma unroll
    for (int w = 0; w < 8; ++w) bmax = fmaxf(bmax, red[w]);
    const float shiftN = boundN + bmax * LOG2E;
    if (!(flags & 2))
    for (int su = F.vcu; su < 256; su += F.G) {
        const int b = su >> 5, head = (su >> 2) & 7, band = su & 3;
        const bf16_t* Qp = Qn + (size_t)(b * NAH + head) * S * 64; const bf16_t* Kp = Kn + (size_t)(b * NAH + head) * S * 64; const bf16_t* Vp = Vtn + (size_t)(b * NAH + head) * 64 * S;
        bf16_t* yb = YB + (size_t)b * S * 512 + head * 64;
#pragma unroll 1
        for (int t = 0; t < 2; ++t) na_tile4(Qp, Kp, Vp, yb, rpbl + head * 465, band * 16 + 4 * (wave2 >> 1), 2 * (wave2 & 1) + t, shiftN, lane2);
    }
    __syncthreads();
}

__device__ __forceinline__ void p5_norm_router(Frame& F) {
    phase_ids(F);
    const int lane = F.lane, tid = F.tid;
    const float* w_router = inptr(IN_WROUTER); const float* norm2_g = inptr(IN_NORM2); const float* xin = inptr(IN_X); const bf16_t* dlt = (const bf16_t*)(F.ws + WS_DLT);
    LAS float* wl = (LAS float*)F.lds;
    for (int i = tid; i < D * NE; i += 512) { const int d = i >> 4, e = i & 15, ln = (d & 255) >> 2, ii = d & 3, j = d >> 8, q = e >> 2, c = e & 3;
        wl[((((j * 4 + ii) * 4 + q) * 64 + ln) << 2) + c] = w_router[i]; }
    __syncthreads();
    const int gw = F.vcu * 8 + F.wave, NGW = F.G * 8;
    bf16_t* H2 = (bf16_t*)(F.ws + WS_HB); float* aff = (float*)(F.ws + WS_AFF);
    const int myexp = ((lane & 1) << 3) | ((lane & 2) << 1) | ((lane & 4) >> 1) | ((lane & 8) >> 3);
    f32x4 xn[2][4]; u32x2 dn[2][4];
#define P5_LOAD(mm) do { _Pragma("unroll") for (int r = 0; r < 2; ++r) { const f32x4* _x = (const f32x4*)(xin + (size_t)((mm) + r) * D) + lane; const u32x2* _d = (const u32x2*)(dlt + (size_t)((mm) + r) * D) + lane; \
        _Pragma("unroll") for (int j = 0; j < 4; ++j) { xn[r][j] = _x[64 * j]; dn[r][j] = _d[64 * j]; } } } while (0)
    if (gw * 2 < M) P5_LOAD(gw * 2);
    for (int m0 = gw * 2; m0 < M; m0 += NGW * 2) {
        f32x2 lg[16];
#pragma unroll
        for (int e = 0; e < 16; ++e) lg[e] = (f32x2){0.f, 0.f};
        float rs[2]; f32x4 v[2][4];
#pragma unroll
        for (int r = 0; r < 2; ++r) { float s = 0.f;
#pragma unroll
            for (int j = 0; j < 4; ++j) { const u32x2 dw = dn[r][j]; v[r][j] = xn[r][j] + (f32x4){bflo(dw.x), bfhi(dw.x), bflo(dw.y), bfhi(dw.y)};
                s += (v[r][j][0] * v[r][j][0] + v[r][j][1] * v[r][j][1]) + (v[r][j][2] * v[r][j][2] + v[r][j][3] * v[r][j][3]); }
            rs[r] = rsqrtf(wave_sum(s, lane) * (1.f / D) + EPS); }
        { const int mn = m0 + NGW * 2; P5_LOAD(mn < M ? mn : m0); }
        __builtin_amdgcn_sched_barrier(0);
#pragma unroll
        for (int j = 0; j < 4; ++j) {
            const f32x4 gj = *(const f32x4*)(norm2_g + 4 * lane + 256 * j);
#pragma unroll
            for (int r = 0; r < 2; ++r) { v[r][j] = v[r][j] * rs[r] * gj;
                u32x2 w; w.x = pk2(v[r][j][0], v[r][j][1]); w.y = pk2(v[r][j][2], v[r][j][3]); ((u32x2*)(H2 + (size_t)(m0 + r) * D) + lane)[64 * j] = w; }
#pragma unroll
            for (int i = 0; i < 4; ++i) {
                const f32x2 hv = {v[0][j][i], v[1][j][i]};
#pragma unroll
                for (int q = 0; q < 4; ++q) { const f32x4 w4 = *(const LAS f32x4*)(wl + ((((j * 4 + i) * 4 + q) * 64 + lane) << 2));
                    lg[4 * q + 0] += hv * w4[0]; lg[4 * q + 1] += hv * w4[1]; lg[4 * q + 2] += hv * w4[2]; lg[4 * q + 3] += hv * w4[3]; }
                __builtin_amdgcn_sched_barrier(0);
            }
        }
#pragma unroll
        for (int r = 0; r < 2; ++r) {
            float a8[8], a4[4], a2[2], a1;
            { const bool up = lane & 1;
#pragma unroll
              for (int k = 0; k < 8; ++k) { const float keep = up ? lg[8 + k][r] : lg[k][r], send = up ? lg[k][r] : lg[8 + k][r]; a8[k] = keep + shx(send, 1, lane); } }
            { const bool up = lane & 2;
#pragma unroll
              for (int k = 0; k < 4; ++k) { const float keep = up ? a8[4 + k] : a8[k], send = up ? a8[k] : a8[4 + k]; a4[k] = keep + shx(send, 2, lane); } }
            { const bool up = lane & 4;
#pragma unroll
              for (int k = 0; k < 2; ++k) { const float keep = up ? a4[2 + k] : a4[k], send = up ? a4[k] : a4[2 + k]; a2[k] = keep + shx(send, 4, lane); } }
            { const bool up = lane & 8; const float keep = up ? a2[1] : a2[0], send = up ? a2[0] : a2[1]; a1 = keep + shx(send, 8, lane); }
            a1 += shx(a1, 16, lane); a1 += shx(a1, 32, lane);
            float mx = a1;
#pragma unroll
            for (int o = 1; o < 16; o <<= 1) mx = fmaxf(mx, shx(mx, o, lane));
            const float p = __expf(a1 - mx); float den = p;
#pragma unroll
            for (int o = 1; o < 16; o <<= 1) den += shx(den, o, lane);
            const int m = m0 + r;
            if (lane < 16) aff[((size_t)((m >> 12) * NE + myexp) << 12) + (m & 4095)] = p / den;
        }
    }
#undef P5_LOAD
    __syncthreads();
}

__device__ __forceinline__ int wave_sum_i(int v, int lane) {
#pragma unroll
    for (int o = 1; o < 64; o <<= 1) v += shxi(v, o, lane);
    return v;
}
__device__ __forceinline__ void p6_topk(Frame& F) {
    phase_ids(F);
    const int lane = F.lane, tid = F.tid, wave = F.wave;
    LAS int* red = (LAS int*)F.lds;
    const float* aff = (const float*)(F.ws + WS_AFF); int* idx = (int*)(F.ws + WS_IDX); float* glist = (float*)(F.ws + WS_GLIST); int* tokslot = (int*)(F.ws + WS_TOKSLOT);
    for (int li = F.vcu; li < NB * NE; li += F.G) {
        const int b = li >> 4, e = li & 15;
        const float* ap = aff + (size_t)li * S + 8 * tid;
        const f32x4 a0 = *(const f32x4*)ap, a1 = *(const f32x4*)(ap + 4);
        const float av[8] = {a0[0], a0[1], a0[2], a0[3], a1[0], a1[1], a1[2], a1[3]};
        unsigned key[8];
#pragma unroll
        for (int k = 0; k < 8; ++k) key[k] = __builtin_bit_cast(unsigned, av[k]);
        unsigned tau = 0u; int par = 0;
        for (int bit = 30; bit >= 0; --bit) {
            const unsigned cand = tau | (1u << bit); int c = 0;
#pragma unroll
            for (int k = 0; k < 8; ++k) c += (key[k] >= cand) ? 1 : 0;
            c = wave_sum_i(c, lane);
            if (lane == 0) red[par * 8 + wave] = c;
            __syncthreads();
            int tot = 0;
#pragma unroll
            for (int w = 0; w < 8; ++w) tot += red[par * 8 + w];
            if (tot >= CAP) tau = cand;
            par ^= 1;
        }
        int cg = 0, ce = 0;
#pragma unroll
        for (int k = 0; k < 8; ++k) { cg += (key[k] > tau) ? 1 : 0; ce += (key[k] == tau) ? 1 : 0; }
        int pkc = cg | (ce << 16), incl = pkc;
#pragma unroll
        for (int o = 1; o < 64; o <<= 1) { const int t = __builtin_amdgcn_ds_bpermute((lane - o) << 2, incl); if (lane >= o) incl += t; }
        __syncthreads();
        if (lane == 63) red[64 + wave] = incl;
        __syncthreads();
        int wpre = 0, total = 0;
#pragma unroll
        for (int w = 0; w < 8; ++w) { const int t = red[64 + w]; if (w < wave) wpre += t; total += t; }
        const int excl = wpre + incl - pkc;
        int gt_before = excl & 0xffff, eq_before = excl >> 16;
        const int need = CAP - (total & 0xffff);
        const size_t rowbase = (size_t)(e * NB + b) * CAP;
#pragma unroll
        for (int k = 0; k < 8; ++k) {
            const bool isg = key[k] > tau, ise = key[k] == tau;
            const bool sel = isg || (ise && eq_before < need);
            const int slot = gt_before + min(eq_before, need);
            const int tok = 8 * tid + k;
            if (sel) { idx[rowbase + slot] = tok; glist[rowbase + slot] = av[k]; }
            tokslot[(size_t)li * S + tok] = sel ? slot : -1;
            gt_before += isg ? 1 : 0; eq_before += ise ? 1 : 0;
        }
        __syncthreads();
    }
}

__device__ __forceinline__ int p9_slot(const int (&ts)[4], int e, int t) {
    const int src = (e >> 2) * 16 + t, k = e & 3;
    const int v = (k == 0) ? ts[0] : (k == 1 ? ts[1] : (k == 2 ? ts[2] : ts[3]));
    return __builtin_amdgcn_readlane(v, src);
}
__device__ __forceinline__ void p9_combine(Frame& F, const int flags) {
    phase_ids(F);
    const int lane = F.lane; (void)flags;
    const int gw = F.vcu * 8 + F.wave, NGW = F.G * 8;
    const int* tokslot = (const int*)(F.ws + WS_TOKSLOT); const bf16_t* Y = (const bf16_t*)(F.ws + WS_Y); const float* glist = (const float*)(F.ws + WS_GLIST);
    const float* xin = inptr(IN_X); const bf16_t* dlt = (const bf16_t*)(F.ws + WS_DLT);
    for (int ch = gw; ch < M / 16; ch += NGW) {
        const int t0 = ch * 16, b = t0 >> 12, s0 = t0 & 4095;
        int ts[4];
        unsigned long long bal[4];
#pragma unroll
        for (int k = 0; k < 4; ++k) { ts[k] = tokslot[((size_t)(b * NE + 4 * (lane >> 4) + k) << 12) + s0 + (lane & 15)]; bal[k] = __ballot(ts[k] >= 0); }
        f32x4 bx[2][4]; u32x2 bd[2][4], by[2][3][4]; float wy[2][3]; unsigned rest[2];
#define P9_ISSUE(t, buf) do { const f32x4* _x = (const f32x4*)(xin + (size_t)(t0 + (t)) * D) + lane; const u32x2* _d = (const u32x2*)(dlt + (size_t)(t0 + (t)) * D) + lane; \
            _Pragma("unroll") for (int j = 0; j < 4; ++j) { bx[buf][j] = _x[64 * j]; bd[buf][j] = _d[64 * j]; } \
            unsigned _m = 0u; _Pragma("unroll") for (int k = 0; k < 4; ++k) _Pragma("unroll") for (int eg = 0; eg < 4; ++eg) _m |= (unsigned)((bal[k] >> (eg * 16 + (t))) & 1ull) << (4 * eg + k); \
            _Pragma("unroll") for (int i = 0; i < 3; ++i) { size_t _row = 0; float _w = 0.f; \
                if (_m) { const int _e = __builtin_ctz(_m); _m &= _m - 1u; const int _s = p9_slot(ts, _e, (t)); _row = (size_t)(_e * NB + b) * CAP + _s; _w = glist[_row]; } \
                const u32x2* _y = (const u32x2*)(Y + _row * D) + lane; _Pragma("unroll") for (int j = 0; j < 4; ++j) by[buf][i][j] = _y[64 * j]; wy[buf][i] = _w; } \
            rest[buf] = _m; } while (0)
#define P9_CONSUME(t, buf) do { f32x4 acc[4]; \
            _Pragma("unroll") for (int j = 0; j < 4; ++j) { const u32x2 dw = bd[buf][j]; acc[j] = bx[buf][j] + (f32x4){bflo(dw.x), bfhi(dw.x), bflo(dw.y), bfhi(dw.y)}; } \
            _Pragma("unroll") for (int i = 0; i < 3; ++i) { const float _w = wy[buf][i]; _Pragma("unroll") for (int j = 0; j < 4; ++j) { const u32x2 w = by[buf][i][j]; \
                acc[j][0] += _w * bflo(w.x); acc[j][1] += _w * bfhi(w.x); acc[j][2] += _w * bflo(w.y); acc[j][3] += _w * bfhi(w.y); } } \
            unsigned _m = rest[buf]; \
            while (_m) { const int _e = __builtin_ctz(_m); _m &= _m - 1u; const int _s = p9_slot(ts, _e, (t)); const size_t _r = (size_t)(_e * NB + b) * CAP + _s; const u32x2* _y = (const u32x2*)(Y + _r * D) + lane; const float _g = glist[_r]; \
                _Pragma("unroll") for (int j = 0; j < 4; ++j) { const u32x2 w = _y[64 * j]; acc[j][0] += _g * bflo(w.x); acc[j][1] += _g * bfhi(w.x); acc[j][2] += _g * bflo(w.y); acc[j][3] += _g * bfhi(w.y); } } \
            f32x4* _o = (f32x4*)(F.out + (size_t)(t0 + (t)) * D) + lane; _Pragma("unroll") for (int j = 0; j < 4; ++j) _o[64 * j] = acc[j]; } while (0)
        P9_ISSUE(0, 0);
#pragma unroll 1
        for (int t = 0; t < 16; t += 2) {
            P9_ISSUE(t + 1, 1); __builtin_amdgcn_sched_barrier(0);
            P9_CONSUME(t, 0); __builtin_amdgcn_sched_barrier(0);
            { const int tn = (t + 2 < 16) ? t + 2 : t; P9_ISSUE(tn, 0); } __builtin_amdgcn_sched_barrier(0);
            P9_CONSUME(t + 1, 1); __builtin_amdgcn_sched_barrier(0);
        }
#undef P9_ISSUE
#undef P9_CONSUME
    }
}

constexpr int N_PHASES = 10;
struct Args { const float* in[16]; float* out; unsigned char* ws; int ph_lo, ph_hi, flags, pad; };
__global__ void __launch_bounds__(512, 2) mk_fwd(Args args) {
    extern __shared__ __attribute__((aligned(16))) unsigned char lds_raw[];
    Frame F;
    F.lds = (LAS unsigned char*)lds_raw;
    { const int t0 = threadIdx.x; F.wave = __builtin_amdgcn_readfirstlane(t0 >> 6); } phase_ids(F);
    F.G = gridDim.x; { const int bx = blockIdx.x; F.vcu = (F.G % 8 == 0) ? (bx % 8) * (F.G / 8) + bx / 8 : bx; }
    F.out = args.out; F.ws = args.ws;
    volatile LAS unsigned* misc = (volatile LAS unsigned*)(F.lds + LDS_MISC_OFF);
    if (F.tid < 64) misc[F.tid] = 0u;
    __syncthreads();
    const int lo = args.ph_lo, hi = args.ph_hi;
    unsigned* ctl = (unsigned*)(F.ws + WS_CTL);
    XcdBarrier bar; bar.bar = ctl + CW_BAR; bar.x = 0; bar.st = misc + 8;
    if (hi - lo > 1) bar = xcd_barrier_post(ctl + CW_BAR, misc + 8, F.tid == 0);
#ifdef MK_ONLY_PHASE
#define IN(k) ((k) == MK_ONLY_PHASE && lo <= (k) && (k) < hi)
#else
#define IN(k) (lo <= (k) && (k) < hi)
#endif
#define SEAM(k) do { if (IN(k) && IN((k) + 1)) { phase_ids(F); xcd_barrier(bar, F.tid == 0); } } while (0)
    const int c = (int)blockIdx.x, G = F.G;
    const char* hb = (const char*)(F.ws + WS_HB); const char* win = (const char*)(F.ws + WS_WIN);
    const WtBuf wbws = wt_make(F.ws, 0x20000000u), wbout = wt_make(F.out, 0x08000000u);
    bf16_t* gates = (bf16_t*)F.out;

    if (IN(0)) { p0_prologue(F); VM_WAIT(); __syncthreads(); }
    SEAM(0);
    if (IN(1)) {
        SchedP1 S1{ SchedQKd{hb, win, (char*)(F.ws + WS_QD), (char*)(F.ws + WS_KD), G, c}, SchedQKn{hb, win, (char*)(F.ws + WS_QN), (char*)(F.ws + WS_KN), G, c},
                    SchedGates{hb, win, G, c}, SchedVt{hb, win, (char*)(F.ws + WS_VTD), (char*)(F.ws + WS_VTN), G, c}, G, c };
        EpiP1 E1{ EpiQK<true>{inptr(IN_DQG), inptr(IN_DKG), (const f32x2*)(F.ws + WS_ROPE), 0.125f * LOG2E, wbws}, EpiQK<false>{inptr(IN_NQG), inptr(IN_NKG), nullptr, 0.125f * LOG2E, wbws},
                  EpiGates{gates, wbout}, EpiVt{wbws}, (args.flags >> 8) & 15 };
        g8::gemm_phase<EpiP1, SchedP1, false>(F.lds, S1, E1, F.wave);
        { const int rem = 2944 % G; if (rem > 0 && c >= rem) { phase_ids(F); convert_experts(F, EXP_P0, EXP_P1, c - rem, G - rem); } }
    }
    SEAM(1);
    if (IN(2)) p2_attention(F, args.flags);
    SEAM(2);
    if (IN(3)) {
        SchedP3 S3{(const char*)(F.ws + WS_YA), (const char*)(F.ws + WS_PA), (const char*)(F.ws + WS_YB), (const char*)(F.ws + WS_PB), G, c};
        EpiP3 E3{(bf16_t*)(F.ws + WS_HB), gates, wbws};
        g8::gemm_phase<EpiP3, SchedP3, false>(F.lds, S3, E3, F.wave);
    }
    SEAM(3);
    if (IN(4)) {
        SchedDense So{(const char*)(F.ws + WS_HB), (const char*)(F.ws + WS_WO), D * 2, D * 2, 128, 4, G, c, 16};
        EpiBf16<0> E{(bf16_t*)(F.ws + WS_DLT), D, 0, wbws};
        g8::gemm_phase<EpiBf16<0>, SchedDense, false>(F.lds, So, E, F.wave);
    }
    SEAM(4);
    if (IN(5)) p5_norm_router(F);
    SEAM(5);
    if (IN(6)) {
        p6_topk(F);
        const int nl = NB * NE;
        if (F.G > nl) { if (F.vcu >= nl) convert_experts(F, EXP_P1, NE, F.vcu - nl, F.G - nl); }
        else convert_experts(F, EXP_P1, NE, F.vcu, F.G);
    }
    SEAM(6);
    if (IN(7)) {
        SchedGU Sg{(const char*)(F.ws + WS_HB), (const char*)(F.ws + WS_WGU), (const int*)(F.ws + WS_IDX), G, c};
        EpiSwiGLU E{(bf16_t*)(F.ws + WS_H), args.flags & 64, wbws};
        g8::gemm_phase<EpiSwiGLU, SchedGU, true>(F.lds, Sg, E, F.wave);
    }
    SEAM(7);
    if (IN(8)) {
        SchedDown Sd{(const char*)(F.ws + WS_H), (const char*)(F.ws + WS_WD), G, c};
        EpiBf16<0> E{(args.flags & 64) ? (bf16_t*)(F.ws + WS_HB) : (bf16_t*)(F.ws + WS_Y), D, (args.flags >> 6) & 3, wbws};
        g8::gemm_phase<EpiBf16<0>, SchedDown, false>(F.lds, Sd, E, F.wave);
    }
    SEAM(8);
    if (IN(9)) p9_combine(F, args.flags);
#undef IN
#undef SEAM
}
#ifndef MK_HYB
#define MK_HYB 10
#endif
#ifndef MK_PER_PHASE
#define MK_PER_PHASE 0
#endif

#if MK_HYB < 10
namespace tail {
struct GemmArgs { const float* A; const float* Bm; float* C; const int* gather; int M, N, K, lda, ldb, ldc; long sA, sB, sC; int sG; };
__global__ void __launch_bounds__(256) k_gemm(GemmArgs g) {
    __shared__ float As[16][128 + 4];
    __shared__ float Bs[16][128 + 4];
    const int z = blockIdx.z;
    const float* A = g.A + (long)z * g.sA; const float* Bm = g.Bm + (long)z * g.sB; float* C = g.C + (long)z * g.sC;
    const int* gi = g.gather ? g.gather + (long)z * g.sG : nullptr;
    const int m0 = blockIdx.y * 128, n0 = blockIdx.x * 128, tid = threadIdx.x, tx = tid & 15, ty = tid >> 4;
    float acc[8][8];
#pragma unroll
    for (int i = 0; i < 8; ++i)
#pragma unroll
        for (int j = 0; j < 8; ++j) acc[i][j] = 0.f;
    const int ar = tid >> 1, ak = (tid & 1) * 8;
    const long arow = gi ? (long)gi[m0 + ar] : (long)(m0 + ar);
    const float* ap = A + arow * g.lda + ak;
    const int bk = tid >> 4, bn = (tid & 15) * 8;
    const float* bp = Bm + (long)bk * g.ldb + n0 + bn;
    for (int k0 = 0; k0 < g.K; k0 += 16) {
        const float4 a0 = *(const float4*)(ap + k0), a1 = *(const float4*)(ap + k0 + 4);
        const float4 b0 = *(const float4*)(bp + (long)k0 * g.ldb), b1 = *(const float4*)(bp + (long)k0 * g.ldb + 4);
        __syncthreads();
        As[ak + 0][ar] = a0.x; As[ak + 1][ar] = a0.y; As[ak + 2][ar] = a0.z; As[ak + 3][ar] = a0.w;
        As[ak + 4][ar] = a1.x; As[ak + 5][ar] = a1.y; As[ak + 6][ar] = a1.z; As[ak + 7][ar] = a1.w;
        *(float4*)&Bs[bk][bn] = b0; *(float4*)&Bs[bk][bn + 4] = b1;
        __syncthreads();
#pragma unroll
        for (int k = 0; k < 16; ++k) {
            float av[8], bv[8];
            const float4 x0 = *(const float4*)&As[k][ty * 4], x1 = *(const float4*)&As[k][64 + ty * 4];
            const float4 y0 = *(const float4*)&Bs[k][tx * 4], y1 = *(const float4*)&Bs[k][64 + tx * 4];
            av[0] = x0.x; av[1] = x0.y; av[2] = x0.z; av[3] = x0.w; av[4] = x1.x; av[5] = x1.y; av[6] = x1.z; av[7] = x1.w;
            bv[0] = y0.x; bv[1] = y0.y; bv[2] = y0.z; bv[3] = y0.w; bv[4] = y1.x; bv[5] = y1.y; bv[6] = y1.z; bv[7] = y1.w;
#pragma unroll
            for (int i = 0; i < 8; ++i)
#pragma unroll
                for (int j = 0; j < 8; ++j) acc[i][j] = fmaf(av[i], bv[j], acc[i][j]);
        }
    }
#pragma unroll
    for (int i = 0; i < 8; ++i) {
        const int m = m0 + (i < 4 ? ty * 4 + i : 64 + ty * 4 + (i - 4));
        float* cp = C + (long)m * g.ldc + n0;
        *(float4*)(cp + tx * 4) = make_float4(acc[i][0], acc[i][1], acc[i][2], acc[i][3]);
        *(float4*)(cp + 64 + tx * 4) = make_float4(acc[i][4], acc[i][5], acc[i][6], acc[i][7]);
    }
}
__device__ __forceinline__ float bf2f(bf16_t v) { return __builtin_bit_cast(float, (unsigned)v << 16); }
__device__ __forceinline__ size_t qd_ix(int pos, int dim) { return (size_t)(pos >> 5) * 2048 + (dim >> 4) * 512 + ((dim >> 3) & 1) * 256 + (pos & 31) * 8 + (dim & 7); }
__device__ __forceinline__ size_t vtd_ix(int pos, int dim) { const int kk = pos & 31, k16 = kk & 15; return (size_t)(pos >> 5) * 2048 + ((dim >> 5) * 2 + (kk >> 4)) * 512 + ((k16 >> 2) & 1) * 256 + (dim & 31) * 8 + (k16 >> 3) * 4 + (k16 & 3); }
__device__ __forceinline__ size_t qn_ix(int tok, int dim) { return (size_t)(tok >> 3) * 512 + (dim >> 5) * 256 + ((dim >> 3) & 3) * 64 + (tok & 7) * 8 + (dim & 7); }
__device__ __forceinline__ size_t vtn_ix(int tok, int dim) { return (size_t)(tok >> 3) * 512 + dim * 8 + (tok & 7); }
__global__ void __launch_bounds__(256) k_dil_attn(const bf16_t* Qd, const bf16_t* Kd, const bf16_t* Vtd, float* ya, int b) {
    const int w = blockIdx.x * 4 + (threadIdx.x >> 6), lane = threadIdx.x & 63, tok = w >> 2, h = w & 3, wi = threadIdx.x >> 6;
    __shared__ float qs[4][64]; __shared__ float ps[4][3 * 129 + 3];
    float sc[3][3]; float mx = -INFINITY;
#pragma unroll
    for (int g = 0; g < 3; ++g) {
        const int d = (g == 0) ? 1 : (g == 1 ? 4 : 16), L = S / d, head = g * 4 + h;
        const size_t hb = (size_t)(b * DILH + head) * S;
        qs[wi][lane] = bf2f(Qd[hb * 64 + qd_ix((tok % d) * L + tok / d, lane)]);
        __syncthreads();
#pragma unroll
        for (int rd = 0; rd < 3; ++rd) {
            const int j = rd * 64 + lane; float s = -INFINITY;
            if (j <= 128) { const int kt = tok + (j - 64) * d;
                if (kt >= 0 && kt < S) { const int kpos = (kt % d) * L + kt / d; float a = 0.f; for (int c = 0; c < 64; ++c) a += qs[wi][c] * bf2f(Kd[hb * 64 + qd_ix(kpos, c)]); s = a; } }
            sc[g][rd] = s; mx = fmaxf(mx, s);
        }
        __syncthreads();
    }
    mx = wave_max(mx);
    float den = 0.f;
#pragma unroll
    for (int g = 0; g < 3; ++g)
#pragma unroll
        for (int rd = 0; rd < 3; ++rd) { const int j = rd * 64 + lane; const float p = (sc[g][rd] == -INFINITY) ? 0.f : exp2f(sc[g][rd] - mx); den += p; if (j <= 128) ps[wi][g * 129 + j] = p; }
    den = wave_sum(den);
    __syncthreads();
    float o = 0.f;
    for (int g = 0; g < 3; ++g) {
        const int d = (g == 0) ? 1 : (g == 1 ? 4 : 16), L = S / d, head = g * 4 + h;
        const bf16_t* vp = Vtd + (size_t)(b * DILH + head) * 64 * S;
        for (int j = 0; j <= 128; ++j) { const int kt = tok + (j - 64) * d; if (kt >= 0 && kt < S) { const int pp = (kt % d) * L + kt / d; o += ps[wi][g * 129 + j] * bf2f(vp[vtd_ix(pp, lane)]); } }
    }
    ya[(long)tok * 256 + h * 64 + lane] = o / den;
}
__global__ void __launch_bounds__(256) k_na_attn(const bf16_t* Qn, const bf16_t* Kn, const bf16_t* Vtn, const float* rpb, float* yb, int b) {
    const int w = blockIdx.x * 4 + (threadIdx.x >> 6), lane = threadIdx.x & 63, tok = w >> 3, h = w & 7, wi = threadIdx.x >> 6;
    __shared__ float qs[4][64]; __shared__ float ps[4][128];
    const int r = tok / GW, c = tok % GW, rs = min(max(r - 4, 0), 56), ws = min(max(c - 8, 0), 48);
    const size_t hb = (size_t)(b * NAH + h) * S;
    qs[wi][lane] = bf2f(Qn[hb * 64 + qn_ix(tok, lane)]);
    __syncthreads();
    float sc[2]; float mx = -INFINITY;
#pragma unroll
    for (int rd = 0; rd < 2; ++rd) {
        const int j = rd * 64 + lane, kr = rs + (j >> 4), kc = ws + (j & 15);
        float a = 0.f;
        for (int cc = 0; cc < 64; ++cc) a += qs[wi][cc] * bf2f(Kn[hb * 64 + qn_ix(kr * GW + kc, cc)]);
        sc[rd] = a + rpb[(h * 15 + (kr - r + 7)) * 31 + (kc - c + 15)] * LOG2E; mx = fmaxf(mx, sc[rd]);
    }
    mx = wave_max(mx);
    float den = 0.f;
#pragma unroll
    for (int rd = 0; rd < 2; ++rd) { const float p = exp2f(sc[rd] - mx); den += p; ps[wi][rd * 64 + lane] = p; }
    den = wave_sum(den);
    __syncthreads();
    float o = 0.f;
    const bf16_t* vp = Vtn + (size_t)(b * NAH + h) * 64 * S;
    for (int j = 0; j < 128; ++j) { const int pp = (rs + (j >> 4)) * GW + ws + (j & 15); o += ps[wi][j] * bf2f(vp[vtn_ix(pp, lane)]); }
    yb[(long)tok * 512 + h * 64 + lane] = o / den;
}
__global__ void k_bf2f(const bf16_t* a, float* o, long n) { const long i = (long)blockIdx.x * blockDim.x + threadIdx.x; if (i < n) o[i] = bf2f(a[i]); }
__global__ void k_merge(const bf16_t* gates, const float* yap, const float* ybp, float* merged) {
    const long i = (long)blockIdx.x * blockDim.x + threadIdx.x; if (i >= (long)S * D) return;
    const int tok = (int)(i / D), c = (int)(i % D);
    const float sn = bf2f(gates[(long)tok * 2048 + 1024 + c]); merged[i] = (yap[i] * bf2f(gates[(long)tok * 2048 + c]) + ybp[i]) * sn;
}
__global__ void k_add(const float* a, const float* b, float* o, long n) { const long i = (long)blockIdx.x * blockDim.x + threadIdx.x; if (i < n) o[i] = a[i] + b[i]; }
__global__ void __launch_bounds__(256) k_norm_router(const float* x1, const float* g, const float* wr, float* h2, float* aff) {
    const int row = blockIdx.x * 4 + (threadIdx.x >> 6), lane = threadIdx.x & 63;
    const float* xp = x1 + (long)row * D; float v[16]; float ss = 0.f;
#pragma unroll
    for (int i = 0; i < 16; ++i) { v[i] = xp[lane + 64 * i]; ss += v[i] * v[i]; }
    ss = wave_sum(ss);
    const float rs = rsqrtf(ss * (1.0f / D) + EPS);
    float lg[16];
#pragma unroll
    for (int e = 0; e < 16; ++e) lg[e] = 0.f;
#pragma unroll
    for (int i = 0; i < 16; ++i) { const float hv = v[i] * rs * g[lane + 64 * i]; h2[(long)row * D + lane + 64 * i] = hv; const float* wp = wr + (long)(lane + 64 * i) * NE;
#pragma unroll
        for (int e = 0; e < 16; ++e) lg[e] += hv * wp[e]; }
    float mx = -INFINITY;
#pragma unroll
    for (int e = 0; e < 16; ++e) { lg[e] = wave_sum(lg[e]); mx = fmaxf(mx, lg[e]); }
    float den = 0.f;
#pragma unroll
    for (int e = 0; e < 16; ++e) { lg[e] = __expf(lg[e] - mx); den += lg[e]; }
    if (lane < 16) { float mine = 0.f;
#pragma unroll
        for (int e = 0; e < 16; ++e) mine = (lane == e) ? lg[e] : mine;
        aff[(long)lane * S + row] = mine / den; }
}
__global__ void __launch_bounds__(1024) k_topk(const float* aff, int* idx, float* gate) {
    __shared__ float a[S]; const int e = blockIdx.x;
    for (int i = threadIdx.x; i < S; i += 1024) a[i] = aff[(long)e * S + i];
    __syncthreads();
    for (int i = threadIdx.x; i < S; i += 1024) { const float v = a[i]; int rank = 0;
        for (int j = 0; j < S; ++j) { const float u = a[j]; rank += (u > v || (u == v && j < i)) ? 1 : 0; }
        if (rank < CAP) { idx[e * CAP + rank] = i; gate[e * CAP + rank] = v; } }
}
__global__ void k_swiglu(const float* a, const float* u, float* o, long n) { const long i = (long)blockIdx.x * blockDim.x + threadIdx.x; if (i < n) { const float x = a[i]; o[i] = x / (1.f + __expf(-x)) * u[i]; } }
__global__ void k_scatter(const float* y, const int* idx, const float* gate, int es, float* out) {
    const long i = (long)blockIdx.x * blockDim.x + threadIdx.x; if (i >= (long)NE * CAP * D) return;
    const int row = (int)(i / D), c = (int)(i % D), e = row / CAP, sl = row % CAP;
    atomicAdd(out + (long)idx[e * es + sl] * D + c, gate[e * es + sl] * y[i]);
}
static void gemm(hipStream_t st, const float* A, const float* Bm, float* C, int M_, int N, int K, int lda, int ldb, int ldc,
                 int nz = 1, long sA = 0, long sB = 0, long sC = 0, const int* gather = nullptr, int sG = 0) {
    GemmArgs g{}; g.A = A; g.Bm = Bm; g.C = C; g.gather = gather; g.M = M_; g.N = N; g.K = K; g.lda = lda; g.ldb = ldb; g.ldc = ldc; g.sA = sA; g.sB = sB; g.sC = sC; g.sG = sG;
    hipLaunchKernelGGL(k_gemm, dim3(N / 128, M_ / 128, nz), dim3(256), 0, st, g);
}
struct Bump { size_t lo[3], hi[3]; int n, cur; size_t at;
    float* take(size_t nfloats) { size_t bytes = ((nfloats * 4) + 255) & ~(size_t)255;
        while (cur < n && at + bytes > hi[cur]) { ++cur; if (cur < n) at = lo[cur]; }
        if (cur >= n) { fprintf(stderr, "tail scratch exhausted\n"); return nullptr; }
        float* p = (float*)at; at += bytes; return p; } };
}
#endif

extern "C" void kernel_launch(void* const* d_in, const int* in_sizes, int n_in, void* d_out, int out_size, void* d_ws, size_t ws_size, hipStream_t stream) {
    static int grid = 0;
    if (grid == 0) {
        if (n_in != 16 || out_size != M * D || ws_size < WS_END) { fprintf(stderr, "kernel_launch: unexpected problem (n_in %d, out %d, ws %zu)\n", n_in, out_size, ws_size); grid = -1; return; }
        int dev = 0, cus = 0, per_cu = 0;
        if (hipGetDevice(&dev) != hipSuccess || hipDeviceGetAttribute(&cus, hipDeviceAttributeMultiprocessorCount, dev) != hipSuccess) { grid = -1; return; }
        if (hipFuncSetAttribute((const void*)mk_fwd, hipFuncAttributeMaxDynamicSharedMemorySize, LDS_BYTES) != hipSuccess) { fprintf(stderr, "kernel_launch: hipFuncSetAttribute failed\n"); grid = -1; return; }
        if (hipOccupancyMaxActiveBlocksPerMultiprocessor(&per_cu, (const void*)mk_fwd, 512, LDS_BYTES) != hipSuccess || per_cu < 1)
            fprintf(stderr, "kernel_launch: occupancy query reports %d workgroups per CU\n", per_cu);
        (void)hipGetLastError();
        grid = cus;
    }
    if (grid < 0) return;
    (void)hipMemsetAsync((char*)d_ws + WS_CTL, 0, CTL_BYTES, stream);
    Args a{};
    for (int i = 0; i < 16; ++i) a.in[i] = (const float*)d_in[i];
    a.out = (float*)d_out; a.ws = (unsigned char*)d_ws;
#if MK_PER_PHASE
    for (int p = 0; p < MK_HYB; ++p) { a.ph_lo = p; a.ph_hi = p + 1; hipLaunchKernelGGL(mk_fwd, dim3(grid), dim3(512), LDS_BYTES, stream, a);
#ifdef MK_REPEAT_PHASE
        if (p == MK_REPEAT_PHASE) {
#ifdef MK_REPEAT_FLAGS
            a.flags = MK_REPEAT_FLAGS;
#endif
            hipLaunchKernelGGL(mk_fwd, dim3(grid), dim3(512), LDS_BYTES, stream, a); a.flags = 0; }
#endif
    }
#else
    a.ph_lo = 0; a.ph_hi = MK_HYB; hipLaunchKernelGGL(mk_fwd, dim3(grid), dim3(512), LDS_BYTES, stream, a);
#endif
#if MK_HYB < 10
    using namespace tail;
    unsigned char* ws = (unsigned char*)d_ws; float* out = (float*)d_out;
    Bump bp{};
#if MK_HYB <= 2
    bp.n = 3; bp.lo[0] = (size_t)(ws + 17 * MiB); bp.hi[0] = (size_t)(ws + 113 * MiB); bp.lo[1] = (size_t)(ws + 118 * MiB); bp.hi[1] = (size_t)(ws + 182 * MiB); bp.lo[2] = (size_t)(ws + 422 * MiB); bp.hi[2] = (size_t)(ws + 512 * MiB);
#elif MK_HYB <= 4
    bp.n = 3; bp.lo[0] = (size_t)(ws + 17 * MiB); bp.hi[0] = (size_t)(ws + 113 * MiB); bp.lo[1] = (size_t)(ws + 182 * MiB); bp.hi[1] = (size_t)(ws + 422 * MiB); bp.lo[2] = (size_t)(ws + 470 * MiB); bp.hi[2] = (size_t)(ws + 512 * MiB);
#elif MK_HYB <= 6
    bp.n = 1; bp.lo[0] = (size_t)(ws + 182 * MiB); bp.hi[0] = (size_t)(ws + 512 * MiB);
#else
    bp.n = 1; bp.lo[0] = (size_t)(ws + 182 * MiB); bp.hi[0] = (size_t)(ws + 512 * MiB);
#endif
    bp.cur = 0; bp.at = bp.lo[0];
    float* ya = bp.take((size_t)S * 256); float* yb = bp.take((size_t)S * 512);
    float* yap = bp.take((size_t)S * D); float* ybp = bp.take((size_t)S * D); float* merged = bp.take((size_t)S * D); float* tmp = bp.take((size_t)S * D);
    float* h2 = bp.take((size_t)S * D); float* aff = bp.take((size_t)NE * S); int* idx = (int*)bp.take((size_t)NE * CAP); float* gate = bp.take((size_t)NE * CAP);
    float* ea = bp.take((size_t)NE * CAP * FF); float* eu = bp.take((size_t)NE * CAP * FF);
    const float* x = a.in[0];
    for (int b = 0; b < NB; ++b) {
        const float* xb = x + (size_t)b * S * D; float* ob = out + (size_t)b * S * D;
        const bf16_t* gates_b = (const bf16_t*)d_out + (size_t)b * S * 2048;
#if MK_HYB <= 2
        hipLaunchKernelGGL(k_dil_attn, dim3(S), dim3(256), 0, stream, (const bf16_t*)(ws + WS_QD), (const bf16_t*)(ws + WS_KD), (const bf16_t*)(ws + WS_VTD), ya, b);
        hipLaunchKernelGGL(k_na_attn, dim3(S * 2), dim3(256), 0, stream, (const bf16_t*)(ws + WS_QN), (const bf16_t*)(ws + WS_KN), (const bf16_t*)(ws + WS_VTN), a.in[7], yb, b);
#elif MK_HYB <= 3
        hipLaunchKernelGGL(k_bf2f, dim3(S * 256 / 256), dim3(256), 0, stream, (const bf16_t*)(ws + WS_YA) + (size_t)b * S * 256, ya, (long)S * 256);
        hipLaunchKernelGGL(k_bf2f, dim3(S * 512 / 256), dim3(256), 0, stream, (const bf16_t*)(ws + WS_YB) + (size_t)b * S * 512, yb, (long)S * 512);
#endif
#if MK_HYB <= 3
        gemm(stream, ya, a.in[8], yap, S, D, 256, 256, D, D);
        gemm(stream, yb, a.in[9], ybp, S, D, 512, 512, D, D);
        hipLaunchKernelGGL(k_merge, dim3((S * D) / 256), dim3(256), 0, stream, gates_b, yap, ybp, merged);
        gemm(stream, merged, a.in[10], tmp, S, D, D, D, D, D);
        hipLaunchKernelGGL(k_add, dim3((S * D) / 256), dim3(256), 0, stream, xb, tmp, ob, (long)S * D);
#elif MK_HYB == 4
        hipLaunchKernelGGL(k_bf2f, dim3(S * D / 256), dim3(256), 0, stream, (const bf16_t*)(ws + WS_HB) + (size_t)b * S * D, merged, (long)S * D);
        gemm(stream, merged, a.in[10], tmp, S, D, D, D, D, D);
        hipLaunchKernelGGL(k_add, dim3((S * D) / 256), dim3(256), 0, stream, xb, tmp, ob, (long)S * D);
#endif
        const int* idx_b = idx; const float* gate_b = gate; int es = CAP;
#if MK_HYB <= 5
        hipLaunchKernelGGL(k_norm_router, dim3(S / 4), dim3(256), 0, stream, ob, a.in[11], a.in[12], h2, aff);
        hipLaunchKernelGGL(k_topk, dim3(NE), dim3(1024), 0, stream, aff, idx, gate);
#else
        hipLaunchKernelGGL(k_bf2f, dim3(S * D / 256), dim3(256), 0, stream, (const bf16_t*)(ws + WS_HB) + (size_t)b * S * D, h2, (long)S * D);
        idx_b = (const int*)(ws + WS_IDX) + (size_t)b * CAP; gate_b = (const float*)(ws + WS_GLIST) + (size_t)b * CAP; es = NB * CAP;
#endif
        gemm(stream, h2, a.in[13], ea, CAP, FF, D, D, FF, FF, NE, 0, (long)D * FF, (long)CAP * FF, idx_b, es);
        gemm(stream, h2, a.in[14], eu, CAP, FF, D, D, FF, FF, NE, 0, (long)D * FF, (long)CAP * FF, idx_b, es);
        hipLaunchKernelGGL(k_swiglu, dim3((NE * CAP * FF) / 256), dim3(256), 0, stream, ea, eu, ea, (long)NE * CAP * FF);
        gemm(stream, ea, a.in[15], eu, CAP, D, FF, FF, D, D, NE, (long)CAP * FF, (long)FF * D, (long)CAP * D);
        hipLaunchKernelGGL(k_scatter, dim3((NE * CAP * D) / 256), dim3(256), 0, stream, eu, idx_b, gate_b, es, ob);
    }
#endif
}
```

```cpp
#define MK_HYB 10
#define MK_PER_PHASE 0
#include <hip/hip_runtime.h>
#include <stdint.h>
#include <stdio.h>

#define LAS __attribute__((address_space(3)))
#define GAS __attribute__((address_space(1)))
typedef unsigned short bf16_t;
typedef short bf16x8 __attribute__((ext_vector_type(8)));
typedef short s16x4 __attribute__((ext_vector_type(4)));
typedef float f32x2 __attribute__((ext_vector_type(2)));
typedef float f32x4 __attribute__((ext_vector_type(4)));
typedef float f32x16 __attribute__((ext_vector_type(16)));
typedef unsigned u32x2 __attribute__((ext_vector_type(2)));
typedef unsigned u32x4 __attribute__((ext_vector_type(4)));
typedef __bf16 bf16x2_t __attribute__((ext_vector_type(2)));

constexpr int D = 1024, NB = 8, S = 4096, HD = 64, M = NB * S;
constexpr int DILH = 12, NAH = 8, GW = 64, NE = 16, CAP = 512, FF = 1024, INC = 5888;
constexpr float EPS = 1e-6f;
constexpr float LOG2E = 1.4426950408889634f;

constexpr size_t MiB = 1u << 20;
constexpr size_t WS_CTL = 0, CTL_BYTES = 1 * MiB;
constexpr size_t WS_ROPE = 1 * MiB;
constexpr size_t WS_WIN = 2 * MiB;
constexpr size_t WS_PA = WS_WIN + (size_t)INC * D * 2;
constexpr size_t WS_PB = 14 * MiB;
constexpr size_t WS_WO = 15 * MiB;
constexpr size_t WS_WGU = 17 * MiB;
constexpr size_t WS_WD = 81 * MiB;
constexpr size_t WS_AFF = 113 * MiB;
constexpr size_t WS_TOKSLOT = 115 * MiB;
constexpr size_t WS_IDX = 117 * MiB;
constexpr size_t WS_GLIST = WS_IDX + 256 * 1024;
constexpr size_t WS_HB = 118 * MiB;
constexpr size_t WS_QD = 182 * MiB, WS_KD = 230 * MiB, WS_VTD = 278 * MiB;
constexpr size_t WS_QN = 326 * MiB, WS_KN = 358 * MiB, WS_VTN = 390 * MiB;
constexpr size_t WS_H = 182 * MiB;
constexpr size_t WS_Y = 310 * MiB;
constexpr size_t WS_YA = 422 * MiB;
constexpr size_t WS_YB = 438 * MiB;
constexpr size_t WS_DLT = 438 * MiB;
constexpr size_t WS_END = 502 * MiB;
constexpr int CW_TMO = 0, CW_BAR = 4096, CW_Q6 = 64;

constexpr int RING_BYTES = 131072;
constexpr int LDS_L_OFF = RING_BYTES;
constexpr int LDS_IDX_OFF = RING_BYTES + 2048;
constexpr int LDS_MISC_OFF = RING_BYTES + 4096;
constexpr int LDS_BYTES = 147456;

__device__ __forceinline__ unsigned pk2(float lo, float hi) { f32x2 v = {lo, hi}; return __builtin_bit_cast(unsigned, __builtin_convertvector(v, bf16x2_t)); }
__device__ __forceinline__ float bflo(unsigned w) { return __builtin_bit_cast(float, w << 16); }
__device__ __forceinline__ float bfhi(unsigned w) { return __builtin_bit_cast(float, w & 0xffff0000u); }
__device__ __forceinline__ float shx(float v, int mask, int lane) { return __builtin_bit_cast(float, __builtin_amdgcn_ds_bpermute((lane ^ mask) << 2, __builtin_bit_cast(int, v))); }
__device__ __forceinline__ int shxi(int v, int mask, int lane) { return __builtin_amdgcn_ds_bpermute((lane ^ mask) << 2, v); }
__device__ __forceinline__ float wave_sum(float v, int lane) {
#pragma unroll
    for (int o = 1; o < 64; o <<= 1) v += shx(v, o, lane);
    return v;
}
__device__ __forceinline__ float wave_max(float v, int lane) {
#pragma unroll
    for (int o = 1; o < 64; o <<= 1) v = fmaxf(v, shx(v, o, lane));
    return v;
}
__device__ __forceinline__ float sigmoidf_fast(float x) { return __builtin_amdgcn_rcpf(1.0f + __builtin_amdgcn_exp2f(-x * LOG2E)); }
__device__ __forceinline__ int fresh_lane() { int l; asm volatile("v_mbcnt_lo_u32_b32 %0, -1, 0\n\tv_mbcnt_hi_u32_b32 %0, -1, %0" : "=v"(l)); return l; }
#ifndef MK_WT
#define MK_WT 0
#endif
struct WtBuf { __amdgpu_buffer_rsrc_t r; const char* base; };
__device__ __forceinline__ WtBuf wt_make(const void* base, unsigned bytes) { WtBuf b; b.r = __builtin_amdgcn_make_buffer_rsrc((void*)base, 0, bytes, 0x00020000); b.base = (const char*)base; return b; }
__device__ __forceinline__ void wt_store16(const WtBuf& b, const void* p, u32x4 w) {
#if MK_WT
    __builtin_amdgcn_raw_buffer_store_b128(w, b.r, (unsigned)((const char*)p - b.base), 0, 16);
#else
    *(u32x4*)p = w;
#endif
}
__device__ __forceinline__ void wt_store8(const WtBuf& b, const void* p, u32x2 w) {
#if MK_WT
    __builtin_amdgcn_raw_buffer_store_b64(w, b.r, (unsigned)((const char*)p - b.base), 0, 16);
#else
    *(u32x2*)p = w;
#endif
}
#define LDS_WAIT() asm volatile("s_waitcnt lgkmcnt(0)" ::: "memory")
#define VM_WAIT() asm volatile("s_waitcnt vmcnt(0)" ::: "memory")

#define XB_TMO      128
#define XB_XCNT(j)  (256  + 64 * (j))
#define XB_XSUB(j)  (1280 + 64 * (j))
#define XB_XGEN(j)  (2304 + 64 * (j))
#define XB_TOP      3328
#define XB_TOPGEN   3392
#define XCD_BAR_WORDS 3456
#define XB_SPIN_CAP (1u << 18)
__device__ __forceinline__ unsigned xb_ld(unsigned* p)              { return __hip_atomic_load(p, __ATOMIC_RELAXED, __HIP_MEMORY_SCOPE_AGENT); }
__device__ __forceinline__ unsigned xb_add(unsigned* p, unsigned v) { return __hip_atomic_fetch_add(p, v, __ATOMIC_RELAXED, __HIP_MEMORY_SCOPE_AGENT); }
__device__ __forceinline__ unsigned xb_xcc_id() { return (unsigned)__builtin_amdgcn_s_getreg((3 << 11) | 20) & 0xFu; }
#define XB_SPIN(cond, bar) do { unsigned _sp = 0; while (cond) { __builtin_amdgcn_s_sleep(1); \
    if ((++_sp & 255u) == 0u) { if (xb_ld(&(bar)[XB_TMO])) break; if (_sp > XB_SPIN_CAP) { atomicAdd(&(bar)[XB_TMO], 1u); break; } } } } while (0)
struct XcdBarrier { unsigned* bar; unsigned x; volatile LAS unsigned* st; };
__device__ __forceinline__ XcdBarrier xcd_barrier_post(unsigned* bar, volatile LAS unsigned* st, const bool first) {
    XcdBarrier b; b.bar = bar; b.x = xb_xcc_id(); b.st = st;
    if (first) (void)xb_add(&bar[XB_XCNT(b.x)], 1u);
    return b;
}
__device__ __forceinline__ void xcd_barrier_complete(unsigned* bar, unsigned x, unsigned& nloc, unsigned& nx) {
    const unsigned G = gridDim.x * gridDim.y * gridDim.z;
    unsigned sum, cnt, mine, sp = 0u;
    for (;;) {
        sum = 0u; cnt = 0u; mine = 0u;
#pragma unroll
        for (unsigned j = 0; j < 16; ++j) { const unsigned c = xb_ld(&bar[XB_XCNT(j)]); sum += c; cnt += (c > 0u) ? 1u : 0u; mine = (j == x) ? c : mine; }
        if (sum == G) break;
        __builtin_amdgcn_s_sleep(1);
        if ((++sp & 255u) == 0u) { if (xb_ld(&bar[XB_TMO])) break; if (sp > XB_SPIN_CAP) { atomicAdd(&bar[XB_TMO], 1u); break; } }
    }
    nloc = mine > 0u ? mine : 1u; nx = cnt > 0u ? cnt : 1u;
}
__device__ __forceinline__ void xcd_barrier(const XcdBarrier& b, const bool first) {
    asm volatile("s_waitcnt vmcnt(0)" ::: "memory");
    __syncthreads();
    if (first) {
        unsigned* bar = b.bar;
        __builtin_amdgcn_s_waitcnt(0);
        unsigned nloc = b.st[0], nx = b.st[1];
        if (nloc == 0u) { xcd_barrier_complete(bar, b.x, nloc, nx); b.st[0] = nloc; b.st[1] = nx; }
        const unsigned old = xb_add(&bar[XB_XSUB(b.x)], 1u);
        const unsigned gen = old / nloc;
        if (old + 1u == (gen + 1u) * nloc) {
            __builtin_amdgcn_fence(__ATOMIC_RELEASE, "agent");
            asm volatile("s_waitcnt vmcnt(0)" ::: "memory");
            const unsigned og = xb_add(&bar[XB_TOP], 1u);
            const unsigned tg = og / nx;
            if (og + 1u == (tg + 1u) * nx) xb_add(&bar[XB_TOPGEN], 1u);
            else XB_SPIN(xb_ld(&bar[XB_TOPGEN]) == tg, bar);
            __builtin_amdgcn_fence(__ATOMIC_ACQUIRE, "agent");
            xb_add(&bar[XB_XGEN(b.x)], 1u);
            asm volatile("s_waitcnt vmcnt(0)" ::: "memory");
        } else {
            XB_SPIN(xb_ld(&bar[XB_XGEN(b.x)]) == gen, bar);
            __builtin_amdgcn_fence(__ATOMIC_ACQUIRE, "agent");
            asm volatile("s_waitcnt vmcnt(0)" ::: "memory");
        }
    }
    __syncthreads();
}

namespace g8 {
constexpr int BM = 256, BK = 64, HALF = 128, HTB = HALF * BK * 2, STAGE_BYTES = 8 * HTB;
__host__ __device__ __forceinline__ int lds_byte(int r, int c) { const int st = (r >> 4) * 2 + (c >> 5), rr = r & 15, cc = c & 31, ob = rr * 64 + cc * 2; return st * 1024 + (ob ^ (((ob >> 9) & 1) << 5)); }
__host__ __device__ __forceinline__ void stage_rc(int b, int& R, int& C) { const int st = b / 1024, sb = b % 1024, swz = sb ^ (((sb >> 9) & 1) << 5); R = (st >> 1) * 16 + swz / 64; C = (st & 1) * 32 + (swz % 64) / 2; }
__host__ __device__ __forceinline__ int perm32(int rho) { const int n = rho >> 4, i = rho & 15; return 8 * (i >> 2) + 4 * n + (i & 3); }

__device__ __forceinline__ bool tile_order(long L, int nM, int nN, int& pm, int& pn) {
    const int nwg = nM * nN; if (L >= nwg) return false;
    int wgid = (int)L; { const int q = nwg / 8, r = nwg % 8, xcd = wgid % 8, off = wgid / 8; wgid = (xcd < r ? xcd * (q + 1) : r * (q + 1) + (xcd - r) * q) + off; }
    const int nig = 8 * nN, gid = wgid / nig, fm = gid * 8, gsz = (nM - fm) < 8 ? (nM - fm) : 8;
    pm = fm + ((wgid % nig) % gsz); pn = (wgid % nig) / gsz; return true;
}

struct Unit {
    const char* A; const char* B;
    unsigned sA, sB;
    char* p;
    int nt, ty;
    int e0, e1, e2, e3;
};

#ifndef G8_ALIGN_EPI
#define G8_ALIGN_EPI true
#endif
template <class Epi, class Sched, bool GATHER>
__device__ __forceinline__ void gemm_phase(LAS unsigned char* lds, const Sched& S, const Epi& E, const int wid) {
    const int lane = fresh_lane();
    const int tid = wid * 64 + lane, wr = wid >> 2, wc = wid & 3, fr = lane & 15, fq = lane >> 4;
    unsigned rA[2], rB[2], c2[2];
#pragma unroll
    for (int i = 0; i < 2; ++i) { int R, C; stage_rc(tid * 16 + i * 8192, R, C); rA[i] = (unsigned)R; rB[i] = (unsigned)(Epi::PERM ? ((R & ~31) + perm32(R & 31)) : R); c2[i] = (unsigned)(C * 2);
        if constexpr (Epi::COL64) rB[i] = (unsigned)(64 * (R >> 5) + perm32(R & 31)); }
    const unsigned ldsw = (unsigned)wid * 1024u;
    const int aoff = lds_byte(wr * 64 + fr, fq * 8), boff = lds_byte(wc * 32 + fr, fq * 8);
    LAS int* idxbuf = (LAS int*)(lds + LDS_IDX_OFF);
#define G8_SA(b, h) (((b) * 2 + (h)) * HTB)
#define G8_SB(b, h) ((4 + (b) * 2 + (h)) * HTB)
#define G8_STAGE(bufoff, gbase, stride, rr) do { _Pragma("unroll") for (int _i = 0; _i < 2; ++_i) \
        __builtin_amdgcn_global_load_lds((const unsigned*)((const char*)(gbase) + ((rr)[_i] * (stride) + c2[_i])), (LAS unsigned*)(lds + (bufoff) + ldsw + _i * 8192), 16, 0, 0); } while (0)
#define G8_STAGE_G(bufoff, gbase, offs) do { _Pragma("unroll") for (int _i = 0; _i < 2; ++_i) \
        __builtin_amdgcn_global_load_lds((const unsigned*)((const char*)(gbase) + (offs)[_i]), (LAS unsigned*)(lds + (bufoff) + ldsw + _i * 8192), 16, 0, 0); } while (0)
#define G8_LDA(dst, b, h) do { _Pragma("unroll") for (int m = 0; m < 4; ++m) _Pragma("unroll") for (int k = 0; k < 2; ++k) dst[m][k] = *(const LAS bf16x8*)(lds + G8_SA(b, h) + aoff + m * 2048 + k * 1024); } while (0)
#define G8_LDB(dst, b, h) do { _Pragma("unroll") for (int n = 0; n < 2; ++n) _Pragma("unroll") for (int k = 0; k < 2; ++k) dst[n][k] = *(const LAS bf16x8*)(lds + G8_SB(b, h) + boff + n * 2048 + k * 1024); } while (0)
#define G8_MMA(ai, bj, At, Bt) do { __builtin_amdgcn_s_setprio(1); _Pragma("unroll") for (int m = 0; m < 4; ++m) _Pragma("unroll") for (int n = 0; n < 2; ++n) _Pragma("unroll") for (int k = 0; k < 2; ++k) \
        acc[ai][bj][m][n] = __builtin_amdgcn_mfma_f32_16x16x32_bf16(Bt[n][k], At[m][k], acc[ai][bj][m][n], 0, 0, 0); __builtin_amdgcn_s_setprio(0); } while (0)
#define G8_WAIT_V(n) asm volatile("s_waitcnt vmcnt(" #n ")" ::: "memory")
#define G8_WAIT_L(n) asm volatile("s_waitcnt lgkmcnt(" #n ")" ::: "memory")
#define G8_BAR __builtin_amdgcn_s_barrier()
#define G8_SCHED __builtin_amdgcn_sched_barrier(0)
#define G8_STAGE_D(bufoff, gbase, sh, rr, h) do { _Pragma("unroll") for (int _i = 0; _i < 2; ++_i) { const unsigned _rd = ((rr)[_i] + 128u * (h)) << (sh); \
        __builtin_amdgcn_global_load_lds((const unsigned*)((const char*)(gbase) + ((_rd >> 8) * 524288u + (_rd & 255u) * 128u + c2[_i])), (LAS unsigned*)(lds + (bufoff) + ldsw + _i * 8192), 16, 0, 0); } } while (0)
#define G8_STA(bufoff, u, go, h, kt) do { if constexpr (GATHER) { G8_STAGE_G(bufoff, (u).A + (kt), (go)[h]); } else if constexpr (Sched::DIL) { G8_STAGE_D(bufoff, (u).A + (kt), (u).sA, rA, h); } else { G8_STAGE(bufoff, (u).A + (size_t)(h) * HALF * (u).sA + (kt), (u).sA, rA); } } while (0)
#define G8_STB(bufoff, u, h, kt) do { if constexpr (Sched::DIL) { G8_STAGE_D(bufoff, (u).B + (kt), (u).sB, rB, h); } else { G8_STAGE(bufoff, (u).B + (size_t)(h) * (Epi::COL64 ? 32 : HALF) * (u).sB + (kt), (u).sB, rB); } } while (0)
    Unit cur, nxt; int ui = 0;
    if (!S.next(0, cur)) return;
    f32x4 acc[2][2][4][2];
#pragma unroll
    for (int a = 0; a < 2; ++a)
#pragma unroll
        for (int b = 0; b < 2; ++b)
#pragma unroll
            for (int m = 0; m < 4; ++m)
#pragma unroll
                for (int n = 0; n < 2; ++n) acc[a][b][m][n] = (f32x4){0.f, 0.f, 0.f, 0.f};
    bf16x8 At[4][2], B0[2][2], B1[2][2];
    unsigned gcur[2][2], gnxt[2][2];
    if constexpr (GATHER) {
        if (wid == 0) __builtin_amdgcn_global_load_lds((const unsigned*)((const int*)cur.p + lane * 4), (LAS unsigned*)(idxbuf), 16, 0, 0);
        G8_WAIT_V(0); G8_BAR;
#pragma unroll
        for (int h = 0; h < 2; ++h)
#pragma unroll
            for (int i = 0; i < 2; ++i) { const unsigned ix = (unsigned)idxbuf[h * HALF + (int)rA[i]]; gcur[h][i] = (ix >> 8) * 524288u + (ix & 255u) * 128u + c2[i]; }
        G8_WAIT_L(0);
    }
#define G8_KOFF(u, t) ((size_t)((t) * (int)Sched::KA))
    { const size_t k0 = G8_KOFF(cur, 0); G8_STB(G8_SB(0, 0), cur, 0, k0); G8_STB(G8_SB(0, 1), cur, 1, k0); G8_STA(G8_SA(0, 0), cur, gcur, 0, k0); G8_STA(G8_SA(0, 1), cur, gcur, 1, k0); }
    if (wr == 1) G8_BAR;
    G8_WAIT_V(2); G8_BAR;
    { const size_t k1 = G8_KOFF(cur, 1); G8_STB(G8_SB(1, 0), cur, 0, k1); G8_STA(G8_SA(1, 0), cur, gcur, 0, k1); G8_STB(G8_SB(1, 1), cur, 1, k1); }
    G8_WAIT_V(6); G8_BAR;
    for (;;) {
        const bool has_next = S.next(ui + 1, nxt);
        if (!has_next) nxt = cur;
        if constexpr (GATHER) {
            if (has_next && wid == 0) __builtin_amdgcn_global_load_lds((const unsigned*)((const int*)nxt.p + lane * 4), (LAS unsigned*)(idxbuf + ((ui + 1) & 1) * 256), 16, 0, 0);
        }
        const int nt = cur.nt;
        for (int t = 0; t < nt; t += 2) {
            const bool last = (t == nt - 2);
            const size_t k1 = G8_KOFF(cur, t + 1);
            const size_t k2 = last ? G8_KOFF(nxt, 0) : G8_KOFF(cur, t + 2), k3 = last ? G8_KOFF(nxt, 1) : G8_KOFF(cur, t + 3);
            if constexpr (GATHER) {
                if (last) {
                    if (has_next) {
#pragma unroll
                        for (int h = 0; h < 2; ++h)
#pragma unroll
                            for (int i = 0; i < 2; ++i) { const unsigned ix = (unsigned)idxbuf[((ui + 1) & 1) * 256 + h * HALF + (int)rA[i]]; gnxt[h][i] = (ix >> 8) * 524288u + (ix & 255u) * 128u + c2[i]; }
                    } else {
#pragma unroll
                        for (int h = 0; h < 2; ++h)
#pragma unroll
                            for (int i = 0; i < 2; ++i) gnxt[h][i] = gcur[h][i];
                    }
                }
            }
            G8_LDB(B0, 0, 0); G8_LDB(B1, 0, 1); G8_SCHED; G8_LDA(At, 0, 0); G8_STA(G8_SA(1, 1), cur, gcur, 1, k1);
            G8_WAIT_V(8); G8_WAIT_L(0); G8_BAR; G8_MMA(0, 0, At, B0); G8_MMA(0, 1, At, B1); G8_BAR; G8_SCHED;
            G8_LDA(At, 0, 1);
            if (last) { G8_STB(G8_SB(0, 0), nxt, 0, k2); G8_STB(G8_SB(0, 1), nxt, 1, k2); G8_STA(G8_SA(0, 0), nxt, gnxt, 0, k2); }
            else      { G8_STB(G8_SB(0, 0), cur, 0, k2); G8_STB(G8_SB(0, 1), cur, 1, k2); G8_STA(G8_SA(0, 0), cur, gcur, 0, k2); }
            G8_WAIT_V(8); G8_WAIT_L(0); G8_BAR; G8_MMA(1, 0, At, B0); G8_MMA(1, 1, At, B1); G8_BAR; G8_SCHED;
            G8_LDB(B0, 1, 0); G8_LDB(B1, 1, 1); G8_SCHED; G8_LDA(At, 1, 0);
            if (last) { G8_STA(G8_SA(0, 1), nxt, gnxt, 1, k2); } else { G8_STA(G8_SA(0, 1), cur, gcur, 1, k2); }
            G8_WAIT_V(8); G8_WAIT_L(0); G8_BAR; G8_MMA(0, 0, At, B0); G8_MMA(0, 1, At, B1); G8_BAR; G8_SCHED;
            G8_LDA(At, 1, 1);
            if (last) { G8_STB(G8_SB(1, 0), nxt, 0, k3); G8_STB(G8_SB(1, 1), nxt, 1, k3); G8_STA(G8_SA(1, 0), nxt, gnxt, 0, k3); }
            else      { G8_STB(G8_SB(1, 0), cur, 0, k3); G8_STB(G8_SB(1, 1), cur, 1, k3); G8_STA(G8_SA(1, 0), cur, gcur, 0, k3); }
            G8_WAIT_V(8); G8_WAIT_L(0); G8_BAR; G8_MMA(1, 0, At, B0); G8_MMA(1, 1, At, B1); G8_BAR; G8_SCHED;
        }
        if constexpr (G8_ALIGN_EPI) { if (wr == 0) G8_BAR; }
        const bool keep = E(acc, cur, wr, wc, fr, fq);
        if (!has_next) break;
        if (!keep) {
#pragma unroll
        for (int a = 0; a < 2; ++a)
#pragma unroll
            for (int b = 0; b < 2; ++b)
#pragma unroll
                for (int m = 0; m < 4; ++m)
#pragma unroll
                    for (int n = 0; n < 2; ++n) acc[a][b][m][n] = (f32x4){0.f, 0.f, 0.f, 0.f};
        }
        cur = nxt; ++ui;
        if constexpr (GATHER) {
#pragma unroll
            for (int h = 0; h < 2; ++h)
#pragma unroll
                for (int i = 0; i < 2; ++i) gcur[h][i] = gnxt[h][i];
        }
        if constexpr (G8_ALIGN_EPI) { if (wr == 1) G8_BAR; }
    }
    G8_WAIT_V(0);
    if constexpr (!G8_ALIGN_EPI) { if (wr == 0) G8_BAR; }
    G8_BAR;
#undef G8_SA
#undef G8_SB
#undef G8_STAGE
#undef G8_STAGE_G
#undef G8_STAGE_D
#undef G8_LDA
#undef G8_LDB
#undef G8_MMA
#undef G8_WAIT_V
#undef G8_WAIT_L
#undef G8_BAR
#undef G8_SCHED
#undef G8_STA
#undef G8_STB
#undef G8_KOFF
}
}
struct Frame {
    LAS unsigned char* lds;
    int tid, lane, wave, vcu, G;
    float* out; unsigned char* ws;
};
__device__ __forceinline__ void phase_ids(Frame& F) { const int l = fresh_lane(); F.lane = l; F.tid = F.wave * 64 + l; }
enum { IN_X = 0, IN_NORM1 = 1, IN_WIN = 2, IN_DQG = 3, IN_DKG = 4, IN_NQG = 5, IN_NKG = 6, IN_RPB = 7, IN_WDIL = 8, IN_WNA = 9, IN_WOUT = 10, IN_NORM2 = 11, IN_WROUTER = 12, IN_WGATE = 13, IN_WUP = 14, IN_WDOWN = 15 };
__device__ __forceinline__ const float* inptr(int k) {
    int off = k * 8; asm volatile("" : "+s"(off));
    const __attribute__((address_space(4))) char* ka = (const __attribute__((address_space(4))) char*)__builtin_amdgcn_kernarg_segment_ptr();
    return *(const float* const __attribute__((address_space(4)))*)(ka + off);
}
__device__ __forceinline__ int dil_of(int g) { return g == 0 ? 1 : (g == 1 ? 4 : 16); }

constexpr int KT = 16;
struct SchedQKd {
    static constexpr unsigned KA = 128, KB = 128; static constexpr bool DIL = false;
    const char* hb; const char* win; char* qd; char* kd; int G, c;
    __device__ __forceinline__ bool next(int i, g8::Unit& u) const { return at((long)i * G + c, u); }
    __device__ __forceinline__ bool at(long Lu, g8::Unit& u) const {
        int pm, pn; if (!g8::tile_order(Lu, 128, 6, pm, pn)) return false;
        const int b = pm >> 4, j = pm & 15, which = pn / 3, g = pn % 3, d = dil_of(g), L = S / d, pos0 = j * 256, r = pos0 / L, u0 = pos0 % L;
        u.A = hb + ((size_t)b * S + (size_t)u0 * d + r) * (D * 2); u.sA = (unsigned)(d * D * 2);
        u.B = win + (size_t)pn * 256 * (D * 2); u.sB = D * 2;
        u.p = (which ? kd : qd) + ((size_t)(b * DILH + g * 4) * S + pos0) * (HD * 2);
        u.e0 = u0; u.e1 = d; u.e2 = r; u.e3 = which; u.nt = KT; u.ty = 0;
        return true;
    }
};
struct SchedQKn {
    static constexpr unsigned KA = 128, KB = 128; static constexpr bool DIL = false;
    const char* hb; const char* win; char* qn; char* kn; int G, c;
    __device__ __forceinline__ bool next(int i, g8::Unit& u) const { return at((long)i * G + c, u); }
    __device__ __forceinline__ bool at(long L, g8::Unit& u) const {
        int pm, pn; if (!g8::tile_order(L, 128, 4, pm, pn)) return false;
        const int b = pm >> 4, j = pm & 15, which = pn >> 1, hh = pn & 1;
        u.A = hb + (size_t)pm * 256 * (D * 2); u.sA = D * 2;
        u.B = win + (size_t)(9 + pn) * 256 * (D * 2); u.sB = D * 2;
        u.p = (which ? kn : qn) + ((size_t)(b * NAH + hh * 4) * S + j * 256) * (HD * 2);
        u.e0 = j * 256; u.e1 = 1; u.e2 = 0; u.e3 = which; u.nt = KT; u.ty = 1;
        return true;
    }
};
struct SchedVt {
    static constexpr unsigned KA = 128, KB = 128; static constexpr bool DIL = false;
    const char* hb; const char* win; char* vtd; char* vtn; int G, c;
    __device__ __forceinline__ bool next(int i, g8::Unit& u) const { return at((long)i * G + c, u); }
    __device__ __forceinline__ bool at(long Lu, g8::Unit& u) const {
        int pm, pn; if (!g8::tile_order(Lu, 5, 128, pm, pn)) return false;
        const int b = pn >> 4, j = pn & 15, pos0 = j * 256;
        const int d = pm < 3 ? dil_of(pm) : 1, L = S / d, r = pos0 / L, u0 = pos0 % L;
        u.A = win + (size_t)(pm < 3 ? 6 + pm : 10 + pm) * 256 * (D * 2); u.sA = D * 2;
        u.B = hb + ((size_t)b * S + (size_t)u0 * d + r) * (D * 2); u.sB = (unsigned)(d * D * 2);
        u.p = (pm < 3 ? vtd + ((size_t)(b * DILH + pm * 4) * HD * S + (size_t)pos0 * HD) * 2 : vtn + ((size_t)(b * NAH + (pm - 3) * 4) * HD * S + (size_t)pos0 * HD) * 2);
        u.e0 = 0; u.e1 = 0; u.e2 = 0; u.e3 = pm < 3 ? 0 : 1; u.nt = KT; u.ty = 3;
        return true;
    }
};
struct SchedDense {
    static constexpr unsigned KA = 128, KB = 128; static constexpr bool DIL = false;
    const char* A; const char* B; unsigned lda, ldb; int nM, nN, G, c, kt;
    __device__ __forceinline__ bool next(int i, g8::Unit& u) const {
        int pm, pn; if (!g8::tile_order((long)i * G + c, nM, nN, pm, pn)) return false;
        u.A = A + (size_t)pm * 256 * lda; u.sA = lda; u.B = B + (size_t)pn * 256 * ldb; u.sB = ldb;
        u.p = nullptr; u.e0 = pm * 256; u.e1 = pn * 256; u.e2 = 0; u.e3 = 0; u.nt = kt; u.ty = 0;
        return true;
    }
};
struct SchedKtm {
    static constexpr unsigned KA = 32768, KB = 32768; static constexpr bool DIL = false;
    const char* A; const char* B; int nM, nN, G, c, kt;
    __device__ __forceinline__ bool next(int i, g8::Unit& u) const {
        int pm, pn; if (!g8::tile_order((long)i * G + c, nM, nN, pm, pn)) return false;
        u.A = A + (size_t)pm * kt * 32768; u.sA = 128; u.B = B + (size_t)pn * kt * 32768; u.sB = 128;
        u.p = nullptr; u.e0 = pm * 256; u.e1 = pn * 256; u.e2 = 0; u.e3 = 0; u.nt = kt; u.ty = 0;
        return true;
    }
};
struct SchedGU {
    static constexpr unsigned KA = 32768, KB = 32768; static constexpr bool DIL = false;
    const char* h2; const char* wgu; const int* idx; int G, c;
    __device__ __forceinline__ bool next(int i, g8::Unit& u) const {
        int pm, pn; if (!g8::tile_order((long)i * G + c, 256, 8, pm, pn)) return false;
        const int e = pm >> 4, b = (pm >> 1) & 7;
        u.A = h2 + (size_t)b * S * (D * 2); u.sA = D * 2; u.p = (char*)(idx + (size_t)pm * 256);
        u.B = wgu + ((size_t)e * 2048 + (size_t)pn * 256) * (D * 2); u.sB = 128;
        u.e0 = pm * 256; u.e1 = pn * 128; u.e2 = 0; u.e3 = 0; u.nt = KT; u.ty = 0;
        return true;
    }
};
struct SchedDown {
    static constexpr unsigned KA = 32768, KB = 32768; static constexpr bool DIL = false;
    const char* hbuf; const char* wd; int G, c;
    __device__ __forceinline__ bool next(int i, g8::Unit& u) const {
        const long Lf = (long)i * G + c; if (Lf >= 1024) return false;
        int pm, pn; if (!g8::tile_order(1023 - Lf, 256, 4, pm, pn)) return false;
        const int e = pm >> 4;
        u.A = hbuf + (size_t)pm * 256 * (FF * 2); u.sA = 128;
        u.B = wd + ((size_t)e * 1024 + (size_t)pn * 256) * (FF * 2); u.sB = 128;
        u.p = nullptr; u.e0 = pm * 256; u.e1 = pn * 256; u.e2 = 0; u.e3 = 0; u.nt = KT; u.ty = 0;
        return true;
    }
};
struct SchedGates {
    static constexpr unsigned KA = 128, KB = 128; static constexpr bool DIL = false;
    const char* hb; const char* win; int G, c;
    __device__ __forceinline__ bool at(long L, g8::Unit& u) const {
        int pm, pn; if (!g8::tile_order(L, 128, 8, pm, pn)) return false;
        u.A = hb + (size_t)pm * 256 * (D * 2); u.sA = D * 2; u.B = win + (size_t)(15 + pn) * 256 * (D * 2); u.sB = D * 2;
        u.p = nullptr; u.e0 = pm * 256; u.e1 = pn * 128; u.e2 = 0; u.e3 = 0; u.nt = KT; u.ty = 2;
        return true;
    }
};
struct SchedP1 {
    static constexpr unsigned KA = 128, KB = 128; static constexpr bool DIL = false;
    SchedQKd a; SchedQKn b; SchedGates g; SchedVt v; int G, c;
    __device__ __forceinline__ bool next(int i, g8::Unit& u) const {
        long L = (long)i * G + c;
        if (L < 768) return a.at(L, u); L -= 768;
        if (L < 512) return b.at(L, u); L -= 512;
        if (L < 1024) return g.at(L, u); L -= 1024;
        return v.at(L, u);
    }
};
struct SchedP3 {
    static constexpr unsigned KA = 128, KB = 128; static constexpr bool DIL = false;
    const char* ya; const char* pa; const char* yb; const char* pb; int G, c;
    __device__ __forceinline__ bool next(int i, g8::Unit& u) const {
        int pm, pn; if (!g8::tile_order((long)(i >> 1) * G + c, 128, 4, pm, pn)) return false;
        if (i & 1) { u.A = yb + (size_t)pm * 256 * 1024; u.sA = 1024; u.B = pb + (size_t)pn * 256 * 1024; u.sB = 1024; u.nt = 8; u.ty = 1; }
        else       { u.A = ya + (size_t)pm * 256 * 512;  u.sA = 512;  u.B = pa + (size_t)pn * 256 * 512;  u.sB = 512;  u.nt = 4; u.ty = 0; }
        u.p = nullptr; u.e0 = pm * 256; u.e1 = pn * 256; u.e2 = 0; u.e3 = 0;
        return true;
    }
};

typedef f32x4 (&AccRef)[2][2][4][2];

template <bool ROT> struct EpiQK {
    static constexpr bool PERM = true, COL64 = false;
    const float* gq; const float* gk; const f32x2* rope; float qscale; WtBuf wb;
    __device__ __forceinline__ bool operator()(AccRef acc, const g8::Unit& u, int wr, int wc, int fr, int fq) const { run(acc, u, wr, wc, fr, fq); return false; }
    __device__ __forceinline__ void run(AccRef acc, const g8::Unit& u, int wr, int wc, int fr, int fq) const {
        asm volatile("" : "+v"(fq), "+v"(fr));
        const float* g = u.e3 ? gk : gq; const float sc = u.e3 ? 1.0f : qscale;
        f32x4 rp[2][4];
#define EQK_LOAD(grp, buf) do { const int _R = ((grp) >> 2) * 128 + wr * 64 + ((grp) & 3) * 16 + fr; const f32x4* _p = (const f32x4*)(rope + (size_t)((u.e0 + _R) * u.e1 + u.e2) * 32 + 8 * fq); \
        rp[buf][0] = _p[0]; rp[buf][1] = _p[1]; rp[buf][2] = _p[2]; rp[buf][3] = _p[3]; } while (0)
        if (ROT) { EQK_LOAD(0, 0); }
        float gl[2][8];
#pragma unroll
        for (int bj = 0; bj < 2; ++bj) { const f32x4 a = *(const f32x4*)(g + 32 * bj + 8 * fq), b = *(const f32x4*)(g + 32 * bj + 8 * fq + 4);
            gl[bj][0] = a[0] * sc; gl[bj][1] = a[1] * sc; gl[bj][2] = a[2] * sc; gl[bj][3] = a[3] * sc; gl[bj][4] = b[0] * sc; gl[bj][5] = b[1] * sc; gl[bj][6] = b[2] * sc; gl[bj][7] = b[3] * sc; }
        char* ob = u.p + (size_t)wc * S * (HD * 2);
        const int ln = fq * 16 + fr;
#pragma unroll
        for (int ai = 0; ai < 2; ++ai) {
            float rs[4];
#pragma unroll
            for (int m = 0; m < 4; ++m) { float ss = 0.f;
#pragma unroll
                for (int bj = 0; bj < 2; ++bj)
#pragma unroll
                    for (int n = 0; n < 2; ++n)
#pragma unroll
                        for (int k = 0; k < 4; ++k) { const float t = acc[ai][bj][m][n][k]; ss += t * t; }
                rs[m] = ss; }
#pragma unroll
            for (int m = 0; m < 4; ++m) rs[m] += shx(rs[m], 16, ln);
#pragma unroll
            for (int m = 0; m < 4; ++m) rs[m] += shx(rs[m], 32, ln);
#pragma unroll
            for (int m = 0; m < 4; ++m) rs[m] = rsqrtf(rs[m] * (1.0f / 64.0f) + EPS);
#pragma unroll
            for (int m = 0; m < 4; ++m) {
                const int grp = ai * 4 + m;
                if (ROT) { if (grp + 1 < 8) EQK_LOAD(grp + 1, (grp + 1) & 1); __builtin_amdgcn_sched_barrier(0); }
                const int R = ai * 128 + wr * 64 + m * 16 + fr;
                float v[2][8];
#pragma unroll
                for (int bj = 0; bj < 2; ++bj)
#pragma unroll
                    for (int n = 0; n < 2; ++n)
#pragma unroll
                        for (int k = 0; k < 4; ++k) v[bj][4 * n + k] = acc[ai][bj][m][n][k] * rs[m] * gl[bj][4 * n + k];
                float o[2][8];
                if (ROT) {
                    const f32x4 c0 = rp[grp & 1][0], c1 = rp[grp & 1][1], c2 = rp[grp & 1][2], c3 = rp[grp & 1][3];
                    const float cs[8] = {c0[0], c0[2], c1[0], c1[2], c2[0], c2[2], c3[0], c3[2]}, sn[8] = {c0[1], c0[3], c1[1], c1[3], c2[1], c2[3], c3[1], c3[3]};
#pragma unroll
                    for (int k = 0; k < 8; ++k) { o[0][k] = v[0][k] * cs[k] - v[1][k] * sn[k]; o[1][k] = v[1][k] * cs[k] + v[0][k] * sn[k]; }
                } else {
#pragma unroll
                    for (int k = 0; k < 8; ++k) { o[0][k] = v[0][k]; o[1][k] = v[1][k]; }
                }
#pragma unroll
                for (int bj = 0; bj < 2; ++bj) { u32x4 w; w.x = pk2(o[bj][0], o[bj][1]); w.y = pk2(o[bj][2], o[bj][3]); w.z = pk2(o[bj][4], o[bj][5]); w.w = pk2(o[bj][6], o[bj][7]);
                    char* dst = ROT ? ob + (size_t)(R >> 5) * 4096 + (2 * bj + (fq >> 1)) * 1024 + (fq & 1) * 512 + (R & 31) * 16
                                    : ob + (size_t)(R >> 3) * 1024 + bj * 512 + fq * 128 + (R & 7) * 16;
                    wt_store16(wb, dst, w); }
                if (ROT) __builtin_amdgcn_sched_barrier(0);
            }
        }
#undef EQK_LOAD
    }
};
struct EpiVt {
    static constexpr bool PERM = true, COL64 = false;
    WtBuf wb;
    __device__ __forceinline__ bool operator()(AccRef acc, const g8::Unit& u, int wr, int wc, int fr, int fq) const { run(acc, u, wr, wc, fr, fq); return false; }
    __device__ __forceinline__ void run(AccRef acc, const g8::Unit& u, int wr, int wc, int fr, int fq) const {
#pragma unroll
        for (int ai = 0; ai < 2; ++ai)
#pragma unroll
            for (int m = 0; m < 4; ++m) { const int dim = 16 * m + fr; char* hp = u.p + (size_t)(2 * ai + wr) * (S * HD * 2);
#pragma unroll
                for (int bj = 0; bj < 2; ++bj) { const f32x4 v0 = acc[ai][bj][m][0], v1 = acc[ai][bj][m][1];
                    u32x4 w; w.x = pk2(v0[0], v0[1]); w.y = pk2(v0[2], v0[3]); w.z = pk2(v1[0], v1[1]); w.w = pk2(v1[2], v1[3]);
                    if (u.e3) { wt_store16(wb, hp + (size_t)(16 * bj + 4 * wc + fq) * 1024 + dim * 16, w); }
                    else { char* q = hp + (size_t)(4 * bj + wc) * 4096 + ((dim >> 5) * 2 + (fq >> 1)) * 1024 + (dim & 31) * 16 + (fq & 1) * 8;
                        wt_store8(wb, q, (u32x2){w.x, w.y}); wt_store8(wb, q + 512, (u32x2){w.z, w.w}); } } }
    }
};
template <int ACT> struct EpiBf16 {
    static constexpr bool PERM = true, COL64 = false;
    bf16_t* O; int ldc; int probe; WtBuf wb;
    __device__ __forceinline__ bool operator()(AccRef acc, const g8::Unit& u, int wr, int wc, int fr, int fq) const { run(acc, u, wr, wc, fr, fq); return false; }
    __device__ __forceinline__ void run(AccRef acc, const g8::Unit& u, int wr, int wc, int fr, int fq) const {
        if (probe == 2) return;
#pragma unroll
        for (int ai = 0; ai < 2; ++ai)
#pragma unroll
            for (int m = 0; m < 4; ++m) { bf16_t* rowp = O + (size_t)(u.e0 + ai * 128 + wr * 64 + m * 16 + fr) * ldc + u.e1 + wc * 32 + 8 * fq;
                if (probe == 1) rowp = O + ((size_t)blockIdx.x * 256 + ai * 128 + wr * 64 + m * 16 + fr) * 256 + wc * 32 + 8 * fq;
                if (probe == 3) rowp = O + ((size_t)((blockIdx.x * 8 + wr * 4 + wc) * 8 + ai * 4 + m) * 2) * 512 + (fq * 16 + fr) * 8 - 0;
#pragma unroll
                for (int bj = 0; bj < 2; ++bj) { f32x4 v0 = acc[ai][bj][m][0], v1 = acc[ai][bj][m][1];
                    if (ACT == 1) {
#pragma unroll
                        for (int k = 0; k < 4; ++k) { v0[k] = sigmoidf_fast(v0[k]); v1[k] = sigmoidf_fast(v1[k]); } }
                    u32x4 w; w.x = pk2(v0[0], v0[1]); w.y = pk2(v0[2], v0[3]); w.z = pk2(v1[0], v1[1]); w.w = pk2(v1[2], v1[3]);
                    *(u32x4*)(rowp + bj * 128) = w; } }
    }
};
template <bool ADD> struct EpiGated {
    static constexpr bool PERM = true, COL64 = false;
    bf16_t* O; const bf16_t* gates; int gcol0;
    __device__ __forceinline__ bool operator()(AccRef acc, const g8::Unit& u, int wr, int wc, int fr, int fq) const { run(acc, u, wr, wc, fr, fq); return false; }
    __device__ __forceinline__ void run(AccRef acc, const g8::Unit& u, int wr, int wc, int fr, int fq) const {
        const int col = u.e1 + wc * 32 + 8 * fq;
        u32x4 gw[2][2], ow[2][2];
#define EG_LOAD(grp, buf) do { const size_t _row = (size_t)(u.e0 + ((grp) >> 2) * 128 + wr * 64 + ((grp) & 3) * 16 + fr); _Pragma("unroll") for (int bj = 0; bj < 2; ++bj) { \
        gw[buf][bj] = *(const u32x4*)(gates + _row * 2048 + gcol0 + col + bj * 128); if (ADD) ow[buf][bj] = *(const u32x4*)(O + _row * D + col + bj * 128); } } while (0)
        EG_LOAD(0, 0);
#pragma unroll
        for (int grp = 0; grp < 8; ++grp) {
            const int ai = grp >> 2, m = grp & 3;
            if (grp + 1 < 8) EG_LOAD(grp + 1, (grp + 1) & 1);
            __builtin_amdgcn_sched_barrier(0);
            const size_t row = (size_t)(u.e0 + ai * 128 + wr * 64 + m * 16 + fr);
#pragma unroll
            for (int bj = 0; bj < 2; ++bj) { const f32x4 v0 = acc[ai][bj][m][0], v1 = acc[ai][bj][m][1]; const u32x4 g = gw[grp & 1][bj];
                float r[8] = {v0[0] * bflo(g.x), v0[1] * bfhi(g.x), v0[2] * bflo(g.y), v0[3] * bfhi(g.y), v1[0] * bflo(g.z), v1[1] * bfhi(g.z), v1[2] * bflo(g.w), v1[3] * bfhi(g.w)};
                if (ADD) { const u32x4 o = ow[grp & 1][bj]; r[0] += bflo(o.x); r[1] += bfhi(o.x); r[2] += bflo(o.y); r[3] += bfhi(o.y); r[4] += bflo(o.z); r[5] += bfhi(o.z); r[6] += bflo(o.w); r[7] += bfhi(o.w); }
                u32x4 w; w.x = pk2(r[0], r[1]); w.y = pk2(r[2], r[3]); w.z = pk2(r[4], r[5]); w.w = pk2(r[6], r[7]);
                *(u32x4*)(O + row * D + col + bj * 128) = w; }
            __builtin_amdgcn_sched_barrier(0);
        }
#undef EG_LOAD
    }
};
struct EpiGates {
    static constexpr bool PERM = true, COL64 = false;
    bf16_t* Gt; WtBuf wb;
    __device__ __forceinline__ void run(AccRef acc, const g8::Unit& u, int wr, int wc, int fr, int fq) const {
#pragma unroll
        for (int ai = 0; ai < 2; ++ai)
#pragma unroll
            for (int m = 0; m < 4; ++m) { bf16_t* rowp = Gt + (size_t)(u.e0 + ai * 128 + wr * 64 + m * 16 + fr) * 2048 + u.e1 + wc * 32 + 8 * fq;
                float rho[8], sn[8];
#pragma unroll
                for (int n = 0; n < 2; ++n)
#pragma unroll
                    for (int k = 0; k < 4; ++k) { const float ea = __builtin_amdgcn_exp2f(-acc[ai][0][m][n][k] * LOG2E), en = __builtin_amdgcn_exp2f(-acc[ai][1][m][n][k] * LOG2E);
                        sn[4 * n + k] = __builtin_amdgcn_rcpf(1.0f + en); rho[4 * n + k] = (1.0f + en) * __builtin_amdgcn_rcpf(1.0f + ea); }
                u32x4 w; w.x = pk2(rho[0], rho[1]); w.y = pk2(rho[2], rho[3]); w.z = pk2(rho[4], rho[5]); w.w = pk2(rho[6], rho[7]); wt_store16(wb, rowp, w);
                w.x = pk2(sn[0], sn[1]); w.y = pk2(sn[2], sn[3]); w.z = pk2(sn[4], sn[5]); w.w = pk2(sn[6], sn[7]); wt_store16(wb, rowp + 1024, w); }
    }
};
struct EpiP1 {
    static constexpr bool PERM = true, COL64 = false;
    EpiQK<true> qkd; EpiQK<false> qkn; EpiGates gt; EpiVt vt; int skipmask;
    __device__ __forceinline__ bool operator()(AccRef acc, const g8::Unit& u, int wr, int wc, int fr, int fq) const {
        if ((skipmask >> u.ty) & 1) return false;
        if (u.ty == 0) qkd.run(acc, u, wr, wc, fr, fq);
        else if (u.ty == 1) qkn.run(acc, u, wr, wc, fr, fq);
        else if (u.ty == 2) gt.run(acc, u, wr, wc, fr, fq);
        else vt.run(acc, u, wr, wc, fr, fq);
        return false;
    }
};
struct EpiP3 {
    static constexpr bool PERM = true, COL64 = false;
    bf16_t* O; const bf16_t* Gt; WtBuf wb;
    __device__ __forceinline__ bool operator()(AccRef acc, const g8::Unit& u, int wr, int wc, int fr, int fq) const {
        const int col = u.e1 + wc * 32 + 8 * fq; const int gc = (u.ty ? 1024 : 0) + col;
        u32x4 gw[2][2];
#define EP3_LOAD(grp, buf) do { const size_t _row = (size_t)(u.e0 + ((grp) >> 2) * 128 + wr * 64 + ((grp) & 3) * 16 + fr); _Pragma("unroll") for (int bj = 0; bj < 2; ++bj) gw[buf][bj] = *(const u32x4*)(Gt + _row * 2048 + gc + bj * 128); } while (0)
        EP3_LOAD(0, 0);
#pragma unroll
        for (int grp = 0; grp < 8; ++grp) {
            const int ai = grp >> 2, m = grp & 3;
            if (grp + 1 < 8) EP3_LOAD(grp + 1, (grp + 1) & 1);
            __builtin_amdgcn_sched_barrier(0);
            const size_t row = (size_t)(u.e0 + ai * 128 + wr * 64 + m * 16 + fr);
#pragma unroll
            for (int bj = 0; bj < 2; ++bj) { const u32x4 g = gw[grp & 1][bj];
                const f32x4 s0 = {bflo(g.x), bfhi(g.x), bflo(g.y), bfhi(g.y)}, s1 = {bflo(g.z), bfhi(g.z), bflo(g.w), bfhi(g.w)};
                const f32x4 v0 = acc[ai][bj][m][0] * s0, v1 = acc[ai][bj][m][1] * s1;
                if (u.ty) { u32x4 w; w.x = pk2(v0[0], v0[1]); w.y = pk2(v0[2], v0[3]); w.z = pk2(v1[0], v1[1]); w.w = pk2(v1[2], v1[3]);
                    const int cc = col + bj * 128;
                    wt_store16(wb, O + ((size_t)(row >> 8) * 16 + (cc >> 6)) * 16384 + (row & 255) * 64 + (cc & 63), w); }
                else { acc[ai][bj][m][0] = v0; acc[ai][bj][m][1] = v1; } }
            __builtin_amdgcn_sched_barrier(0);
        }
#undef EP3_LOAD
        return u.ty == 0;
    }
};
struct EpiResid {
    static constexpr bool PERM = false, COL64 = false;
    const float* base; float* out;
    __device__ __forceinline__ bool operator()(AccRef acc, const g8::Unit& u, int wr, int wc, int fr, int fq) const { run(acc, u, wr, wc, fr, fq); return false; }
    __device__ __forceinline__ void run(AccRef acc, const g8::Unit& u, int wr, int wc, int fr, int fq) const {
        const int col = u.e1 + wc * 32 + 4 * fq;
        f32x4 bs[3][2][2];
#define ER_LOAD(grp, buf) do { const size_t _off = (size_t)(u.e0 + ((grp) >> 2) * 128 + wr * 64 + ((grp) & 3) * 16 + fr) * D + col; _Pragma("unroll") for (int bj = 0; bj < 2; ++bj) _Pragma("unroll") for (int n = 0; n < 2; ++n) \
        bs[buf][bj][n] = *(const f32x4*)(base + _off + bj * 128 + n * 16); } while (0)
        ER_LOAD(0, 0); ER_LOAD(1, 1);
#pragma unroll
        for (int grp = 0; grp < 8; ++grp) {
            const int ai = grp >> 2, m = grp & 3;
            if (grp + 2 < 8) ER_LOAD(grp + 2, (grp + 2) % 3);
            __builtin_amdgcn_sched_barrier(0);
            const size_t off = (size_t)(u.e0 + ai * 128 + wr * 64 + m * 16 + fr) * D + col;
#pragma unroll
            for (int bj = 0; bj < 2; ++bj)
#pragma unroll
                for (int n = 0; n < 2; ++n) *(f32x4*)(out + off + bj * 128 + n * 16) = bs[grp % 3][bj][n] + acc[ai][bj][m][n];
            __builtin_amdgcn_sched_barrier(0);
        }
#undef ER_LOAD
    }
};
struct EpiSwiGLU {
    static constexpr bool PERM = true, COL64 = false;
    bf16_t* H; int skip; WtBuf wb;
    __device__ __forceinline__ bool operator()(AccRef acc, const g8::Unit& u, int wr, int wc, int fr, int fq) const { run(acc, u, wr, wc, fr, fq); return false; }
    __device__ __forceinline__ void run(AccRef acc, const g8::Unit& u, int wr, int wc, int fr, int fq) const {
        if (skip) return;
#pragma unroll
        for (int ai = 0; ai < 2; ++ai)
#pragma unroll
            for (int m = 0; m < 4; ++m) { const int col = u.e1 + wc * 32 + 8 * fq;
                bf16_t* rowp = H + ((size_t)(u.e0 >> 8) * 16 + (col >> 6)) * 16384 + (size_t)(ai * 128 + wr * 64 + m * 16 + fr) * 64 + (col & 63);
                float r[8];
#pragma unroll
                for (int n = 0; n < 2; ++n)
#pragma unroll
                    for (int k = 0; k < 4; ++k) { const float a = acc[ai][0][m][n][k], b = acc[ai][1][m][n][k]; r[4 * n + k] = a * sigmoidf_fast(a) * b; }
                u32x4 w; w.x = pk2(r[0], r[1]); w.y = pk2(r[2], r[3]); w.z = pk2(r[4], r[5]); w.w = pk2(r[6], r[7]);
                wt_store16(wb, rowp, w); }
    }
};
__device__ __forceinline__ void p0_transpose_item(const float* W, int K, int N, bf16_t* WT, int k0, int n0s, int n0d, LAS float* scr, int lane, bool ktm = false) {
#pragma unroll 8
    for (int i = 0; i < 32; ++i) { const int kk = 2 * i + (lane >> 5); scr[kk * 33 + (lane & 31)] = W[(size_t)(k0 + kk) * N + n0s + (lane & 31)]; }
    LDS_WAIT(); asm volatile("" ::: "memory");
    const int c = lane & 7;
#pragma unroll
    for (int j = 0; j < 4; ++j) { const int n = (lane >> 3) + 8 * j; const LAS float* s = scr + (8 * c) * 33 + n;
        u32x4 o; o.x = pk2(s[0 * 33], s[1 * 33]); o.y = pk2(s[2 * 33], s[3 * 33]); o.z = pk2(s[4 * 33], s[5 * 33]); o.w = pk2(s[6 * 33], s[7 * 33]);
        const int nd = n0d + n;
        *(u32x4*)(ktm ? WT + ((size_t)(nd >> 8) * (K >> 6) + (k0 >> 6)) * 16384 + (size_t)(nd & 255) * 64 + 8 * c : WT + (size_t)nd * K + k0 + 8 * c) = o; }
    LDS_WAIT(); asm volatile("" ::: "memory");
}
__device__ __forceinline__ int win_dst_row(int cg) {
    const int tile = cg >> 3, w = cg & 7;
    const bool qk = (tile < 6) || (tile >= 9 && tile < 13);
    if (tile >= 15) {
        const int isn = tile >= 19, c0 = (cg - (isn ? 152 : 120)) * 32;
        return (15 + (c0 >> 7)) * 256 + isn * 128 + ((c0 & 127) >> 5) * 32;
    }
    if (!qk) return cg * 32;
    const int wc = w >> 1, bj = w & 1;
    return tile * 256 + bj * 128 + wc * 32;
}
__device__ __forceinline__ double dsin_poly(double t) { const double t2 = t * t;
    return t * (1.0 + t2 * (-1.0 / 6 + t2 * (1.0 / 120 + t2 * (-1.0 / 5040 + t2 * (1.0 / 362880 + t2 * (-1.0 / 39916800 + t2 * (1.0 / 6227020800.0))))))); }
__device__ __forceinline__ double dcos_poly(double t) { const double t2 = t * t;
    return 1.0 + t2 * (-0.5 + t2 * (1.0 / 24 + t2 * (-1.0 / 720 + t2 * (1.0 / 40320 + t2 * (-1.0 / 3628800 + t2 * (1.0 / 479001600.0 + t2 * (-1.0 / 87178291200.0))))))); }

#ifndef MK_EXP_P0
#define MK_EXP_P0 8
#endif
#ifndef MK_EXP_P1
#define MK_EXP_P1 11
#endif
constexpr int EXP_P0 = MK_EXP_P0, EXP_P1 = MK_EXP_P1;
__device__ __forceinline__ void convert_experts(Frame& F, int e_lo, int e_hi, int rank, int nranks, unsigned* queue = nullptr) {
    LAS float* scr = (LAS float*)(F.lds + F.wave * 16384);
    const int lane = F.lane;
    bf16_t* WguT = (bf16_t*)(F.ws + WS_WGU); bf16_t* WdT = (bf16_t*)(F.ws + WS_WD);
    const float* w_gate = inptr(IN_WGATE); const float* w_up = inptr(IN_WUP); const float* w_down = inptr(IN_WDOWN);
    constexpr int I_E = 16 * 32;
    const int nit = (e_hi - e_lo) * 3 * I_E;
    for (int it = rank * 8 + F.wave;; it += nranks * 8) {
        if (queue) { unsigned t = 0; if (lane == 0) t = __hip_atomic_fetch_add(queue, 1u, __ATOMIC_RELAXED, __HIP_MEMORY_SCOPE_AGENT); it = (int)__builtin_amdgcn_readfirstlane(t); }
        if (it >= nit) break;
        const int e = e_lo + it / (3 * I_E), q = it % (3 * I_E), wsel = q / I_E, rr = q % I_E, kb = rr / 32, cg = rr % 32;
        if (wsel == 2) { p0_transpose_item(w_down + (size_t)e * FF * D, FF, D, WdT + (size_t)e * D * FF, 64 * kb, 32 * cg, 32 * cg, scr, lane, true); continue; }
        const int pn = cg >> 2, wcg = cg & 3;
        p0_transpose_item((wsel ? w_up : w_gate) + (size_t)e * D * FF, D, FF, WguT + (size_t)e * 2048 * D, 64 * kb, 32 * cg, pn * 256 + wsel * 128 + wcg * 32, scr, lane, true);
    }
}
__device__ __forceinline__ void p0_prologue(Frame& F) {
    phase_ids(F);
    LAS float* scr = (LAS float*)(F.lds + F.wave * 16384);
    const int gw = F.vcu * 8 + F.wave, NGW = F.G * 8, lane = F.lane;
    bf16_t* WinT = (bf16_t*)(F.ws + WS_WIN); bf16_t* PAt = (bf16_t*)(F.ws + WS_PA); bf16_t* PBt = (bf16_t*)(F.ws + WS_PB); bf16_t* WoT = (bf16_t*)(F.ws + WS_WO);
    const float* w_in = inptr(IN_WIN); const float* w_dil = inptr(IN_WDIL); const float* w_na = inptr(IN_WNA); const float* w_out = inptr(IN_WOUT);
    constexpr int I_IN = 16 * 184, I_PA = 4 * 32, I_PB = 8 * 32, I_WO = 16 * 32;
    constexpr int NITEMS = I_IN + I_PA + I_PB + I_WO;
    for (int it = gw; it < NITEMS; it += NGW) {
        int r = it;
        if (r < I_IN) { const int kb = r / 184, cg = r % 184; p0_transpose_item(w_in, D, INC, WinT, 64 * kb, 32 * cg, win_dst_row(cg), scr, lane); continue; } r -= I_IN;
        if (r < I_PA) { const int kb = r / 32, cg = r % 32; p0_transpose_item(w_dil, 256, D, PAt, 64 * kb, 32 * cg, 32 * cg, scr, lane); continue; } r -= I_PA;
        if (r < I_PB) { const int kb = r / 32, cg = r % 32; p0_transpose_item(w_na, 512, D, PBt, 64 * kb, 32 * cg, 32 * cg, scr, lane); continue; } r -= I_PB;
        p0_transpose_item(w_out, D, D, WoT, 64 * (r / 32), 32 * (r % 32), 32 * (r % 32), scr, lane, true);
    }
    convert_experts(F, 0, EXP_P0, F.vcu, F.G);
    bf16_t* HB = (bf16_t*)(F.ws + WS_HB);
    f32x4 gv[4];
#pragma unroll
    for (int j = 0; j < 4; ++j) gv[j] = *(const f32x4*)(inptr(IN_NORM1) + 4 * lane + 256 * j);
    const float* xin = inptr(IN_X);
    for (int m = gw; m < M; m += NGW) {
        const f32x4* xr = (const f32x4*)(xin + (size_t)m * D) + lane; f32x4 v[4]; float s = 0.f;
#pragma unroll
        for (int j = 0; j < 4; ++j) { v[j] = xr[64 * j]; s += (v[j][0] * v[j][0] + v[j][1] * v[j][1]) + (v[j][2] * v[j][2] + v[j][3] * v[j][3]); }
        const float rs = rsqrtf(wave_sum(s, lane) * (1.f / D) + EPS);
        u32x2* o8 = (u32x2*)(HB + (size_t)m * D) + lane;
#pragma unroll
        for (int j = 0; j < 4; ++j) { u32x2 w; w.x = pk2(v[j][0] * rs * gv[j][0], v[j][1] * rs * gv[j][1]); w.y = pk2(v[j][2] * rs * gv[j][2], v[j][3] * rs * gv[j][3]); o8[64 * j] = w; }
    }
    f32x2* rope = (f32x2*)(F.ws + WS_ROPE);
    for (int i = gw * 64 + lane; i < S * 32; i += NGW * 64) {
        const int pos = i >> 5, c = i & 31;
        const float inv = (float)exp2(-(double)c * (13.287712379549449 / 32.0));
        const double ang = (double)((float)pos * inv);
        const double kq = rint(ang * 0.6366197723675814);
        const double t = (ang - kq * 1.5707963267948966) - kq * 6.123233995736766e-17;
        const int q = ((int)kq) & 3;
        const double sv = dsin_poly(t), cv = dcos_poly(t);
        const double sn = (q == 0) ? sv : (q == 1 ? cv : (q == 2 ? -sv : -cv));
        const double cs = (q == 0) ? cv : (q == 1 ? -sv : (q == 2 ? -cv : sv));
        rope[i] = (f32x2){(float)cs, (float)sn};
    }
}
#define MFMA32(a, b, c) __builtin_amdgcn_mfma_f32_32x32x16_bf16((a), (b), (c), 0, 0, 0)
#define MFMA16(a, b, c) __builtin_amdgcn_mfma_f32_16x16x32_bf16((a), (b), (c), 0, 0, 0)
__device__ __forceinline__ int swz9(int tl) { return (tl & ~31) | ((tl ^ (tl >> 5)) & 31); }
__device__ __forceinline__ bf16x8 cat8(s16x4 lo, s16x4 hi) { return __builtin_shufflevector(lo, hi, 0, 1, 2, 3, 4, 5, 6, 7); }

#define SCHED_FENCE() __builtin_amdgcn_sched_barrier(0)
__device__ __forceinline__ void lds_fadd(LAS float* p, float v) { (void)__hip_atomic_fetch_add(p, v, __ATOMIC_RELAXED, __HIP_MEMORY_SCOPE_WORKGROUP); }

template <int NT>
__device__ __forceinline__ void dil_tile64(const bf16_t* Qp, const bf16_t* Kp, const bf16_t* Vp, int p0, int seg0, int seg1, float shift, f32x16 (&O)[NT][2], float (&lsum)[NT], int lane) {
    const int r = lane & 31, hf = lane >> 5;
    const bf16_t* ql = Qp + (size_t)p0 * 64 + lane * 8;
    const bf16_t* kl = Kp + lane * 8;
    const bf16_t* vl = Vp + lane * 8;
    bf16x8 qf[NT][4], kf[2][4], vf[2][2][2];
#pragma unroll
    for (int t = 0; t < NT; ++t)
#pragma unroll
        for (int s = 0; s < 4; ++s) qf[t][s] = *(const bf16x8*)(ql + 2048 * t + 512 * s);
#define DIL_KC(j) ((((p0 + 32 * ((j) - 2)) >= seg0) && ((p0 + 32 * ((j) - 2)) < seg1)) ? (p0 + 32 * ((j) - 2)) : p0)
#define DIL_TV(j) (((p0 + 32 * ((j) - 2)) >= seg0) && ((p0 + 32 * ((j) - 2)) < seg1))
#define DIL_LDK(j, slot) do { const bf16_t* _k = kl + (size_t)DIL_KC(j) * 64; _Pragma("unroll") for (int s = 0; s < 4; ++s) kf[slot][s] = *(const bf16x8*)(_k + 512 * s); } while (0)
#define DIL_LDV(j, slot) do { const bf16_t* _v = vl + (size_t)DIL_KC(j) * 64; _Pragma("unroll") for (int mt = 0; mt < 2; ++mt) _Pragma("unroll") for (int s2 = 0; s2 < 2; ++s2) vf[slot][mt][s2] = *(const bf16x8*)(_v + (mt * 2 + s2) * 512); } while (0)
    DIL_LDK(0, 0); DIL_LDV(0, 0);
    SCHED_FENCE();
#pragma unroll
    for (int t = 0; t < NT; ++t) { lsum[t] = 0.f;
#pragma unroll
        for (int i = 0; i < 16; ++i) { O[t][0][i] = 0.f; O[t][1][i] = 0.f; } }
#pragma unroll
    for (int j = 0; j < 4 + NT; ++j) {
        if (j + 1 < 4 + NT) { DIL_LDK(j + 1, (j + 1) & 1); DIL_LDV(j + 1, (j + 1) & 1); }
        SCHED_FENCE();
        const bool tv = DIL_TV(j);
#pragma unroll
        for (int t = 0; t < NT; ++t) {
            const int jj = j - t;
            if (jj >= 0 && jj <= 4) {
                f32x16 sa;
#pragma unroll
                for (int i = 0; i < 16; ++i) sa[i] = 0.f;
#pragma unroll
                for (int s = 0; s < 4; ++s) sa = MFMA32(kf[j & 1][s], qf[t][s], sa);
                float p[16];
#pragma unroll
                for (int reg = 0; reg < 16; ++reg) {
                    const int kk = (reg & 3) + 8 * (reg >> 2) + 4 * hf;
                    bool ok = tv;
                    if (jj == 0) ok = ok && (kk >= r);
                    if (jj == 4) ok = ok && (kk <= r);
                    const float e = __builtin_amdgcn_exp2f(sa[reg] - shift);
                    p[reg] = ok ? e : 0.f; lsum[t] += p[reg];
                }
#pragma unroll
                for (int s2 = 0; s2 < 2; ++s2) {
                    u32x4 pw; pw.x = pk2(p[8 * s2], p[8 * s2 + 1]); pw.y = pk2(p[8 * s2 + 2], p[8 * s2 + 3]); pw.z = pk2(p[8 * s2 + 4], p[8 * s2 + 5]); pw.w = pk2(p[8 * s2 + 6], p[8 * s2 + 7]);
                    const bf16x8 pb = __builtin_bit_cast(bf16x8, pw);
#pragma unroll
                    for (int mt = 0; mt < 2; ++mt) O[t][mt] = MFMA32(vf[j & 1][mt][s2], pb, O[t][mt]);
                }
            }
        }
        SCHED_FENCE();
    }
#undef DIL_KC
#undef DIL_TV
#undef DIL_LDK
#undef DIL_LDV
}

__device__ __forceinline__ void na_tile4(const bf16_t* Qp, const bf16_t* Kp, const bf16_t* Vp, bf16_t* yb, const LAS float* rpbl, int r0, int cb, float shift, int lane) {
    const int qi = lane & 15, q4 = lane >> 4;
    const int qc = 16 * cb + qi;
    const int kc0 = min(max(16 * cb - 8, 0), 32), ws = min(max(qc - 8, 0), 48);
    const int cA = kc0 + 4 * q4, cB = cA + 16;
    const int lo = (qi >> 3) * 512 + q4 * 64 + (qi & 7) * 8;
    const int mb = kc0 + 4 * q4 - ws;
    const int rs0 = min(max(r0 - 4, 0), 56);
    int off[4];
#pragma unroll
    for (int q = 0; q < 4; ++q) off[q] = min(max(r0 + q - 4, 0), 56) - rs0;
    const int nrows = off[3] + 8;
    const bf16_t* kl = Kp + (size_t)(rs0 * GW + kc0) * 64 + lo;
    const bf16_t* vlA = Vp + (size_t)(rs0 * GW + (cA & ~7)) * 64 + qi * 8 + (cA & 7);
    const bf16_t* vlB = Vp + (size_t)(rs0 * GW + (cB & ~7)) * 64 + qi * 8 + (cB & 7);
    const LAS float* bl = rpbl + (rs0 - r0 + 7) * 31 + (kc0 + 4 * q4 - qc + 15);
    bf16x8 qf[4][2], kf[3][2][2]; s16x4 vf[2][4][2];
#pragma unroll
    for (int q = 0; q < 4; ++q)
#pragma unroll
        for (int s = 0; s < 2; ++s) qf[q][s] = *(const bf16x8*)(Qp + (size_t)((r0 + q) * GW + 16 * cb) * 64 + lo + 256 * s);
#define NA_LDK(j, slot) do { const int _j = ((j) < nrows) ? (j) : (nrows - 1); _Pragma("unroll") for (int hh = 0; hh < 2; ++hh) _Pragma("unroll") for (int s = 0; s < 2; ++s) kf[slot][hh][s] = *(const bf16x8*)(kl + _j * 4096 + hh * 1024 + 256 * s); } while (0)
#define NA_LDV(j, slot) do { const int _j = ((j) < nrows) ? (j) : (nrows - 1); _Pragma("unroll") for (int mt = 0; mt < 4; ++mt) { vf[slot][mt][0] = *(const s16x4*)(vlA + _j * 4096 + mt * 128); vf[slot][mt][1] = *(const s16x4*)(vlB + _j * 4096 + mt * 128); } } while (0)
    NA_LDK(0, 0); NA_LDK(1, 1); NA_LDV(0, 0);
    SCHED_FENCE();
    bool okm[8];
#pragma unroll
    for (int e = 0; e < 8; ++e) okm[e] = (unsigned)(mb + 16 * (e >> 2) + (e & 3)) < 16u;
    f32x4 O[4][4]; float lsum[4];
#pragma unroll
    for (int q = 0; q < 4; ++q) { lsum[q] = 0.f;
#pragma unroll
        for (int mt = 0; mt < 4; ++mt) O[q][mt] = (f32x4){0.f, 0.f, 0.f, 0.f}; }
#pragma unroll
    for (int j = 0; j < 11; ++j) {
        if (j < nrows) {
            if (j + 2 < 11) { NA_LDK(j + 2, (j + 2) % 3); }
            if (j + 1 < 11) { NA_LDV(j + 1, (j + 1) & 1); }
            SCHED_FENCE();
#pragma unroll
            for (int q = 0; q < 4; ++q) {
                if (j - q >= -3 && j - q <= 10 && j >= off[q] && j < off[q] + 8) {
                    float p[8];
#pragma unroll
                    for (int hh = 0; hh < 2; ++hh) {
                        f32x4 sa = (f32x4){0.f, 0.f, 0.f, 0.f};
#pragma unroll
                        for (int s = 0; s < 2; ++s) sa = MFMA16(kf[j % 3][hh][s], qf[q][s], sa);
#pragma unroll
                        for (int v = 0; v < 4; ++v) {
                            const float e = __builtin_amdgcn_exp2f(sa[v] + bl[(j - q) * 31 + 16 * hh + v] - shift);
                            p[4 * hh + v] = okm[4 * hh + v] ? e : 0.f; lsum[q] += p[4 * hh + v];
                        }
                    }
                    u32x4 pw; pw.x = pk2(p[0], p[1]); pw.y = pk2(p[2], p[3]); pw.z = pk2(p[4], p[5]); pw.w = pk2(p[6], p[7]);
                    const bf16x8 pb = __builtin_bit_cast(bf16x8, pw);
#pragma unroll
                    for (int mt = 0; mt < 4; ++mt) O[q][mt] = MFMA16(cat8(vf[j & 1][mt][0], vf[j & 1][mt][1]), pb, O[q][mt]);
                }
            }
            SCHED_FENCE();
        }
    }
#undef NA_LDK
#undef NA_LDV
#pragma unroll
    for (int q = 0; q < 4; ++q) {
        float l = lsum[q]; l += shx(l, 16, lane); l += shx(l, 32, lane);
        const float inv = 1.0f / l;
#pragma unroll
        for (int mt = 0; mt < 4; ++mt) { u32x2 w; w.x = pk2(O[q][mt][0] * inv, O[q][mt][1] * inv); w.y = pk2(O[q][mt][2] * inv, O[q][mt][3] * inv);
            *(u32x2*)(yb + (size_t)((r0 + q) * GW + qc) * 512 + 16 * mt + 4 * q4) = w; }
    }
}

__device__ __forceinline__ void p2_attention(Frame& F, const int flags) {
    phase_ids(F);
    const int lane = F.lane, wave = F.wave, tid = F.tid;
    LAS float* Ol = (LAS float*)F.lds;
    LAS float* Ll = (LAS float*)(F.lds + LDS_L_OFF);
    const bf16_t* Qd = (const bf16_t*)(F.ws + WS_QD); const bf16_t* Kd = (const bf16_t*)(F.ws + WS_KD); const bf16_t* Vtd = (const bf16_t*)(F.ws + WS_VTD);
    const bf16_t* Qn = (const bf16_t*)(F.ws + WS_QN); const bf16_t* Kn = (const bf16_t*)(F.ws + WS_KN); const bf16_t* Vtn = (const bf16_t*)(F.ws + WS_VTN);
    bf16_t* YA = (bf16_t*)(F.ws + WS_YA); bf16_t* YB = (bf16_t*)(F.ws + WS_YB);
    const float shiftD = 8.0f * wave_max(fabsf(inptr(IN_DQG)[lane]), lane) * wave_max(fabsf(inptr(IN_DKG)[lane]), lane) * LOG2E;
    if (!(flags & 1))
    for (int su = F.vcu; su < 256; su += F.G) {
        const int b = su >> 5, h = (su >> 3) & 3, T0 = (su & 7) * 512;
#pragma unroll 1
        for (int g = 0; g < 3; ++g) {
            const int d = dil_of(g), L = S / d, sh = (g == 0) ? 3 : (g == 1 ? 1 : 0), head = g * 4 + h;
            const bf16_t* Qp = Qd + (size_t)(b * DILH + head) * S * 64; const bf16_t* Kp = Kd + (size_t)(b * DILH + head) * S * 64; const bf16_t* Vp = Vtd + (size_t)(b * DILH + head) * 64 * S;
            if (g < 2) {
                const int rres = wave >> sh, tq = wave & ((1 << sh) - 1);
                const int p0 = rres * L + T0 / d + tq * 64;
                f32x16 O[2][2]; float lsum[2];
                dil_tile64<2>(Qp, Kp, Vp, p0, rres * L, (rres + 1) * L, shiftD, O, lsum, lane);
                const int r = lane & 31, hf = lane >> 5;
#pragma unroll
                for (int t = 0; t < 2; ++t) {
                    const int sw = swz9((tq * 64 + 32 * t + r) * d + rres);
                    const float lt = lsum[t] + shx(lsum[t], 32, lane);
                    if (g == 0) {
#pragma unroll
                        for (int mt = 0; mt < 2; ++mt)
#pragma unroll
                            for (int reg = 0; reg < 16; ++reg) Ol[(32 * mt + (reg & 3) + 8 * (reg >> 2) + 4 * hf) * 512 + sw] = O[t][mt][reg];
                        if (hf == 0) Ll[sw] = lt;
                    } else {
#pragma unroll
                        for (int mt = 0; mt < 2; ++mt)
#pragma unroll
                            for (int reg = 0; reg < 16; ++reg) Ol[(32 * mt + (reg & 3) + 8 * (reg >> 2) + 4 * hf) * 512 + sw] += O[t][mt][reg];
                        if (hf == 0) Ll[sw] += lt;
                    }
                }
            } else {
#pragma unroll 1
                for (int tt = 0; tt < 2; ++tt) {
                    const int rres = wave + 8 * tt, p0 = rres * L + T0 / d;
                    f32x16 O[1][2]; float lsum[1];
                    dil_tile64<1>(Qp, Kp, Vp, p0, rres * L, (rres + 1) * L, shiftD, O, lsum, lane);
                    const int r = lane & 31, hf = lane >> 5;
                    const int sw = swz9(r * d + rres);
                    const float lt = lsum[0] + shx(lsum[0], 32, lane);
#pragma unroll
                    for (int mt = 0; mt < 2; ++mt)
#pragma unroll
                        for (int reg = 0; reg < 16; ++reg) Ol[(32 * mt + (reg & 3) + 8 * (reg >> 2) + 4 * hf) * 512 + sw] += O[0][mt][reg];
                    if (hf == 0) Ll[sw] += lt;
                }
            }
            __syncthreads();
        }
        {
            const int sw = swz9(tid); const float inv = 1.0f / Ll[sw];
            bf16_t* op = YA + ((size_t)b * S + T0 + tid) * 256 + h * 64;
#pragma unroll
            for (int c = 0; c < 8; ++c) { float v[8];
#pragma unroll
                for (int k = 0; k < 8; ++k) v[k] = Ol[(8 * c + k) * 512 + sw] * inv;
                u32x4 w; w.x = pk2(v[0], v[1]); w.y = pk2(v[2], v[3]); w.z = pk2(v[4], v[5]); w.w = pk2(v[6], v[7]);
                *(u32x4*)(op + 8 * c) = w; }
        }
        __syncthreads();
    }
    phase_ids(F);
    const int lane2 = F.lane, wave2 = F.wave, tid2 = F.tid;
    const float boundN = 8.0f * wave_max(fabsf(inptr(IN_NQG)[lane2]), lane2) * wave_max(fabsf(inptr(IN_NKG)[lane2]), lane2) * LOG2E;
    LAS float* rpbl = (LAS float*)(F.lds + 256);
    LAS float* red = (LAS float*)(F.lds + LDS_L_OFF);
    float mx = 0.f;
    const float* rpb = inptr(IN_RPB);
    for (int i = tid2; i < NAH * 465; i += 512) { const float v = rpb[i]; rpbl[i] = v * LOG2E; mx = fmaxf(mx, fabsf(v)); }
    mx = wave_max(mx, lane2);
    if (lane2 == 0) red[wave2] = mx;
    __syncthreads();
    float bmax = 0.f;
#pragma unroll
    for (int w = 0; w < 8; ++w) bmax = fmaxf(bmax, red[w]);
    const float shiftN = boundN + bmax * LOG2E;
    if (!(flags & 2))
    for (int su = F.vcu; su < 256; su += F.G) {
        const int b = su >> 5, head = (su >> 2) & 7, band = su & 3;
        const bf16_t* Qp = Qn + (size_t)(b * NAH + head) * S * 64; const bf16_t* Kp = Kn + (size_t)(b * NAH + head) * S * 64; const bf16_t* Vp = Vtn + (size_t)(b * NAH + head) * 64 * S;
        bf16_t* yb = YB + (size_t)b * S * 512 + head * 64;
#pragma unroll 1
        for (int t = 0; t < 2; ++t) na_tile4(Qp, Kp, Vp, yb, rpbl + head * 465, band * 16 + 4 * (wave2 >> 1), 2 * (wave2 & 1) + t, shiftN, lane2);
    }
    __syncthreads();
}

__device__ __forceinline__ void p5_norm_router(Frame& F) {
    phase_ids(F);
    const int lane = F.lane, tid = F.tid;
    const float* w_router = inptr(IN_WROUTER); const float* norm2_g = inptr(IN_NORM2); const float* xin = inptr(IN_X); const bf16_t* dlt = (const bf16_t*)(F.ws + WS_DLT);
    LAS float* wl = (LAS float*)F.lds;
    for (int i = tid; i < D * NE; i += 512) { const int d = i >> 4, e = i & 15, ln = (d & 255) >> 2, ii = d & 3, j = d >> 8, q = e >> 2, c = e & 3;
        wl[((((j * 4 + ii) * 4 + q) * 64 + ln) << 2) + c] = w_router[i]; }
    __syncthreads();
    const int gw = F.vcu * 8 + F.wave, NGW = F.G * 8;
    bf16_t* H2 = (bf16_t*)(F.ws + WS_HB); float* aff = (float*)(F.ws + WS_AFF);
    const int myexp = ((lane & 1) << 3) | ((lane & 2) << 1) | ((lane & 4) >> 1) | ((lane & 8) >> 3);
    f32x4 xn[2][4]; u32x2 dn[2][4];
#define P5_LOAD(mm) do { _Pragma("unroll") for (int r = 0; r < 2; ++r) { const f32x4* _x = (const f32x4*)(xin + (size_t)((mm) + r) * D) + lane; const u32x2* _d = (const u32x2*)(dlt + (size_t)((mm) + r) * D) + lane; \
        _Pragma("unroll") for (int j = 0; j < 4; ++j) { xn[r][j] = _x[64 * j]; dn[r][j] = _d[64 * j]; } } } while (0)
    if (gw * 2 < M) P5_LOAD(gw * 2);
    for (int m0 = gw * 2; m0 < M; m0 += NGW * 2) {
        f32x2 lg[16];
#pragma unroll
        for (int e = 0; e < 16; ++e) lg[e] = (f32x2){0.f, 0.f};
        float rs[2]; f32x4 v[2][4];
#pragma unroll
        for (int r = 0; r < 2; ++r) { float s = 0.f;
#pragma unroll
            for (int j = 0; j < 4; ++j) { const u32x2 dw = dn[r][j]; v[r][j] = xn[r][j] + (f32x4){bflo(dw.x), bfhi(dw.x), bflo(dw.y), bfhi(dw.y)};
                s += (v[r][j][0] * v[r][j][0] + v[r][j][1] * v[r][j][1]) + (v[r][j][2] * v[r][j][2] + v[r][j][3] * v[r][j][3]); }
            rs[r] = rsqrtf(wave_sum(s, lane) * (1.f / D) + EPS); }
        { const int mn = m0 + NGW * 2; P5_LOAD(mn < M ? mn : m0); }
        __builtin_amdgcn_sched_barrier(0);
#pragma unroll
        for (int j = 0; j < 4; ++j) {
            const f32x4 gj = *(const f32x4*)(norm2_g + 4 * lane + 256 * j);
#pragma unroll
            for (int r = 0; r < 2; ++r) { v[r][j] = v[r][j] * rs[r] * gj;
                u32x2 w; w.x = pk2(v[r][j][0], v[r][j][1]); w.y = pk2(v[r][j][2], v[r][j][3]);
                const int mr = m0 + r, cc = 4 * lane + 256 * j;
                *(u32x2*)(H2 + ((size_t)(mr >> 8) * 16 + (cc >> 6)) * 16384 + (mr & 255) * 64 + (cc & 63)) = w; }
#pragma unroll
            for (int i = 0; i < 4; ++i) {
                const f32x2 hv = {v[0][j][i], v[1][j][i]};
#pragma unroll
                for (int q = 0; q < 4; ++q) { const f32x4 w4 = *(const LAS f32x4*)(wl + ((((j * 4 + i) * 4 + q) * 64 + lane) << 2));
                    lg[4 * q + 0] += hv * w4[0]; lg[4 * q + 1] += hv * w4[1]; lg[4 * q + 2] += hv * w4[2]; lg[4 * q + 3] += hv * w4[3]; }
                __builtin_amdgcn_sched_barrier(0);
            }
        }
#pragma unroll
        for (int r = 0; r < 2; ++r) {
            float a8[8], a4[4], a2[2], a1;
            { const bool up = lane & 1;
#pragma unroll
              for (int k = 0; k < 8; ++k) { const float keep = up ? lg[8 + k][r] : lg[k][r], send = up ? lg[k][r] : lg[8 + k][r]; a8[k] = keep + shx(send, 1, lane); } }
            { const bool up = lane & 2;
#pragma unroll
              for (int k = 0; k < 4; ++k) { const float keep = up ? a8[4 + k] : a8[k], send = up ? a8[k] : a8[4 + k]; a4[k] = keep + shx(send, 2, lane); } }
            { const bool up = lane & 4;
#pragma unroll
              for (int k = 0; k < 2; ++k) { const float keep = up ? a4[2 + k] : a4[k], send = up ? a4[k] : a4[2 + k]; a2[k] = keep + shx(send, 4, lane); } }
            { const bool up = lane & 8; const float keep = up ? a2[1] : a2[0], send = up ? a2[0] : a2[1]; a1 = keep + shx(send, 8, lane); }
            a1 += shx(a1, 16, lane); a1 += shx(a1, 32, lane);
            float mx = a1;
#pragma unroll
            for (int o = 1; o < 16; o <<= 1) mx = fmaxf(mx, shx(mx, o, lane));
            const float p = __expf(a1 - mx); float den = p;
#pragma unroll
            for (int o = 1; o < 16; o <<= 1) den += shx(den, o, lane);
            const int m = m0 + r;
            if (lane < 16) aff[((size_t)((m >> 12) * NE + myexp) << 12) + (m & 4095)] = p / den;
        }
    }
#undef P5_LOAD
    __syncthreads();
}

__device__ __forceinline__ int wave_sum_i(int v, int lane) {
#pragma unroll
    for (int o = 1; o < 64; o <<= 1) v += shxi(v, o, lane);
    return v;
}
__device__ __forceinline__ void p6_topk(Frame& F) {
    phase_ids(F);
    const int lane = F.lane, tid = F.tid, wave = F.wave;
    LAS int* red = (LAS int*)F.lds;
    const float* aff = (const float*)(F.ws + WS_AFF); int* idx = (int*)(F.ws + WS_IDX); float* glist = (float*)(F.ws + WS_GLIST); int* tokslot = (int*)(F.ws + WS_TOKSLOT);
    for (int li = F.vcu; li < NB * NE; li += F.G) {
        const int b = li >> 4, e = li & 15;
        const float* ap = aff + (size_t)li * S + 8 * tid;
        const f32x4 a0 = *(const f32x4*)ap, a1 = *(const f32x4*)(ap + 4);
        const float av[8] = {a0[0], a0[1], a0[2], a0[3], a1[0], a1[1], a1[2], a1[3]};
        unsigned key[8];
#pragma unroll
        for (int k = 0; k < 8; ++k) key[k] = __builtin_bit_cast(unsigned, av[k]);
        unsigned tau = 0u; int par = 0;
        for (int bit = 30; bit >= 0; --bit) {
            const unsigned cand = tau | (1u << bit); int c = 0;
#pragma unroll
            for (int k = 0; k < 8; ++k) c += (key[k] >= cand) ? 1 : 0;
            c = wave_sum_i(c, lane);
            if (lane == 0) red[par * 8 + wave] = c;
            __syncthreads();
            int tot = 0;
#pragma unroll
            for (int w = 0; w < 8; ++w) tot += red[par * 8 + w];
            if (tot >= CAP) tau = cand;
            par ^= 1;
        }
        int cg = 0, ce = 0;
#pragma unroll
        for (int k = 0; k < 8; ++k) { cg += (key[k] > tau) ? 1 : 0; ce += (key[k] == tau) ? 1 : 0; }
        int pkc = cg | (ce << 16), incl = pkc;
#pragma unroll
        for (int o = 1; o < 64; o <<= 1) { const int t = __builtin_amdgcn_ds_bpermute((lane - o) << 2, incl); if (lane >= o) incl += t; }
        __syncthreads();
        if (lane == 63) red[64 + wave] = incl;
        __syncthreads();
        int wpre = 0, total = 0;
#pragma unroll
        for (int w = 0; w < 8; ++w) { const int t = red[64 + w]; if (w < wave) wpre += t; total += t; }
        const int excl = wpre + incl - pkc;
        int gt_before = excl & 0xffff, eq_before = excl >> 16;
        const int need = CAP - (total & 0xffff);
        const size_t rowbase = (size_t)(e * NB + b) * CAP;
#pragma unroll
        for (int k = 0; k < 8; ++k) {
            const bool isg = key[k] > tau, ise = key[k] == tau;
            const bool sel = isg || (ise && eq_before < need);
            const int slot = gt_before + min(eq_before, need);
            const int tok = 8 * tid + k;
            if (sel) { idx[rowbase + slot] = tok; glist[rowbase + slot] = av[k]; }
            tokslot[(size_t)li * S + tok] = sel ? slot : -1;
            gt_before += isg ? 1 : 0; eq_before += ise ? 1 : 0;
        }
        __syncthreads();
    }
}

__device__ __forceinline__ int p9_slot(const int (&ts)[4], int e, int t) {
    const int src = (e >> 2) * 16 + t, k = e & 3;
    const int v = (k == 0) ? ts[0] : (k == 1 ? ts[1] : (k == 2 ? ts[2] : ts[3]));
    return __builtin_amdgcn_readlane(v, src);
}
__device__ __forceinline__ void p9_combine(Frame& F, const int flags) {
    phase_ids(F);
    const int lane = F.lane; (void)flags;
    const int gw = F.vcu * 8 + F.wave, NGW = F.G * 8;
    const int* tokslot = (const int*)(F.ws + WS_TOKSLOT); const bf16_t* Y = (const bf16_t*)(F.ws + WS_Y); const float* glist = (const float*)(F.ws + WS_GLIST);
    const float* xin = inptr(IN_X); const bf16_t* dlt = (const bf16_t*)(F.ws + WS_DLT);
    for (int ch = gw; ch < M / 16; ch += NGW) {
        const int t0 = ch * 16, b = t0 >> 12, s0 = t0 & 4095;
        int ts[4];
        unsigned long long bal[4];
#pragma unroll
        for (int k = 0; k < 4; ++k) { ts[k] = tokslot[((size_t)(b * NE + 4 * (lane >> 4) + k) << 12) + s0 + (lane & 15)]; bal[k] = __ballot(ts[k] >= 0); }
        f32x4 bx[3][4]; u32x2 bd[3][4], by[3][3][4]; float wy[3][3]; unsigned rest[3];
#define P9_ISSUE(t, buf) do { const f32x4* _x = (const f32x4*)(xin + (size_t)(t0 + (t)) * D) + lane; const u32x2* _d = (const u32x2*)(dlt + (size_t)(t0 + (t)) * D) + lane; \
            _Pragma("unroll") for (int j = 0; j < 4; ++j) { bx[buf][j] = _x[64 * j]; bd[buf][j] = _d[64 * j]; } \
            unsigned _m = 0u; _Pragma("unroll") for (int k = 0; k < 4; ++k) _Pragma("unroll") for (int eg = 0; eg < 4; ++eg) _m |= (unsigned)((bal[k] >> (eg * 16 + (t))) & 1ull) << (4 * eg + k); \
            _Pragma("unroll") for (int i = 0; i < 3; ++i) { size_t _row = 0; float _w = 0.f; \
                if (_m) { const int _e = __builtin_ctz(_m); _m &= _m - 1u; const int _s = p9_slot(ts, _e, (t)); _row = (size_t)(_e * NB + b) * CAP + _s; _w = glist[_row]; } \
                const u32x2* _y = (const u32x2*)(Y + _row * D) + lane; _Pragma("unroll") for (int j = 0; j < 4; ++j) by[buf][i][j] = _y[64 * j]; wy[buf][i] = _w; } \
            rest[buf] = _m; } while (0)
#define P9_CONSUME(t, buf) do { f32x4 acc[4]; \
            _Pragma("unroll") for (int j = 0; j < 4; ++j) { const u32x2 dw = bd[buf][j]; acc[j] = bx[buf][j] + (f32x4){bflo(dw.x), bfhi(dw.x), bflo(dw.y), bfhi(dw.y)}; } \
            _Pragma("unroll") for (int i = 0; i < 3; ++i) { const float _w = wy[buf][i]; _Pragma("unroll") for (int j = 0; j < 4; ++j) { const u32x2 w = by[buf][i][j]; \
                acc[j][0] += _w * bflo(w.x); acc[j][1] += _w * bfhi(w.x); acc[j][2] += _w * bflo(w.y); acc[j][3] += _w * bfhi(w.y); } } \
            unsigned _m = rest[buf]; \
            while (_m) { const int _e = __builtin_ctz(_m); _m &= _m - 1u; const int _s = p9_slot(ts, _e, (t)); const size_t _r = (size_t)(_e * NB + b) * CAP + _s; const u32x2* _y = (const u32x2*)(Y + _r * D) + lane; const float _g = glist[_r]; \
                _Pragma("unroll") for (int j = 0; j < 4; ++j) { const u32x2 w = _y[64 * j]; acc[j][0] += _g * bflo(w.x); acc[j][1] += _g * bfhi(w.x); acc[j][2] += _g * bflo(w.y); acc[j][3] += _g * bfhi(w.y); } } \
            f32x4* _o = (f32x4*)(F.out + (size_t)(t0 + (t)) * D) + lane; _Pragma("unroll") for (int j = 0; j < 4; ++j) _o[64 * j] = acc[j]; } while (0)
        P9_ISSUE(0, 0); P9_ISSUE(1, 1);
#pragma unroll 1
        for (int t = 0; t < 15; t += 3) {
            P9_ISSUE(t + 2, 2); __builtin_amdgcn_sched_barrier(0);
            P9_CONSUME(t, 0); __builtin_amdgcn_sched_barrier(0);
            P9_ISSUE(t + 3, 0); __builtin_amdgcn_sched_barrier(0);
            P9_CONSUME(t + 1, 1); __builtin_amdgcn_sched_barrier(0);
            { const int tn = (t + 4 < 16) ? t + 4 : 15; P9_ISSUE(tn, 1); } __builtin_amdgcn_sched_barrier(0);
            P9_CONSUME(t + 2, 2); __builtin_amdgcn_sched_barrier(0);
        }
        P9_CONSUME(15, 0);
#undef P9_ISSUE
#undef P9_CONSUME
    }
}

constexpr int N_PHASES = 10;
struct Args { const float* in[16]; float* out; unsigned char* ws; int ph_lo, ph_hi, flags, pad; };
__global__ void __launch_bounds__(512, 2) mk_fwd(Args args) {
    extern __shared__ __attribute__((aligned(16))) unsigned char lds_raw[];
    Frame F;
    F.lds = (LAS unsigned char*)lds_raw;
    { const int t0 = threadIdx.x; F.wave = __builtin_amdgcn_readfirstlane(t0 >> 6); } phase_ids(F);
    F.G = gridDim.x; { const int bx = blockIdx.x; F.vcu = (F.G % 8 == 0) ? (bx % 8) * (F.G / 8) + bx / 8 : bx; }
    F.out = args.out; F.ws = args.ws;
    volatile LAS unsigned* misc = (volatile LAS unsigned*)(F.lds + LDS_MISC_OFF);
    if (F.tid < 64) misc[F.tid] = 0u;
    __syncthreads();
    const int lo = args.ph_lo, hi = args.ph_hi;
    unsigned* ctl = (unsigned*)(F.ws + WS_CTL);
    XcdBarrier bar; bar.bar = ctl + CW_BAR; bar.x = 0; bar.st = misc + 8;
    if (hi - lo > 1) bar = xcd_barrier_post(ctl + CW_BAR, misc + 8, F.tid == 0);
#ifdef MK_ONLY_PHASE
#define IN(k) ((k) == MK_ONLY_PHASE && lo <= (k) && (k) < hi)
#else
#define IN(k) (lo <= (k) && (k) < hi)
#endif
#define SEAM(k) do { if (IN(k) && IN((k) + 1)) { phase_ids(F); xcd_barrier(bar, F.tid == 0); } } while (0)
    const int c = (int)blockIdx.x, G = F.G;
    const char* hb = (const char*)(F.ws + WS_HB); const char* win = (const char*)(F.ws + WS_WIN);
    const WtBuf wbws = wt_make(F.ws, 0x20000000u), wbout = wt_make(F.out, 0x08000000u);
    bf16_t* gates = (bf16_t*)F.out;

    if (IN(0)) { p0_prologue(F); VM_WAIT(); __syncthreads(); }
    SEAM(0);
    if (IN(1)) {
        SchedP1 S1{ SchedQKd{hb, win, (char*)(F.ws + WS_QD), (char*)(F.ws + WS_KD), G, c}, SchedQKn{hb, win, (char*)(F.ws + WS_QN), (char*)(F.ws + WS_KN), G, c},
                    SchedGates{hb, win, G, c}, SchedVt{hb, win, (char*)(F.ws + WS_VTD), (char*)(F.ws + WS_VTN), G, c}, G, c };
        EpiP1 E1{ EpiQK<true>{inptr(IN_DQG), inptr(IN_DKG), (const f32x2*)(F.ws + WS_ROPE), 0.125f * LOG2E, wbws}, EpiQK<false>{inptr(IN_NQG), inptr(IN_NKG), nullptr, 0.125f * LOG2E, wbws},
                  EpiGates{gates, wbout}, EpiVt{wbws}, (args.flags >> 8) & 15 };
        g8::gemm_phase<EpiP1, SchedP1, false>(F.lds, S1, E1, F.wave);
        { const int rem = 2944 % G; if (rem > 0 && c >= rem) { phase_ids(F); convert_experts(F, EXP_P0, EXP_P1, c - rem, G - rem); } }
    }
    SEAM(1);
    if (IN(2)) p2_attention(F, args.flags);
    SEAM(2);
    if (IN(3)) {
        SchedP3 S3{(const char*)(F.ws + WS_YA), (const char*)(F.ws + WS_PA), (const char*)(F.ws + WS_YB), (const char*)(F.ws + WS_PB), G, c};
        EpiP3 E3{(bf16_t*)(F.ws + WS_HB), gates, wbws};
        g8::gemm_phase<EpiP3, SchedP3, false>(F.lds, S3, E3, F.wave);
    }
    SEAM(3);
    if (IN(4)) {
        SchedKtm So{(const char*)(F.ws + WS_HB), (const char*)(F.ws + WS_WO), 128, 4, G, c, 16};
        EpiBf16<0> E{(bf16_t*)(F.ws + WS_DLT), D, 0, wbws};
        g8::gemm_phase<EpiBf16<0>, SchedKtm, false>(F.lds, So, E, F.wave);
    }
    SEAM(4);
    if (IN(5)) p5_norm_router(F);
    SEAM(5);
    if (IN(6)) {
        p6_topk(F);
        const int nl = NB * NE;
        if (F.G > nl) { if (F.vcu >= nl) convert_experts(F, EXP_P1, NE, F.vcu - nl, F.G - nl); }
        else convert_experts(F, EXP_P1, NE, F.vcu, F.G);
    }
    SEAM(6);
    if (IN(7)) {
        SchedGU Sg{(const char*)(F.ws + WS_HB), (const char*)(F.ws + WS_WGU), (const int*)(F.ws + WS_IDX), G, c};
        EpiSwiGLU E{(bf16_t*)(F.ws + WS_H), args.flags & 64, wbws};
        g8::gemm_phase<EpiSwiGLU, SchedGU, true>(F.lds, Sg, E, F.wave);
    }
    SEAM(7);
    if (IN(8)) {
        SchedDown Sd{(const char*)(F.ws + WS_H), (const char*)(F.ws + WS_WD), G, c};
        EpiBf16<0> E{(args.flags & 64) ? (bf16_t*)(F.ws + WS_HB) : (bf16_t*)(F.ws + WS_Y), D, (args.flags >> 6) & 3, wbws};
        g8::gemm_phase<EpiBf16<0>, SchedDown, false>(F.lds, Sd, E, F.wave);
    }
    SEAM(8);
    if (IN(9)) p9_combine(F, args.flags);
#undef IN
#undef SEAM
}
#ifndef MK_HYB
#define MK_HYB 10
#endif
#ifndef MK_PER_PHASE
#define MK_PER_PHASE 0
#endif

#if MK_HYB < 10
#if MK_HYB > 5
#error "hybrid builds past P5 are not supported any more (h2 is stored K-tile-major)"
#endif
namespace tail {
struct GemmArgs { const float* A; const float* Bm; float* C; const int* gather; int M, N, K, lda, ldb, ldc; long sA, sB, sC; int sG; };
__global__ void __launch_bounds__(256) k_gemm(GemmArgs g) {
    __shared__ float As[16][128 + 4];
    __shared__ float Bs[16][128 + 4];
    const int z = blockIdx.z;
    const float* A = g.A + (long)z * g.sA; const float* Bm = g.Bm + (long)z * g.sB; float* C = g.C + (long)z * g.sC;
    const int* gi = g.gather ? g.gather + (long)z * g.sG : nullptr;
    const int m0 = blockIdx.y * 128, n0 = blockIdx.x * 128, tid = threadIdx.x, tx = tid & 15, ty = tid >> 4;
    float acc[8][8];
#pragma unroll
    for (int i = 0; i < 8; ++i)
#pragma unroll
        for (int j = 0; j < 8; ++j) acc[i][j] = 0.f;
    const int ar = tid >> 1, ak = (tid & 1) * 8;
    const long arow = gi ? (long)gi[m0 + ar] : (long)(m0 + ar);
    const float* ap = A + arow * g.lda + ak;
    const int bk = tid >> 4, bn = (tid & 15) * 8;
    const float* bp = Bm + (long)bk * g.ldb + n0 + bn;
    for (int k0 = 0; k0 < g.K; k0 += 16) {
        const float4 a0 = *(const float4*)(ap + k0), a1 = *(const float4*)(ap + k0 + 4);
        const float4 b0 = *(const float4*)(bp + (long)k0 * g.ldb), b1 = *(const float4*)(bp + (long)k0 * g.ldb + 4);
        __syncthreads();
        As[ak + 0][ar] = a0.x; As[ak + 1][ar] = a0.y; As[ak + 2][ar] = a0.z; As[ak + 3][ar] = a0.w;
        As[ak + 4][ar] = a1.x; As[ak + 5][ar] = a1.y; As[ak + 6][ar] = a1.z; As[ak + 7][ar] = a1.w;
        *(float4*)&Bs[bk][bn] = b0; *(float4*)&Bs[bk][bn + 4] = b1;
        __syncthreads();
#pragma unroll
        for (int k = 0; k < 16; ++k) {
            float av[8], bv[8];
            const float4 x0 = *(const float4*)&As[k][ty * 4], x1 = *(const float4*)&As[k][64 + ty * 4];
            const float4 y0 = *(const float4*)&Bs[k][tx * 4], y1 = *(const float4*)&Bs[k][64 + tx * 4];
            av[0] = x0.x; av[1] = x0.y; av[2] = x0.z; av[3] = x0.w; av[4] = x1.x; av[5] = x1.y; av[6] = x1.z; av[7] = x1.w;
            bv[0] = y0.x; bv[1] = y0.y; bv[2] = y0.z; bv[3] = y0.w; bv[4] = y1.x; bv[5] = y1.y; bv[6] = y1.z; bv[7] = y1.w;
#pragma unroll
            for (int i = 0; i < 8; ++i)
#pragma unroll
                for (int j = 0; j < 8; ++j) acc[i][j] = fmaf(av[i], bv[j], acc[i][j]);
        }
    }
#pragma unroll
    for (int i = 0; i < 8; ++i) {
        const int m = m0 + (i < 4 ? ty * 4 + i : 64 + ty * 4 + (i - 4));
        float* cp = C + (long)m * g.ldc + n0;
        *(float4*)(cp + tx * 4) = make_float4(acc[i][0], acc[i][1], acc[i][2], acc[i][3]);
        *(float4*)(cp + 64 + tx * 4) = make_float4(acc[i][4], acc[i][5], acc[i][6], acc[i][7]);
    }
}
__device__ __forceinline__ float bf2f(bf16_t v) { return __builtin_bit_cast(float, (unsigned)v << 16); }
__device__ __forceinline__ size_t qd_ix(int pos, int dim) { return (size_t)(pos >> 5) * 2048 + (dim >> 4) * 512 + ((dim >> 3) & 1) * 256 + (pos & 31) * 8 + (dim & 7); }
__device__ __forceinline__ size_t vtd_ix(int pos, int dim) { const int kk = pos & 31, k16 = kk & 15; return (size_t)(pos >> 5) * 2048 + ((dim >> 5) * 2 + (kk >> 4)) * 512 + ((k16 >> 2) & 1) * 256 + (dim & 31) * 8 + (k16 >> 3) * 4 + (k16 & 3); }
__device__ __forceinline__ size_t qn_ix(int tok, int dim) { return (size_t)(tok >> 3) * 512 + (dim >> 5) * 256 + ((dim >> 3) & 3) * 64 + (tok & 7) * 8 + (dim & 7); }
__device__ __forceinline__ size_t vtn_ix(int tok, int dim) { return (size_t)(tok >> 3) * 512 + dim * 8 + (tok & 7); }
__global__ void __launch_bounds__(256) k_dil_attn(const bf16_t* Qd, const bf16_t* Kd, const bf16_t* Vtd, float* ya, int b) {
    const int w = blockIdx.x * 4 + (threadIdx.x >> 6), lane = threadIdx.x & 63, tok = w >> 2, h = w & 3, wi = threadIdx.x >> 6;
    __shared__ float qs[4][64]; __shared__ float ps[4][3 * 129 + 3];
    float sc[3][3]; float mx = -INFINITY;
#pragma unroll
    for (int g = 0; g < 3; ++g) {
        const int d = (g == 0) ? 1 : (g == 1 ? 4 : 16), L = S / d, head = g * 4 + h;
        const size_t hb = (size_t)(b * DILH + head) * S;
        qs[wi][lane] = bf2f(Qd[hb * 64 + qd_ix((tok % d) * L + tok / d, lane)]);
        __syncthreads();
#pragma unroll
        for (int rd = 0; rd < 3; ++rd) {
            const int j = rd * 64 + lane; float s = -INFINITY;
            if (j <= 128) { const int kt = tok + (j - 64) * d;
                if (kt >= 0 && kt < S) { const int kpos = (kt % d) * L + kt / d; float a = 0.f; for (int c = 0; c < 64; ++c) a += qs[wi][c] * bf2f(Kd[hb * 64 + qd_ix(kpos, c)]); s = a; } }
            sc[g][rd] = s; mx = fmaxf(mx, s);
        }
        __syncthreads();
    }
    mx = wave_max(mx);
    float den = 0.f;
#pragma unroll
    for (int g = 0; g < 3; ++g)
#pragma unroll
        for (int rd = 0; rd < 3; ++rd) { const int j = rd * 64 + lane; const float p = (sc[g][rd] == -INFINITY) ? 0.f : exp2f(sc[g][rd] - mx); den += p; if (j <= 128) ps[wi][g * 129 + j] = p; }
    den = wave_sum(den);
    __syncthreads();
    float o = 0.f;
    for (int g = 0; g < 3; ++g) {
        const int d = (g == 0) ? 1 : (g == 1 ? 4 : 16), L = S / d, head = g * 4 + h;
        const bf16_t* vp = Vtd + (size_t)(b * DILH + head) * 64 * S;
        for (int j = 0; j <= 128; ++j) { const int kt = tok + (j - 64) * d; if (kt >= 0 && kt < S) { const int pp = (kt % d) * L + kt / d; o += ps[wi][g * 129 + j] * bf2f(vp[vtd_ix(pp, lane)]); } }
    }
    ya[(long)tok * 256 + h * 64 + lane] = o / den;
}
__global__ void __launch_bounds__(256) k_na_attn(const bf16_t* Qn, const bf16_t* Kn, const bf16_t* Vtn, const float* rpb, float* yb, int b) {
    const int w = blockIdx.x * 4 + (threadIdx.x >> 6), lane = threadIdx.x & 63, tok = w >> 3, h = w & 7, wi = threadIdx.x >> 6;
    __shared__ float qs[4][64]; __shared__ float ps[4][128];
    const int r = tok / GW, c = tok % GW, rs = min(max(r - 4, 0), 56), ws = min(max(c - 8, 0), 48);
    const size_t hb = (size_t)(b * NAH + h) * S;
    qs[wi][lane] = bf2f(Qn[hb * 64 + qn_ix(tok, lane)]);
    __syncthreads();
    float sc[2]; float mx = -INFINITY;
#pragma unroll
    for (int rd = 0; rd < 2; ++rd) {
        const int j = rd * 64 + lane, kr = rs + (j >> 4), kc = ws + (j & 15);
        float a = 0.f;
        for (int cc = 0; cc < 64; ++cc) a += qs[wi][cc] * bf2f(Kn[hb * 64 + qn_ix(kr * GW + kc, cc)]);
        sc[rd] = a + rpb[(h * 15 + (kr - r + 7)) * 31 + (kc - c + 15)] * LOG2E; mx = fmaxf(mx, sc[rd]);
    }
    mx = wave_max(mx);
    float den = 0.f;
#pragma unroll
    for (int rd = 0; rd < 2; ++rd) { const float p = exp2f(sc[rd] - mx); den += p; ps[wi][rd * 64 + lane] = p; }
    den = wave_sum(den);
    __syncthreads();
    float o = 0.f;
    const bf16_t* vp = Vtn + (size_t)(b * NAH + h) * 64 * S;
    for (int j = 0; j < 128; ++j) { const int pp = (rs + (j >> 4)) * GW + ws + (j & 15); o += ps[wi][j] * bf2f(vp[vtn_ix(pp, lane)]); }
    yb[(long)tok * 512 + h * 64 + lane] = o / den;
}
__global__ void k_bf2f(const bf16_t* a, float* o, long n) { const long i = (long)blockIdx.x * blockDim.x + threadIdx.x; if (i < n) o[i] = bf2f(a[i]); }
__global__ void k_merge(const bf16_t* gates, const float* yap, const float* ybp, float* merged) {
    const long i = (long)blockIdx.x * blockDim.x + threadIdx.x; if (i >= (long)S * D) return;
    const int tok = (int)(i / D), c = (int)(i % D);
    const float sn = bf2f(gates[(long)tok * 2048 + 1024 + c]); merged[i] = (yap[i] * bf2f(gates[(long)tok * 2048 + c]) + ybp[i]) * sn;
}
__global__ void k_add(const float* a, const float* b, float* o, long n) { const long i = (long)blockIdx.x * blockDim.x + threadIdx.x; if (i < n) o[i] = a[i] + b[i]; }
__global__ void __launch_bounds__(256) k_norm_router(const float* x1, const float* g, const float* wr, float* h2, float* aff) {
    const int row = blockIdx.x * 4 + (threadIdx.x >> 6), lane = threadIdx.x & 63;
    const float* xp = x1 + (long)row * D; float v[16]; float ss = 0.f;
#pragma unroll
    for (int i = 0; i < 16; ++i) { v[i] = xp[lane + 64 * i]; ss += v[i] * v[i]; }
    ss = wave_sum(ss);
    const float rs = rsqrtf(ss * (1.0f / D) + EPS);
    float lg[16];
#pragma unroll
    for (int e = 0; e < 16; ++e) lg[e] = 0.f;
#pragma unroll
    for (int i = 0; i < 16; ++i) { const float hv = v[i] * rs * g[lane + 64 * i]; h2[(long)row * D + lane + 64 * i] = hv; const float* wp = wr + (long)(lane + 64 * i) * NE;
#pragma unroll
        for (int e = 0; e < 16; ++e) lg[e] += hv * wp[e]; }
    float mx = -INFINITY;
#pragma unroll
    for (int e = 0; e < 16; ++e) { lg[e] = wave_sum(lg[e]); mx = fmaxf(mx, lg[e]); }
    float den = 0.f;
#pragma unroll
    for (int e = 0; e < 16; ++e) { lg[e] = __expf(lg[e] - mx); den += lg[e]; }
    if (lane < 16) { float mine = 0.f;
#pragma unroll
        for (int e = 0; e < 16; ++e) mine = (lane == e) ? lg[e] : mine;
        aff[(long)lane * S + row] = mine / den; }
}
__global__ void __launch_bounds__(1024) k_topk(const float* aff, int* idx, float* gate) {
    __shared__ float a[S]; const int e = blockIdx.x;
    for (int i = threadIdx.x; i < S; i += 1024) a[i] = aff[(long)e * S + i];
    __syncthreads();
    for (int i = threadIdx.x; i < S; i += 1024) { const float v = a[i]; int rank = 0;
        for (int j = 0; j < S; ++j) { const float u = a[j]; rank += (u > v || (u == v && j < i)) ? 1 : 0; }
        if (rank < CAP) { idx[e * CAP + rank] = i; gate[e * CAP + rank] = v; } }
}
__global__ void k_swiglu(const float* a, const float* u, float* o, long n) { const long i = (long)blockIdx.x * blockDim.x + threadIdx.x; if (i < n) { const float x = a[i]; o[i] = x / (1.f + __expf(-x)) * u[i]; } }
__global__ void k_scatter(const float* y, const int* idx, const float* gate, int es, float* out) {
    const long i = (long)blockIdx.x * blockDim.x + threadIdx.x; if (i >= (long)NE * CAP * D) return;
    const int row = (int)(i / D), c = (int)(i % D), e = row / CAP, sl = row % CAP;
    atomicAdd(out + (long)idx[e * es + sl] * D + c, gate[e * es + sl] * y[i]);
}
static void gemm(hipStream_t st, const float* A, const float* Bm, float* C, int M_, int N, int K, int lda, int ldb, int ldc,
                 int nz = 1, long sA = 0, long sB = 0, long sC = 0, const int* gather = nullptr, int sG = 0) {
    GemmArgs g{}; g.A = A; g.Bm = Bm; g.C = C; g.gather = gather; g.M = M_; g.N = N; g.K = K; g.lda = lda; g.ldb = ldb; g.ldc = ldc; g.sA = sA; g.sB = sB; g.sC = sC; g.sG = sG;
    hipLaunchKernelGGL(k_gemm, dim3(N / 128, M_ / 128, nz), dim3(256), 0, st, g);
}
struct Bump { size_t lo[3], hi[3]; int n, cur; size_t at;
    float* take(size_t nfloats) { size_t bytes = ((nfloats * 4) + 255) & ~(size_t)255;
        while (cur < n && at + bytes > hi[cur]) { ++cur; if (cur < n) at = lo[cur]; }
        if (cur >= n) { fprintf(stderr, "tail scratch exhausted\n"); return nullptr; }
        float* p = (float*)at; at += bytes; return p; } };
}
#endif

extern "C" void kernel_launch(void* const* d_in, const int* in_sizes, int n_in, void* d_out, int out_size, void* d_ws, size_t ws_size, hipStream_t stream) {
    static int grid = 0;
    if (grid == 0) {
        if (n_in != 16 || out_size != M * D || ws_size < WS_END) { fprintf(stderr, "kernel_launch: unexpected problem (n_in %d, out %d, ws %zu)\n", n_in, out_size, ws_size); grid = -1; return; }
        int dev = 0, cus = 0, per_cu = 0;
        if (hipGetDevice(&dev) != hipSuccess || hipDeviceGetAttribute(&cus, hipDeviceAttributeMultiprocessorCount, dev) != hipSuccess) { grid = -1; return; }
        if (hipFuncSetAttribute((const void*)mk_fwd, hipFuncAttributeMaxDynamicSharedMemorySize, LDS_BYTES) != hipSuccess) { fprintf(stderr, "kernel_launch: hipFuncSetAttribute failed\n"); grid = -1; return; }
        if (hipOccupancyMaxActiveBlocksPerMultiprocessor(&per_cu, (const void*)mk_fwd, 512, LDS_BYTES) != hipSuccess || per_cu < 1)
            fprintf(stderr, "kernel_launch: occupancy query reports %d workgroups per CU\n", per_cu);
        (void)hipGetLastError();
        grid = cus;
    }
    if (grid < 0) return;
    (void)hipMemsetAsync((char*)d_ws + WS_CTL, 0, CTL_BYTES, stream);
    Args a{};
    for (int i = 0; i < 16; ++i) a.in[i] = (const float*)d_in[i];
    a.out = (float*)d_out; a.ws = (unsigned char*)d_ws;
#if MK_PER_PHASE
    for (int p = 0; p < MK_HYB; ++p) { a.ph_lo = p; a.ph_hi = p + 1; hipLaunchKernelGGL(mk_fwd, dim3(grid), dim3(512), LDS_BYTES, stream, a);
#ifdef MK_REPEAT_PHASE
        if (p == MK_REPEAT_PHASE) {
#ifdef MK_REPEAT_FLAGS
            a.flags = MK_REPEAT_FLAGS;
#endif
            hipLaunchKernelGGL(mk_fwd, dim3(grid), dim3(512), LDS_BYTES, stream, a); a.flags = 0; }
#endif
    }
#else
    a.ph_lo = 0; a.ph_hi = MK_HYB; hipLaunchKernelGGL(mk_fwd, dim3(grid), dim3(512), LDS_BYTES, stream, a);
#endif
#if MK_HYB < 10
    using namespace tail;
    unsigned char* ws = (unsigned char*)d_ws; float* out = (float*)d_out;
    Bump bp{};
#if MK_HYB <= 2
    bp.n = 3; bp.lo[0] = (size_t)(ws + 17 * MiB); bp.hi[0] = (size_t)(ws + 113 * MiB); bp.lo[1] = (size_t)(ws + 118 * MiB); bp.hi[1] = (size_t)(ws + 182 * MiB); bp.lo[2] = (size_t)(ws + 422 * MiB); bp.hi[2] = (size_t)(ws + 512 * MiB);
#elif MK_HYB <= 4
    bp.n = 3; bp.lo[0] = (size_t)(ws + 17 * MiB); bp.hi[0] = (size_t)(ws + 113 * MiB); bp.lo[1] = (size_t)(ws + 182 * MiB); bp.hi[1] = (size_t)(ws + 422 * MiB); bp.lo[2] = (size_t)(ws + 470 * MiB); bp.hi[2] = (size_t)(ws + 512 * MiB);
#elif MK_HYB <= 6
    bp.n = 1; bp.lo[0] = (size_t)(ws + 182 * MiB); bp.hi[0] = (size_t)(ws + 512 * MiB);
#else
    bp.n = 1; bp.lo[0] = (size_t)(ws + 182 * MiB); bp.hi[0] = (size_t)(ws + 512 * MiB);
#endif
    bp.cur = 0; bp.at = bp.lo[0];
    float* ya = bp.take((size_t)S * 256); float* yb = bp.take((size_t)S * 512);
    float* yap = bp.take((size_t)S * D); float* ybp = bp.take((size_t)S * D); float* merged = bp.take((size_t)S * D); float* tmp = bp.take((size_t)S * D);
    float* h2 = bp.take((size_t)S * D); float* aff = bp.take((size_t)NE * S); int* idx = (int*)bp.take((size_t)NE * CAP); float* gate = bp.take((size_t)NE * CAP);
    float* ea = bp.take((size_t)NE * CAP * FF); float* eu = bp.take((size_t)NE * CAP * FF);
    const float* x = a.in[0];
    for (int b = 0; b < NB; ++b) {
        const float* xb = x + (size_t)b * S * D; float* ob = out + (size_t)b * S * D;
        const bf16_t* gates_b = (const bf16_t*)d_out + (size_t)b * S * 2048;
#if MK_HYB <= 2
        hipLaunchKernelGGL(k_dil_attn, dim3(S), dim3(256), 0, stream, (const bf16_t*)(ws + WS_QD), (const bf16_t*)(ws + WS_KD), (const bf16_t*)(ws + WS_VTD), ya, b);
        hipLaunchKernelGGL(k_na_attn, dim3(S * 2), dim3(256), 0, stream, (const bf16_t*)(ws + WS_QN), (const bf16_t*)(ws + WS_KN), (const bf16_t*)(ws + WS_VTN), a.in[7], yb, b);
#elif MK_HYB <= 3
        hipLaunchKernelGGL(k_bf2f, dim3(S * 256 / 256), dim3(256), 0, stream, (const bf16_t*)(ws + WS_YA) + (size_t)b * S * 256, ya, (long)S * 256);
        hipLaunchKernelGGL(k_bf2f, dim3(S * 512 / 256), dim3(256), 0, stream, (const bf16_t*)(ws + WS_YB) + (size_t)b * S * 512, yb, (long)S * 512);
#endif
#if MK_HYB <= 3
        gemm(stream, ya, a.in[8], yap, S, D, 256, 256, D, D);
        gemm(stream, yb, a.in[9], ybp, S, D, 512, 512, D, D);
        hipLaunchKernelGGL(k_merge, dim3((S * D) / 256), dim3(256), 0, stream, gates_b, yap, ybp, merged);
        gemm(stream, merged, a.in[10], tmp, S, D, D, D, D, D);
        hipLaunchKernelGGL(k_add, dim3((S * D) / 256), dim3(256), 0, stream, xb, tmp, ob, (long)S * D);
#elif MK_HYB == 4
#error "MK_HYB == 4 is not supported any more (merged is stored K-tile-major)"
        hipLaunchKernelGGL(k_bf2f, dim3(S * D / 256), dim3(256), 0, stream, (const bf16_t*)(ws + WS_HB) + (size_t)b * S * D, merged, (long)S * D);
        gemm(stream, merged, a.in[10], tmp, S, D, D, D, D, D);
        hipLaunchKernelGGL(k_add, dim3((S * D) / 256), dim3(256), 0, stream, xb, tmp, ob, (long)S * D);
#endif
        const int* idx_b = idx; const float* gate_b = gate; int es = CAP;
#if MK_HYB <= 5
        hipLaunchKernelGGL(k_norm_router, dim3(S / 4), dim3(256), 0, stream, ob, a.in[11], a.in[12], h2, aff);
        hipLaunchKernelGGL(k_topk, dim3(NE), dim3(1024), 0, stream, aff, idx, gate);
#else
        hipLaunchKernelGGL(k_bf2f, dim3(S * D / 256), dim3(256), 0, stream, (const bf16_t*)(ws + WS_HB) + (size_t)b * S * D, h2, (long)S * D);
        idx_b = (const int*)(ws + WS_IDX) + (size_t)b * CAP; gate_b = (const float*)(ws + WS_GLIST) + (size_t)b * CAP; es = NB * CAP;
#endif
        gemm(stream, h2, a.in[13], ea, CAP, FF, D, D, FF, FF, NE, 0, (long)D * FF, (long)CAP * FF, idx_b, es);
        gemm(stream, h2, a.in[14], eu, CAP, FF, D, D, FF, FF, NE, 0, (long)D * FF, (long)CAP * FF, idx_b, es);
        hipLaunchKernelGGL(k_swiglu, dim3((NE * CAP * FF) / 256), dim3(256), 0, stream, ea, eu, ea, (long)NE * CAP * FF);
        gemm(stream, ea, a.in[15], eu, CAP, D, FF, FF, D, D, NE, (long)CAP * FF, (long)FF * D, (long)CAP * D);
        hipLaunchKernelGGL(k_scatter, dim3((NE * CAP * D) / 256), dim3(256), 0, stream, eu, idx_b, gate_b, es, ob);
    }
#endif
}
```
